# Optimizing an MI355X kernel written in HIP

```python
import math
import jax
import jax.numpy as jnp
from jax import lax
import numpy as np

D_MODEL = 1024
BATCH = 4
SEQ = 4096
DEPTH = 1
DEC_BATCH = 2
DEC_SEQ = 8192
PAST_LEN = 128

HEAD_DIM = 64
DA_HEADS = 8
DA_VDIM = 2 * HEAD_DIM
DIL_CONFIG = ((128, 1), (512, 4), (2048, 16))
N_DIL = 3
DIL_HEADS = 8
D_FF = 4 * D_MODEL
N_BUCKETS = 32
MAX_DISTANCE = 128
Q_BLOCK = 128
NEG_INF = -1e30
EPS = 1e-6

DA_QK = DA_HEADS * HEAD_DIM
DA_V = DA_HEADS * DA_VDIM
DIL_W = DIL_HEADS * HEAD_DIM
COL_SIZES = (DA_QK, DA_QK, DA_QK, DA_QK, DA_V) + (DIL_W,) * (3 * N_DIL) + (D_MODEL, D_MODEL)
IN_COLS = 4 * DA_QK + DA_V + 3 * N_DIL * DIL_W + 2 * D_MODEL
N_REL_HEADS = DA_HEADS + N_DIL * DIL_HEADS

kernel_name = "hybrid_diff_dilated_encoder"


def rms_norm(x, g):
    xf = x.astype(jnp.float32)
    y = xf * lax.rsqrt(jnp.mean(jnp.square(xf), axis=-1, keepdims=True) + EPS)
    return (y * g.astype(jnp.float32)).astype(x.dtype)


def rel_bucket(rel):
    nb = N_BUCKETS // 2
    max_exact = nb // 2
    ret = jnp.where(rel > 0, nb, 0)
    n = jnp.abs(rel)
    nf = jnp.maximum(n, 1).astype(jnp.float32)
    large = max_exact + (jnp.log(nf / max_exact) / math.log(MAX_DISTANCE / max_exact)
                         * (nb - max_exact)).astype(jnp.int32)
    large = jnp.minimum(large, nb - 1)
    return ret + jnp.where(n < max_exact, n, large)


def diff_attention(q1, q2, k1, k2, v, bias_tab, lam):
    B, H, S, Dh = q1.shape
    nblk = S // Q_BLOCK
    scale = Dh ** -0.5
    kpos = jnp.arange(S)

    def block(args):
        i, q1b, q2b = args
        qpos = i * Q_BLOCK + jnp.arange(Q_BLOCK)
        bias = jnp.transpose(bias_tab[rel_bucket(kpos[None, :] - qpos[:, None])], (2, 0, 1)).astype(jnp.float32)
        s1 = jnp.einsum('bhqd,bhkd->bhqk', q1b, k1).astype(jnp.float32) * scale + bias
        s2 = jnp.einsum('bhqd,bhkd->bhqk', q2b, k2).astype(jnp.float32) * scale + bias
        p = jax.nn.softmax(s1, axis=-1) - lam * jax.nn.softmax(s2, axis=-1)
        return jnp.einsum('bhqk,bhkv->bhqv', p.astype(v.dtype), v)

    qb1 = q1.reshape(B, H, nblk, Q_BLOCK, Dh).transpose(2, 0, 1, 3, 4)
    qb2 = q2.reshape(B, H, nblk, Q_BLOCK, Dh).transpose(2, 0, 1, 3, 4)
    out = lax.map(block, (jnp.arange(nblk), qb1, qb2))
    return out.transpose(1, 0, 3, 2, 4).reshape(B, S, H, v.shape[-1])


def dilated_window_attention(q, k, v, bias_tab, window, dilation):
    B, S, H, Dh = q.shape
    r = dilation
    half = window // (2 * r)
    L = S // r
    blk = half
    nb = -(-L // blk)
    Lp = nb * blk
    scale = Dh ** -0.5

    def to_sub(t):
        return t.reshape(B, L, r, H, Dh).transpose(0, 2, 1, 3, 4)

    qs = jnp.pad(to_sub(q), ((0, 0), (0, 0), (0, Lp - L), (0, 0), (0, 0))).reshape(B, r, nb, blk, H, Dh)

    def windows(t):
        t = jnp.pad(to_sub(t), ((0, 0), (0, 0), (blk, Lp - L + blk), (0, 0), (0, 0))).reshape(B, r, nb + 2, blk, H, Dh)
        return jnp.concatenate([t[:, :, 0:nb], t[:, :, 1:nb + 1], t[:, :, 2:nb + 2]], axis=3)

    kw, vw = windows(k), windows(v)
    qi = jnp.arange(blk)
    kj = jnp.arange(3 * blk) - blk
    rel = kj[None, :] - qi[:, None]
    kpos = jnp.arange(nb)[:, None] * blk + kj[None, :]
    valid = (jnp.abs(rel) <= half)[None] & ((kpos >= 0) & (kpos < L))[:, None, :]
    bias = jnp.transpose(bias_tab[rel_bucket(rel * r)], (2, 0, 1)).astype(jnp.float32)
    s = jnp.einsum('brnqhd,brnkhd->brnhqk', qs, kw).astype(jnp.float32) * scale + bias
    s = jnp.where(valid[:, None], s, NEG_INF)
    lse = jax.nn.logsumexp(s, axis=-1)
    p = jnp.exp(s - lse[..., None])
    out = jnp.einsum('brnhqk,brnkhd->brnqhd', p.astype(v.dtype), vw)
    out = out.reshape(B, r, Lp, H, Dh)[:, :, :L].transpose(0, 2, 1, 3, 4).reshape(B, S, H, Dh)
    lse = lse.transpose(0, 1, 2, 4, 3).reshape(B, r, Lp, H)[:, :, :L].transpose(0, 2, 1, 3).reshape(B, S, H)
    return out, lse


def encoder_layer(x, c, layer_idx, rel_bias, norm1_g, w_ada, b_ada, w_in, qn_a, kn_a,
                  lambda_q1, lambda_k1, lambda_q2, lambda_k2, subln_g, qn_b, kn_b,
                  w_br_a, w_br_b, w_o, norm2_g, w_up, w_down):
    B, S, _ = x.shape
    mod = jax.nn.silu(c) @ w_ada + b_ada
    shift1, scale1, gate1, shift2, scale2, gate2 = [m[:, None, :] for m in jnp.split(mod, 6, axis=-1)]

    h = rms_norm(x, norm1_g) * (1 + scale1) + shift1
    proj = h @ w_in
    splits = []
    acc = 0
    for size in COL_SIZES[:-1]:
        acc += size
        splits.append(acc)
    parts = jnp.split(proj, splits, axis=-1)
    q1, q2, k1, k2, va = parts[:5]
    dil_parts = parts[5:5 + 3 * N_DIL]
    gate_a_logit, gate_b_logit = parts[5 + 3 * N_DIL], parts[6 + 3 * N_DIL]

    def qk_heads(t, g):
        return rms_norm(t.reshape(B, S, -1, HEAD_DIM), g)

    lam_init = 0.8 - 0.6 * math.exp(-0.3 * layer_idx)
    f32 = jnp.float32
    lam = (jnp.exp(jnp.sum(lambda_q1.astype(f32) * lambda_k1.astype(f32)))
           - jnp.exp(jnp.sum(lambda_q2.astype(f32) * lambda_k2.astype(f32))) + lam_init)
    tr = lambda t: t.transpose(0, 2, 1, 3)
    ya = diff_attention(tr(qk_heads(q1, qn_a)), tr(qk_heads(q2, qn_a)),
                        tr(qk_heads(k1, kn_a)), tr(qk_heads(k2, kn_a)),
                        tr(va.reshape(B, S, DA_HEADS, DA_VDIM)), rel_bias[:, :DA_HEADS], lam)
    ya = rms_norm(ya, subln_g) * (1 - lam_init)
    ya = ya.reshape(B, S, DA_V) @ w_br_a

    outs, lses = [], []
    for g, (window, dilation) in enumerate(DIL_CONFIG):
        qg = qk_heads(dil_parts[3 * g], qn_b[g])
        kg = qk_heads(dil_parts[3 * g + 1], kn_b[g])
        vg = dil_parts[3 * g + 2].reshape(B, S, DIL_HEADS, HEAD_DIM)
        tab = rel_bias[:, DA_HEADS + g * DIL_HEADS: DA_HEADS + (g + 1) * DIL_HEADS]
        o, l = dilated_window_attention(qg, kg, vg, tab, window, dilation)
        outs.append(o)
        lses.append(l)
    wts = jax.nn.softmax(jnp.stack(lses, axis=0), axis=0)
    yb = jnp.sum(wts[..., None] * jnp.stack(outs, axis=0).astype(f32), axis=0).astype(x.dtype)
    yb = yb.reshape(B, S, DIL_W) @ w_br_b

    merged = jax.nn.sigmoid(gate_a_logit) * ya + jax.nn.sigmoid(gate_b_logit) * yb
    x = x + gate1 * (merged @ w_o)

    h2 = rms_norm(x, norm2_g) * (1 + scale2) + shift2
    x = x + gate2 * (jnp.square(jax.nn.relu(h2 @ w_up)) @ w_down)
    return x


def trunk(x, c, rel_bias, norm1_g, w_ada, b_ada, w_in, qn_a, kn_a, lambda_q1, lambda_k1,
          lambda_q2, lambda_k2, subln_g, qn_b, kn_b, w_br_a, w_br_b, w_o, norm2_g, w_up, w_down):
    for l in range(DEPTH):
        x = encoder_layer(x, c, l, rel_bias, norm1_g[l], w_ada[l], b_ada[l], w_in[l], qn_a[l], kn_a[l],
                          lambda_q1[l], lambda_k1[l], lambda_q2[l], lambda_k2[l], subln_g[l],
                          qn_b[l], kn_b[l], w_br_a[l], w_br_b[l], w_o[l], norm2_g[l], w_up[l], w_down[l])
    return x


def setup_inputs(seed: int = 0) -> dict:
    key = jax.random.key(seed)
    ks = jax.random.split(key, 24)
    nrm = lambda k, shape, s: jax.random.normal(k, shape, jnp.float32) * s
    D = D_MODEL
    return {
        "x_prompt": nrm(ks[0], (BATCH, SEQ, D), 1.0),
        "x_sample": nrm(ks[1], (DEC_BATCH, DEC_SEQ, D), 1.0),
        "c_prompt": nrm(ks[2], (BATCH, D), 1.0),
        "c_sample": nrm(ks[3], (DEC_BATCH, D), 1.0),
        "rel_bias": nrm(ks[4], (N_BUCKETS, N_REL_HEADS), 0.5),
        "norm1_g": 1.0 + nrm(ks[5], (DEPTH, D), 0.02),
        "w_ada": nrm(ks[6], (DEPTH, D, 6 * D), 0.2 * D ** -0.5),
        "b_ada": nrm(ks[7], (DEPTH, 6 * D), 0.02),
        "w_in": nrm(ks[8], (DEPTH, D, IN_COLS), D ** -0.5),
        "qn_a": 1.0 + nrm(ks[9], (DEPTH, HEAD_DIM), 0.02),
        "kn_a": 1.0 + nrm(ks[10], (DEPTH, HEAD_DIM), 0.02),
        "lambda_q1": nrm(ks[11], (DEPTH, HEAD_DIM), 0.1),
        "lambda_k1": nrm(ks[12], (DEPTH, HEAD_DIM), 0.1),
        "lambda_q2": nrm(ks[13], (DEPTH, HEAD_DIM), 0.1),
        "lambda_k2": nrm(ks[14], (DEPTH, HEAD_DIM), 0.1),
        "subln_g": 1.0 + nrm(ks[15], (DEPTH, DA_VDIM), 0.02),
        "qn_b": 1.0 + nrm(ks[16], (DEPTH, N_DIL, HEAD_DIM), 0.02),
        "kn_b": 1.0 + nrm(ks[17], (DEPTH, N_DIL, HEAD_DIM), 0.02),
        "w_br_a": nrm(ks[18], (DEPTH, DA_V, D), DA_V ** -0.5),
        "w_br_b": nrm(ks[19], (DEPTH, DIL_W, D), DIL_W ** -0.5),
        "w_o": nrm(ks[20], (DEPTH, D, D), D ** -0.5),
        "norm2_g": 1.0 + nrm(ks[21], (DEPTH, D), 0.02),
        "w_up": nrm(ks[22], (DEPTH, D, D_FF), D ** -0.5),
        "w_down": nrm(ks[23], (DEPTH, D_FF, D), D_FF ** -0.5),
    }


def reference(x_prompt, x_sample, c_prompt, c_sample, rel_bias, norm1_g, w_ada, b_ada, w_in,
              qn_a, kn_a, lambda_q1, lambda_k1, lambda_q2, lambda_k2, subln_g, qn_b, kn_b,
              w_br_a, w_br_b, w_o, norm2_g, w_up, w_down):
    y_prompt = trunk(x_prompt, c_prompt, rel_bias, norm1_g, w_ada, b_ada, w_in, qn_a, kn_a,
                     lambda_q1, lambda_k1, lambda_q2, lambda_k2, subln_g, qn_b, kn_b,
                     w_br_a, w_br_b, w_o, norm2_g, w_up, w_down)
    y_sample = trunk(x_sample, c_sample, rel_bias, norm1_g, w_ada, b_ada, w_in, qn_a, kn_a,
                     lambda_q1, lambda_k1, lambda_q2, lambda_k2, subln_g, qn_b, kn_b,
                     w_br_a, w_br_b, w_o, norm2_g, w_up, w_down)
    return (y_prompt, y_sample)
```

```cpp
#include <hip/hip_runtime.h>
#include <hip/hip_cooperative_groups.h>
#include <cstdio>
#include <cstdint>
namespace cg = cooperative_groups;
namespace pg8 {
#define PG8_LAS __attribute__((address_space(3)))
typedef unsigned short bf16_t;
typedef short bf16x8 __attribute__((ext_vector_type(8)));
typedef float f32x4 __attribute__((ext_vector_type(4)));
typedef unsigned u32x4 __attribute__((ext_vector_type(4)));
constexpr int BM = 256, BK = 64, HALF = 128, HTB = HALF * BK * 2  , STAGE_BYTES = 8 * HTB, NXCD = 8, WGM = 8;

__host__ __device__ __forceinline__ int lds_byte(int r, int c) { const int st = (r >> 4) * 2 + (c >> 5), rr = r & 15, cc = c & 31, ob = rr * 64 + cc * 2; return st * 1024 + (ob ^ (((ob >> 9) & 1) << 5)); }
__host__ __device__ __forceinline__ void stage_rc(int b, int& R, int& C) { const int st = b / 1024, sb = b % 1024, swz = sb ^ (((sb >> 9) & 1) << 5); R = (st >> 1) * 16 + swz / 64; C = (st & 1) * 32 + (swz % 64) / 2; }
__host__ __device__ __forceinline__ int perm32(int rho) { const int n = rho >> 4, i = rho & 15; return 8 * (i >> 2) + 4 * n + (i & 3); }

struct Unit { int pm, pn; };
struct Gemm { const bf16_t* A; const bf16_t* Bt; int M, N, K; };

struct StaticOrder {
    int nM, nN, nwg, G, c;
    __host__ __device__ void init(int M, int N, int G_, int c_) { nM = M / BM; nN = N / BM; nwg = nM * nN; G = G_; c = c_; }
    __host__ __device__ bool next(int i, Unit& u) const {
        const long L = (long)i * G + c; if (L >= nwg) return false;
        int wgid = (int)L; { const int q = nwg / NXCD, r = nwg % NXCD, xcd = wgid % NXCD, off = wgid / NXCD; wgid = (xcd < r ? xcd * (q + 1) : r * (q + 1) + (xcd - r) * q) + off; }
        const int nig = WGM * nN, gid = wgid / nig, fm = gid * WGM, gsz = (nM - fm) < WGM ? (nM - fm) : WGM;
        u.pm = fm + ((wgid % nig) % gsz); u.pn = (wgid % nig) / gsz; return true;
    }
    __device__ __forceinline__ void a_ready(const Unit&) const {}
    __device__ __forceinline__ void done(const Unit&) const {}
};
__device__ __forceinline__ unsigned cvt_pk_bf16(float lo, float hi) { unsigned r; asm volatile("v_cvt_pk_bf16_f32 %0, %1, %2" : "=v"(r) : "v"(lo), "v"(hi)); return r; }
template <class Epi, class Sched, bool ALIGN_EPI = false, bool SP2 = false>
__device__ __forceinline__ void gemm_phase(PG8_LAS unsigned char* lds, const Gemm g, const Sched& S, const Epi& E) {
    int tid_ = threadIdx.x; asm volatile("" : "+v"(tid_));
    const int tid = tid_, wid = __builtin_amdgcn_readfirstlane(tid >> 6), lane = tid & 63, wr = wid >> 2, wc = wid & 3, fr = lane & 15, fq = lane >> 4;
    const int K = g.K, nt = K / BK;
    unsigned voffA[2], voffB[2];
#pragma unroll
    for (int i = 0; i < 2; ++i) { int R, C; stage_rc(tid * 16 + i * 8192, R, C); const int Rb = Epi::PERM ? ((R & ~31) + perm32(R & 31)) : R;
        voffA[i] = (unsigned)(R * K + C) * 2u; voffB[i] = (unsigned)(Rb * K + C) * 2u; }
    const size_t kstep = (size_t)(BK * 2);
    const size_t hstep = (size_t)HALF * K * 2;
    const size_t tstep = 2 * hstep;
    const unsigned ldsw = (unsigned)wid * 1024u;
    const int aoff = lds_byte(wr * 64 + fr, fq * 8), boff = lds_byte(wc * 32 + fr, fq * 8);
#define PG8_SA(b, h) (((b) * 2 + (h)) * HTB)
#define PG8_SB(b, h) ((4 + (b) * 2 + (h)) * HTB)
#define PG8_STAGE(bufoff, gbase, voff) do { _Pragma("unroll") for (int _i = 0; _i < 2; ++_i) \
        __builtin_amdgcn_global_load_lds((const unsigned*)((const char*)(gbase) + (voff)[_i]), (PG8_LAS unsigned*)(lds + (bufoff) + ldsw + _i * 8192), 16, 0, 0); } while (0)
#define PG8_LDA(dst, b, h) do { _Pragma("unroll") for (int m = 0; m < 4; ++m) _Pragma("unroll") for (int k = 0; k < 2; ++k) dst[m][k] = *(const PG8_LAS bf16x8*)(lds + PG8_SA(b, h) + aoff + m * 2048 + k * 1024); } while (0)
#define PG8_LDB(dst, b, h) do { _Pragma("unroll") for (int n = 0; n < 2; ++n) _Pragma("unroll") for (int k = 0; k < 2; ++k) dst[n][k] = *(const PG8_LAS bf16x8*)(lds + PG8_SB(b, h) + boff + n * 2048 + k * 1024); } while (0)
#define PG8_MMA(ai, bj, At, Bt) do { __builtin_amdgcn_s_setprio(1); _Pragma("unroll") for (int m = 0; m < 4; ++m) _Pragma("unroll") for (int n = 0; n < 2; ++n) _Pragma("unroll") for (int k = 0; k < 2; ++k) \
        acc[ai][bj][m][n] = __builtin_amdgcn_mfma_f32_16x16x32_bf16(Bt[n][k], At[m][k], acc[ai][bj][m][n], 0, 0, 0); __builtin_amdgcn_s_setprio(0); } while (0)
#define PG8_WAIT_V(n) asm volatile("s_waitcnt vmcnt(" #n ")" ::: "memory")
#define PG8_WAIT_L(n) asm volatile("s_waitcnt lgkmcnt(" #n ")" ::: "memory")
#define PG8_BAR __builtin_amdgcn_s_barrier()
#define PG8_SCHED __builtin_amdgcn_sched_barrier(0)
    Unit cur, nxt; int ui = 0;
    if (!S.next(0, cur)) return;
    f32x4 acc[2][2][4][2];
#pragma unroll
    for (int a = 0; a < 2; ++a)
#pragma unroll
        for (int b = 0; b < 2; ++b)
#pragma unroll
            for (int m = 0; m < 4; ++m)
#pragma unroll
                for (int n = 0; n < 2; ++n) acc[a][b][m][n] = (f32x4){0.f, 0.f, 0.f, 0.f};
    bf16x8 At[4][2], B0[2][2], B1[2][2];
    const char* cA = (const char*)g.A + (size_t)cur.pm * tstep; const char* cB = (const char*)g.Bt + (size_t)cur.pn * tstep;
    S.a_ready(cur);
    if constexpr (SP2) {
        PG8_STAGE(PG8_SB(0, 0), cB, voffB); PG8_STAGE(PG8_SB(0, 1), cB + hstep, voffB); PG8_STAGE(PG8_SA(0, 0), cA, voffA); PG8_STAGE(PG8_SA(0, 1), cA + hstep, voffA);
        if (wr == 1) PG8_BAR;
        PG8_WAIT_V(2); PG8_BAR;
        PG8_STAGE(PG8_SB(1, 0), cB + kstep, voffB); PG8_STAGE(PG8_SA(1, 0), cA + kstep, voffA); PG8_STAGE(PG8_SB(1, 1), cB + hstep + kstep, voffB);
        PG8_WAIT_V(6); PG8_BAR;
    } else {
        PG8_STAGE(PG8_SB(0, 0), cB, voffB); PG8_STAGE(PG8_SA(0, 0), cA, voffA); PG8_STAGE(PG8_SB(0, 1), cB + hstep, voffB); PG8_STAGE(PG8_SA(0, 1), cA + hstep, voffA);
        if (wr == 1) PG8_BAR;
        PG8_WAIT_V(4); PG8_BAR;
        PG8_STAGE(PG8_SB(1, 0), cB + kstep, voffB); PG8_STAGE(PG8_SA(1, 0), cA + kstep, voffA); PG8_STAGE(PG8_SB(1, 1), cB + hstep + kstep, voffB);
        PG8_WAIT_V(6); PG8_BAR;
    }
    for (;;) {
        const bool has_next = S.next(ui + 1, nxt);
        const char* nA = has_next ? (const char*)g.A + (size_t)nxt.pm * tstep : cA; const char* nB = has_next ? (const char*)g.Bt + (size_t)nxt.pn * tstep : cB;
        for (int t = 0; t < nt; t += 2) {
            const bool last = (t == nt - 2);
            const char* a1 = cA + (size_t)(t + 1) * kstep;
            const char* a2 = last ? nA : cA + (size_t)(t + 2) * kstep; const char* b2 = last ? nB : cB + (size_t)(t + 2) * kstep;
            const char* a3 = a2 + kstep; const char* b3 = b2 + kstep;
            if (last && has_next) S.a_ready(nxt);
            if constexpr (SP2) {
            PG8_LDB(B0, 0, 0); PG8_LDB(B1, 0, 1); PG8_SCHED; PG8_LDA(At, 0, 0); PG8_STAGE(PG8_SA(1, 1), a1 + hstep, voffA);
            PG8_WAIT_V(8); PG8_WAIT_L(0); PG8_BAR; PG8_MMA(0, 0, At, B0); PG8_MMA(0, 1, At, B1); PG8_BAR; PG8_SCHED;
            PG8_LDA(At, 0, 1); PG8_STAGE(PG8_SB(0, 0), b2, voffB); PG8_STAGE(PG8_SB(0, 1), b2 + hstep, voffB); PG8_STAGE(PG8_SA(0, 0), a2, voffA);
            PG8_WAIT_V(8); PG8_WAIT_L(0); PG8_BAR; PG8_MMA(1, 0, At, B0); PG8_MMA(1, 1, At, B1); PG8_BAR; PG8_SCHED;
            PG8_LDB(B0, 1, 0); PG8_LDB(B1, 1, 1); PG8_SCHED; PG8_LDA(At, 1, 0); PG8_STAGE(PG8_SA(0, 1), a2 + hstep, voffA);
            PG8_WAIT_V(8); PG8_WAIT_L(0); PG8_BAR; PG8_MMA(0, 0, At, B0); PG8_MMA(0, 1, At, B1); PG8_BAR; PG8_SCHED;
            PG8_LDA(At, 1, 1); PG8_STAGE(PG8_SB(1, 0), b3, voffB); PG8_STAGE(PG8_SB(1, 1), b3 + hstep, voffB); PG8_STAGE(PG8_SA(1, 0), a3, voffA);
            PG8_WAIT_V(8); PG8_WAIT_L(0); PG8_BAR; PG8_MMA(1, 0, At, B0); PG8_MMA(1, 1, At, B1); PG8_BAR; PG8_SCHED;
            } else {
            PG8_LDB(B0, 0, 0); PG8_SCHED; PG8_LDA(At, 0, 0); PG8_STAGE(PG8_SA(1, 1), a1 + hstep, voffA);
            PG8_WAIT_L(8); PG8_BAR; PG8_WAIT_L(0); PG8_MMA(0, 0, At, B0); PG8_BAR; PG8_SCHED;
            PG8_LDB(B1, 0, 1); PG8_STAGE(PG8_SB(0, 0), b2, voffB);
            PG8_BAR; PG8_WAIT_L(0); PG8_MMA(0, 1, At, B1); PG8_BAR;
            PG8_LDA(At, 0, 1); PG8_STAGE(PG8_SA(0, 0), a2, voffA);
            PG8_BAR; PG8_WAIT_L(0); PG8_MMA(1, 0, At, B0); PG8_BAR; PG8_SCHED;
            PG8_STAGE(PG8_SB(0, 1), b2 + hstep, voffB);
            PG8_WAIT_V(6); PG8_BAR; PG8_MMA(1, 1, At, B1); PG8_BAR;
            PG8_LDB(B0, 1, 0); PG8_SCHED; PG8_LDA(At, 1, 0); PG8_STAGE(PG8_SA(0, 1), a2 + hstep, voffA);
            PG8_WAIT_L(8); PG8_BAR; PG8_WAIT_L(0); PG8_MMA(0, 0, At, B0); PG8_BAR; PG8_SCHED;
            PG8_LDB(B1, 1, 1); PG8_STAGE(PG8_SB(1, 0), b3, voffB);
            PG8_BAR; PG8_WAIT_L(0); PG8_MMA(0, 1, At, B1); PG8_BAR;
            PG8_LDA(At, 1, 1); PG8_STAGE(PG8_SA(1, 0), a3, voffA);
            PG8_BAR; PG8_WAIT_L(0); PG8_MMA(1, 0, At, B0); PG8_BAR; PG8_SCHED;
            PG8_STAGE(PG8_SB(1, 1), b3 + hstep, voffB);
            PG8_WAIT_V(6); PG8_BAR; PG8_MMA(1, 1, At, B1); PG8_BAR;
            }
        }
        if constexpr (ALIGN_EPI) { if (wr == 0) PG8_BAR; }
        if constexpr (!Epi::AFTER_DRAIN) { E(acc, cur, wr, wc, fr, fq); S.done(cur); }
        if (!has_next) break;
#pragma unroll
        for (int a = 0; a < 2; ++a)
#pragma unroll
            for (int b = 0; b < 2; ++b)
#pragma unroll
                for (int m = 0; m < 4; ++m)
#pragma unroll
                    for (int n = 0; n < 2; ++n) acc[a][b][m][n] = (f32x4){0.f, 0.f, 0.f, 0.f};
        cur = nxt; cA = nA; cB = nB; ++ui;
        if constexpr (ALIGN_EPI) { if (wr == 1) PG8_BAR; }
    }
    PG8_WAIT_V(0);
    if constexpr (!ALIGN_EPI) { if (wr == 0) PG8_BAR; }
    PG8_BAR;
    if constexpr (Epi::AFTER_DRAIN) { E.fused(acc, cur, wr, wc, fr, fq, lds, wid, lane); S.done(cur); }
#undef PG8_SA
#undef PG8_SB
#undef PG8_STAGE
#undef PG8_LDA
#undef PG8_LDB
#undef PG8_MMA
#undef PG8_WAIT_V
#undef PG8_WAIT_L
#undef PG8_BAR
#undef PG8_SCHED
}
constexpr int CH = 16384;
constexpr float C2Q = 0.125f * 1.4426950408889634f;
__device__ __forceinline__ u32x4 pack8(const f32x4& a, const f32x4& b) { u32x4 w; w.x = cvt_pk_bf16(a[0], a[1]); w.y = cvt_pk_bf16(a[2], a[3]); w.z = cvt_pk_bf16(b[0], b[1]); w.w = cvt_pk_bf16(b[2], b[3]); return w; }
__device__ __forceinline__ f32x4 bf4lo(const u32x4& w) { return (f32x4){__uint_as_float(w.x << 16), __uint_as_float(w.x & 0xffff0000u), __uint_as_float(w.y << 16), __uint_as_float(w.y & 0xffff0000u)}; }
__device__ __forceinline__ f32x4 bf4hi(const u32x4& w) { return (f32x4){__uint_as_float(w.z << 16), __uint_as_float(w.z & 0xffff0000u), __uint_as_float(w.w << 16), __uint_as_float(w.w & 0xffff0000u)}; }
__device__ __forceinline__ int batch_of(int m) { return m < 16384 ? (m >> 12) : 4 + ((m - 16384) >> 13); }

struct EpiProj {
    static constexpr bool PERM = true, AFTER_DRAIN = false;
    bf16_t *QK, *VA, *DIL, *GT; const float *qn_a, *kn_a, *qn_b, *kn_b; int S, lgS;
    __device__ __forceinline__ void operator()(const f32x4 (&acc)[2][2][4][2], const Unit& u, int wr, int wc, int fr, int fq) const {
        const int pn = u.pn, lrb = u.pm * BM + wr * 64 + fr;
        int kind, lgr = 0; bf16_t* dst; const float* gain = nullptr; float sc = 1.f;
        if (pn < 8) { const int which = pn >> 1, head = (pn & 1) * 4 + wc; kind = 0; gain = which < 2 ? qn_a : kn_a; sc = which < 2 ? C2Q : 1.f; dst = QK + (size_t)(which * 8 + head) * ((size_t)CH * 64); }
        else if (pn < 12) { const int head = (pn - 8) * 2 + (wc >> 1); kind = 1; dst = VA + (size_t)head * ((size_t)CH * 128) + (2 * (wc & 1)) * 2048 + 8 * fq; }
        else if (pn < 30) { const int idx = pn - 12, g = idx / 6, part = (idx % 6) >> 1, head = (idx & 1) * 4 + wc; lgr = 2 * g;
            dst = DIL + (size_t)((g * 3 + part) * 8 + head) * ((size_t)CH * 64);
            if (part < 2) { kind = 0; gain = (part == 0 ? qn_b : kn_b) + 64 * g; sc = part == 0 ? C2Q : 1.f; } else { kind = 2; dst += 8 * fq; } }
        else { const int which = (pn - 30) >> 2; kind = 3; dst = GT + (size_t)which * ((size_t)CH * 1024) + ((pn - 30) & 3) * 256 + 64 * wc + 8 * fq; }
        const int Sm = S - 1, rm = (1 << lgr) - 1, lsh = lgS - lgr;
        if (kind == 0) {
            f32x4 gv[2][2];
#pragma unroll
            for (int bj = 0; bj < 2; ++bj)
#pragma unroll
                for (int n = 0; n < 2; ++n) gv[bj][n] = *(const f32x4*)(gain + 32 * bj + 8 * fq + 4 * n) * sc;
#pragma unroll
            for (int ai = 0; ai < 2; ++ai)
#pragma unroll
                for (int m = 0; m < 4; ++m) {
                    const int lr = lrb + ai * HALF + m * 16, t = lr & Sm, dr = (lr & ~Sm) + ((t & rm) << lsh) + (t >> lgr);
                    float ss = 0.f;
#pragma unroll
                    for (int bj = 0; bj < 2; ++bj)
#pragma unroll
                        for (int n = 0; n < 2; ++n) { const f32x4 x = acc[ai][bj][m][n]; ss += (x[0] * x[0] + x[1] * x[1]) + (x[2] * x[2] + x[3] * x[3]); }
                    ss += __shfl_xor(ss, 16); ss += __shfl_xor(ss, 32);
                    const float rs = __builtin_amdgcn_rsqf(ss * (1.0f / 64.0f) + 1e-6f);
                    bf16_t* rowp = dst + (size_t)(dr >> 6) * 4096 + fq * 512 + (dr & 63) * 8;
#pragma unroll
                    for (int bj = 0; bj < 2; ++bj) *(u32x4*)(rowp + bj * 2048) = pack8(acc[ai][bj][m][0] * rs * gv[bj][0], acc[ai][bj][m][1] * rs * gv[bj][1]);
                }
        } else if (kind == 1) {
#pragma unroll
            for (int ai = 0; ai < 2; ++ai)
#pragma unroll
                for (int m = 0; m < 4; ++m) {
                    const int lr = lrb + ai * HALF + m * 16;
                    bf16_t* rowp = dst + (size_t)(lr >> 6) * 8192 + ((lr & 63) >> 4) * 512 + (lr & 15) * 32;
#pragma unroll
                    for (int bj = 0; bj < 2; ++bj) *(u32x4*)(rowp + bj * 2048) = pack8(acc[ai][bj][m][0], acc[ai][bj][m][1]);
                }
        } else if (kind == 2) {
#pragma unroll
            for (int ai = 0; ai < 2; ++ai)
#pragma unroll
                for (int m = 0; m < 4; ++m) {
                    const int lr = lrb + ai * HALF + m * 16, t = lr & Sm, dr = (lr & ~Sm) + ((t & rm) << lsh) + (t >> lgr);
                    bf16_t* rowp = dst + (size_t)dr * 64;
#pragma unroll
                    for (int bj = 0; bj < 2; ++bj) *(u32x4*)(rowp + bj * 32) = pack8(acc[ai][bj][m][0], acc[ai][bj][m][1]);
                }
        } else {
#pragma unroll
            for (int ai = 0; ai < 2; ++ai)
#pragma unroll
                for (int m = 0; m < 4; ++m) {
                    const int lr = lrb + ai * HALF + m * 16;
                    bf16_t* rowp = dst + (size_t)lr * 1024;
#pragma unroll
                    for (int bj = 0; bj < 2; ++bj) { f32x4 v0 = acc[ai][bj][m][0], v1 = acc[ai][bj][m][1];
#pragma unroll
                        for (int i = 0; i < 4; ++i) { v0[i] = __builtin_amdgcn_rcpf(1.0f + __builtin_amdgcn_exp2f(-1.4426950408889634f * v0[i])); v1[i] = __builtin_amdgcn_rcpf(1.0f + __builtin_amdgcn_exp2f(-1.4426950408889634f * v1[i])); }
                        *(u32x4*)(rowp + bj * 32) = pack8(v0, v1); }
                }
        }
    }
};
template <bool ADD> struct EpiBr {
    static constexpr bool PERM = true, AFTER_DRAIN = false;
    bf16_t* MG; const bf16_t* G;
    __device__ __forceinline__ void operator()(const f32x4 (&acc)[2][2][4][2], const Unit& u, int wr, int wc, int fr, int fq) const {
        const int row0 = u.pm * BM + wr * 64 + fr, col0 = u.pn * BM + wc * 32 + 8 * fq;
#pragma unroll
        for (int ai = 0; ai < 2; ++ai)
#pragma unroll
            for (int m = 0; m < 4; ++m) { const size_t off = (size_t)(row0 + ai * HALF + m * 16) * 1024 + col0;
#pragma unroll
                for (int bj = 0; bj < 2; ++bj) { const u32x4 gw = *(const u32x4*)(G + off + bj * HALF);
                    f32x4 v0 = acc[ai][bj][m][0] * bf4lo(gw), v1 = acc[ai][bj][m][1] * bf4hi(gw);
                    if (ADD) { const u32x4 tw = *(const u32x4*)(MG + off + bj * HALF); v0 += bf4lo(tw); v1 += bf4hi(tw); }
                    *(u32x4*)(MG + off + bj * HALF) = pack8(v0, v1); } }
    }
};
struct EpiWo {
    static constexpr bool PERM = true, AFTER_DRAIN = false;
    const float *xp, *xs; float* out; bf16_t* A2; const float *mod, *n2g; float* rowss;
    __device__ __forceinline__ void operator()(const f32x4 (&acc)[2][2][4][2], const Unit& u, int wr, int wc, int fr, int fq) const {
        const int m0 = u.pm * BM, b = batch_of(m0), row0 = m0 + wr * 64 + fr, col0 = u.pn * BM + wc * 32 + 8 * fq;
        const float* xb = m0 < 16384 ? xp : xs - (size_t)16384 * 1024;
        const float* g1p = mod + b * 6144 + 2048 + col0; const float* s2p = mod + b * 6144 + 4096 + col0; const float* ngp = n2g + col0;
        f32x4 g1[2][2], gm[2][2];
#pragma unroll
        for (int bj = 0; bj < 2; ++bj)
#pragma unroll
            for (int n = 0; n < 2; ++n) { g1[bj][n] = *(const f32x4*)(g1p + bj * HALF + 4 * n); gm[bj][n] = *(const f32x4*)(ngp + bj * HALF + 4 * n) * (*(const f32x4*)(s2p + bj * HALF + 4 * n) + 1.0f); }
#pragma unroll
        for (int ai = 0; ai < 2; ++ai)
#pragma unroll
            for (int m = 0; m < 4; ++m) { const int r = row0 + ai * HALF + m * 16; const size_t off = (size_t)r * 1024 + col0; float ss = 0.f;
#pragma unroll
                for (int bj = 0; bj < 2; ++bj) {
                    const f32x4 y0 = *(const f32x4*)(xb + off + bj * HALF) + g1[bj][0] * acc[ai][bj][m][0], y1 = *(const f32x4*)(xb + off + bj * HALF + 4) + g1[bj][1] * acc[ai][bj][m][1];
                    *(f32x4*)(out + off + bj * HALF) = y0; *(f32x4*)(out + off + bj * HALF + 4) = y1;
                    ss += (y0[0] * y0[0] + y0[1] * y0[1]) + (y0[2] * y0[2] + y0[3] * y0[3]) + (y1[0] * y1[0] + y1[1] * y1[1]) + (y1[2] * y1[2] + y1[3] * y1[3]);
                    *(u32x4*)(A2 + off + bj * HALF) = pack8(y0 * gm[bj][0], y1 * gm[bj][1]); }
                ss += __shfl_xor(ss, 16); ss += __shfl_xor(ss, 32);
                if (fq == 0) atomicAdd(rowss + r, ss); }
    }
};
struct EpiUp {
    static constexpr bool PERM = true, AFTER_DRAIN = false;
    bf16_t* H; const float *rowss, *sbias;
    __device__ __forceinline__ void operator()(const f32x4 (&acc)[2][2][4][2], const Unit& u, int wr, int wc, int fr, int fq) const {
        const int m0 = u.pm * BM, b = batch_of(m0), row0 = m0 + wr * 64 + fr, col0 = u.pn * BM + wc * 32 + 8 * fq;
        f32x4 sb[2][2];
#pragma unroll
        for (int bj = 0; bj < 2; ++bj)
#pragma unroll
            for (int n = 0; n < 2; ++n) sb[bj][n] = *(const f32x4*)(sbias + b * 4096 + col0 + bj * HALF + 4 * n);
#pragma unroll
        for (int ai = 0; ai < 2; ++ai)
#pragma unroll
            for (int m = 0; m < 4; ++m) { const int r = row0 + ai * HALF + m * 16; const float rs = __builtin_amdgcn_rsqf(rowss[r] * (1.0f / 1024.0f) + 1e-6f);
                bf16_t* rowp = H + (size_t)r * 4096 + col0;
#pragma unroll
                for (int bj = 0; bj < 2; ++bj) { f32x4 v0 = acc[ai][bj][m][0] * rs + sb[bj][0], v1 = acc[ai][bj][m][1] * rs + sb[bj][1];
#pragma unroll
                    for (int i = 0; i < 4; ++i) { v0[i] = fmaxf(v0[i], 0.f); v1[i] = fmaxf(v1[i], 0.f); }
                    *(u32x4*)(rowp + bj * HALF) = pack8(v0 * v0, v1 * v1); } }
    }
};
struct EpiDown {
    static constexpr bool PERM = true, AFTER_DRAIN = false;
    float* out; const float* mod;
    __device__ __forceinline__ void operator()(const f32x4 (&acc)[2][2][4][2], const Unit& u, int wr, int wc, int fr, int fq) const {
        const int m0 = u.pm * BM, b = batch_of(m0), row0 = m0 + wr * 64 + fr, col0 = u.pn * BM + wc * 32 + 8 * fq;
        const float* g2p = mod + b * 6144 + 5120 + col0;
        f32x4 g2[2][2];
#pragma unroll
        for (int bj = 0; bj < 2; ++bj)
#pragma unroll
            for (int n = 0; n < 2; ++n) g2[bj][n] = *(const f32x4*)(g2p + bj * HALF + 4 * n);
#pragma unroll
        for (int ai = 0; ai < 2; ++ai)
#pragma unroll
            for (int m = 0; m < 4; ++m) { float* rowp = out + (size_t)(row0 + ai * HALF + m * 16) * 1024 + col0;
#pragma unroll
                for (int bj = 0; bj < 2; ++bj) { *(f32x4*)(rowp + bj * HALF) = *(const f32x4*)(rowp + bj * HALF) + g2[bj][0] * acc[ai][bj][m][0]; *(f32x4*)(rowp + bj * HALF + 4) = *(const f32x4*)(rowp + bj * HALF + 4) + g2[bj][1] * acc[ai][bj][m][1]; } }
    }
};
}
namespace att {
#define LASC __attribute__((address_space(3)))
typedef unsigned short bf16;
typedef short bf16x8 __attribute__((ext_vector_type(8)));
typedef short s16x4 __attribute__((ext_vector_type(4)));
typedef short v4i16_t __attribute__((ext_vector_type(4)));
typedef float f32x16 __attribute__((ext_vector_type(16)));
typedef float f32x4 __attribute__((ext_vector_type(4)));
typedef unsigned u32x4 __attribute__((ext_vector_type(4)));
typedef float f32x2_t __attribute__((ext_vector_type(2))); typedef __bf16 bf16x2_t __attribute__((ext_vector_type(2)));
constexpr int CH = 16384;
constexpr float LOG2E = 1.4426950408889634f;
__device__ __forceinline__ int crow(int r, int hi) { return (r & 3) + 8 * (r >> 2) + 4 * hi; }
__device__ __forceinline__ unsigned cvtpk(float lo, float hi) { f32x2_t v = {lo, hi}; bf16x2_t b = __builtin_convertvector(v, bf16x2_t); return __builtin_bit_cast(unsigned, b); }
__device__ __forceinline__ s16x4 vtr(const LASC unsigned char* p) { return __builtin_bit_cast(s16x4, __builtin_amdgcn_ds_read_tr16_b64_v4i16((LASC v4i16_t*)p)); }
#ifndef BK_SH
#define BK_SH 0
#endif
__device__ __forceinline__ int rel_bucket(int rel) {
    const int n = rel < 0 ? -rel : rel; const int ret = rel > 0 ? 16 : 0;
    int v;
    if (n < 8) v = n; else if (n < 12) v = 8; else if (n < 16 + BK_SH) v = 9; else if (n < 23) v = 10; else if (n < 32 + BK_SH) v = 11; else if (n < 46) v = 12; else if (n < 64 + BK_SH) v = 13; else if (n < 91) v = 14; else v = 15;
    return ret + v;
}
__device__ __forceinline__ bf16x8 pack_frag(const f32x16& p, int base) {
    u32x4 w; w.x = cvtpk(p[base], p[base + 1]); w.y = cvtpk(p[base + 2], p[base + 3]); w.z = cvtpk(p[base + 4], p[base + 5]); w.w = cvtpk(p[base + 6], p[base + 7]);
    return __builtin_bit_cast(bf16x8, w);
}
constexpr int DA_BUF = 32768;
constexpr int DA_BT = 65536;
constexpr int DA_WS = 65536 + 2048;
constexpr int DA_Q = 65536 + 2048 + 4096;
constexpr int SC_OFF = 139264;
constexpr int DL_N = 0, DL_D = 131072, DL_T = 131072 + 2048;

__device__ __forceinline__ void da_epilogue(LASC unsigned char* lds, bf16* YA, const float* subln_g, f32x16 (&o1)[4], f32x16 (&o2)[4], float l1, float l2, float lam, int head, int tile0, int qb, int tid_in);
__device__ __forceinline__ void da_unit(LASC unsigned char* lds, const bf16* QK, const bf16* VA, bf16* YA, const float* rel_bias, const float* subln_g,
                                        int head, int tile0, int NT, int qb, int tid_in) {
    int tid = tid_in; asm volatile("" : "+v"(tid));
    const int lane = tid & 63, r32 = lane & 31, hi = lane >> 5; const int wid = __builtin_amdgcn_readfirstlane(tid >> 6);
    LASC float* BT = (LASC float*)(lds + DA_BT); LASC float* wsf = (LASC float*)(lds + DA_WS) + wid * 128; const LASC float* SC = (const LASC float*)(lds + SC_OFF);
    const float lam = SC[0], M2 = SC[1];
    if (tid < 257) { const int rel = tid - 128; BT[tid] = rel_bias[rel_bucket(rel) * 32 + head] * LOG2E - M2; }
    const bf16* Q1h = QK + (size_t)(0 * 8 + head) * ((size_t)CH * 64); const bf16* Q2h = QK + (size_t)(1 * 8 + head) * ((size_t)CH * 64);
    const bf16* K1h = QK + (size_t)(2 * 8 + head) * ((size_t)CH * 64) + (size_t)tile0 * 4096; const bf16* K2h = QK + (size_t)(3 * 8 + head) * ((size_t)CH * 64) + (size_t)tile0 * 4096;
    const bf16* Vh = VA + (size_t)head * ((size_t)CH * 128) + (size_t)tile0 * 8192;
#define DA_DMA(t, b) do { const size_t e_ = (size_t)wid * 512 + lane * 8; LASC unsigned char* d_ = lds + (b) * DA_BUF + wid * 1024; \
        __builtin_amdgcn_global_load_lds((const unsigned*)(K1h + (size_t)(t) * 4096 + e_), (LASC unsigned*)(d_), 16, 0, 0); \
        __builtin_amdgcn_global_load_lds((const unsigned*)(K2h + (size_t)(t) * 4096 + e_), (LASC unsigned*)(d_ + 8192), 16, 0, 0); \
        __builtin_amdgcn_global_load_lds((const unsigned*)(Vh + (size_t)(t) * 8192 + e_), (LASC unsigned*)(d_ + 16384), 16, 0, 0); \
        __builtin_amdgcn_global_load_lds((const unsigned*)(Vh + (size_t)(t) * 8192 + 4096 + e_), (LASC unsigned*)(d_ + 24576), 16, 0, 0); } while (0)
    DA_DMA(0, 0);
    LASC unsigned char* qlds = lds + DA_Q + wid * 8192 + lane * 16;
    { const int tq = tile0 + 4 * qb + (wid >> 1), rq = (wid & 1) * 32 + r32;
#pragma unroll
      for (int ks = 0; ks < 4; ++ks) { *(LASC bf16x8*)(qlds + ks * 1024) = *(const bf16x8*)(Q1h + (size_t)tq * 4096 + (2 * ks + hi) * 512 + rq * 8);
                                       *(LASC bf16x8*)(qlds + 4096 + ks * 1024) = *(const bf16x8*)(Q2h + (size_t)tq * 4096 + (2 * ks + hi) * 512 + rq * 8); } }
    f32x16 o1[4], o2[4];
#pragma unroll
    for (int d = 0; d < 4; ++d) { o1[d] = f32x16{}; o2[d] = f32x16{}; }
    float l1 = 0.f, l2 = 0.f;
    asm volatile("s_waitcnt vmcnt(0)" ::: "memory");
    __syncthreads();
    const float cL = BT[0], cR = BT[256];
    const int qw0 = 256 * qb + 32 * wid;
    const int vboff = ((lane >> 4) & 1) * 32 + (lane & 3) * 8 + (4 * hi + ((lane & 15) >> 2)) * 64;
#define DA_BIAS(p0, p1) do { if (kt0 - (qw0 + 31) >= 128) { _Pragma("unroll") for (int r = 0; r < 16; ++r) { p0[r] = cR; p1[r] = cR; } } \
        else if (qw0 - (kt0 + 63) >= 128) { _Pragma("unroll") for (int r = 0; r < 16; ++r) { p0[r] = cL; p1[r] = cL; } } \
        else { const int relb = kt0 - (qw0 + r32) + 4 * hi; \
            _Pragma("unroll") for (int r = 0; r < 16; ++r) { const int rel = relb + (r & 3) + 8 * (r >> 2); const int i0 = min(max(rel, -128), 128) + 128, i1 = min(max(rel + 32, -128), 128) + 128; p0[r] = BT[i0]; p1[r] = BT[i1]; } } } while (0)
    for (int t = 0; t < NT; ++t) {
        if (t + 1 < NT) DA_DMA(t + 1, (t + 1) & 1);
        const LASC unsigned char* cur = lds + (t & 1) * DA_BUF;
        const int kt0 = 64 * t;
        bf16x8 pa1[4], pa2[4];
        {
            f32x16 p0, p1; DA_BIAS(p0, p1); const LASC unsigned char* kb = cur + hi * 1024 + r32 * 16;
#pragma unroll
            for (int ks = 0; ks < 4; ++ks) { const bf16x8 k0 = *(const LASC bf16x8*)(kb + ks * 2048), k1 = *(const LASC bf16x8*)(kb + ks * 2048 + 512);
                const bf16x8 qf = *(const LASC bf16x8*)(qlds + ks * 1024);
                p0 = __builtin_amdgcn_mfma_f32_32x32x16_bf16(k0, qf, p0, 0, 0, 0); p1 = __builtin_amdgcn_mfma_f32_32x32x16_bf16(k1, qf, p1, 0, 0, 0); }
            float s = 0.f;
#pragma unroll
            for (int r = 0; r < 16; ++r) { p0[r] = __builtin_amdgcn_exp2f(p0[r]); p1[r] = __builtin_amdgcn_exp2f(p1[r]); s += p0[r] + p1[r]; }
            l1 += s;
            pa1[0] = pack_frag(p0, 0); pa1[1] = pack_frag(p0, 8); pa1[2] = pack_frag(p1, 0); pa1[3] = pack_frag(p1, 8);
        }
        __builtin_amdgcn_sched_barrier(0);
        {
            f32x16 p0, p1; DA_BIAS(p0, p1); const LASC unsigned char* kb = cur + 8192 + hi * 1024 + r32 * 16;
#pragma unroll
            for (int ks = 0; ks < 4; ++ks) { const bf16x8 k0 = *(const LASC bf16x8*)(kb + ks * 2048), k1 = *(const LASC bf16x8*)(kb + ks * 2048 + 512);
                const bf16x8 qf = *(const LASC bf16x8*)(qlds + 4096 + ks * 1024);
                p0 = __builtin_amdgcn_mfma_f32_32x32x16_bf16(k0, qf, p0, 0, 0, 0); p1 = __builtin_amdgcn_mfma_f32_32x32x16_bf16(k1, qf, p1, 0, 0, 0); }
            float s = 0.f;
#pragma unroll
            for (int r = 0; r < 16; ++r) { p0[r] = __builtin_amdgcn_exp2f(p0[r]); p1[r] = __builtin_amdgcn_exp2f(p1[r]); s += p0[r] + p1[r]; }
            l2 += s;
            pa2[0] = pack_frag(p0, 0); pa2[1] = pack_frag(p0, 8); pa2[2] = pack_frag(p1, 0); pa2[3] = pack_frag(p1, 8);
        }
        __builtin_amdgcn_sched_barrier(0);
        {
            const LASC unsigned char* vp = cur + 16384 + vboff;
#pragma unroll
            for (int d0 = 0; d0 < 4; ++d0) {
                bf16x8 vf[4];
#pragma unroll
                for (int ks = 0; ks < 4; ++ks) { const s16x4 lo = vtr(vp + d0 * 4096 + ks * 1024), hh = vtr(vp + d0 * 4096 + ks * 1024 + 512); vf[ks] = (bf16x8){lo[0], lo[1], lo[2], lo[3], hh[0], hh[1], hh[2], hh[3]}; }
#pragma unroll
                for (int ks = 0; ks < 4; ++ks) { o1[d0] = __builtin_amdgcn_mfma_f32_32x32x16_bf16(pa1[ks], vf[ks], o1[d0], 0, 0, 0); o2[d0] = __builtin_amdgcn_mfma_f32_32x32x16_bf16(pa2[ks], vf[ks], o2[d0], 0, 0, 0); }
                __builtin_amdgcn_sched_barrier(0);
            }
        }
        asm volatile("s_waitcnt vmcnt(0)" ::: "memory");
        __syncthreads();
    }
#undef DA_DMA
#undef DA_BIAS
    da_epilogue(lds, YA, subln_g, o1, o2, l1, l2, lam, head, tile0, qb, tid);
}
__device__ __forceinline__ void da_epilogue(LASC unsigned char* lds, bf16* YA, const float* subln_g, f32x16 (&o1)[4], f32x16 (&o2)[4], float l1, float l2, float lam, int head, int tile0, int qb, int tid_in) {
    int tid = tid_in; asm volatile("" : "+v"(tid));
    const int lane = tid & 63, r32 = lane & 31, hi = lane >> 5; const int wid = __builtin_amdgcn_readfirstlane(tid >> 6);
    LASC float* wsf = (LASC float*)(lds + DA_WS) + wid * 128;
    l1 += __shfl_xor(l1, 32); l2 += __shfl_xor(l2, 32);
    if (hi == 0) { wsf[r32] = l1; wsf[32 + r32] = l2; }
    asm volatile("s_waitcnt lgkmcnt(0)" ::: "memory");
    float sg[4];
#pragma unroll
    for (int d0 = 0; d0 < 4; ++d0) sg[d0] = subln_g[32 * d0 + r32] * 0.8f;
    LASC bf16* stg = (LASC bf16*)(lds + wid * 8192);
#pragma unroll
    for (int r = 0; r < 16; ++r) {
        const int row = crow(r, hi); const float i1 = __builtin_amdgcn_rcpf(wsf[row]), i2 = lam * __builtin_amdgcn_rcpf(wsf[32 + row]);
        float v[4]; float ss = 0.f;
#pragma unroll
        for (int d0 = 0; d0 < 4; ++d0) { v[d0] = o1[d0][r] * i1 - o2[d0][r] * i2; ss += v[d0] * v[d0]; }
        ss += __shfl_xor(ss, 1); ss += __shfl_xor(ss, 2); ss += __shfl_xor(ss, 4); ss += __shfl_xor(ss, 8); ss += __shfl_xor(ss, 16);
        const float rs = __builtin_amdgcn_rsqf(ss * (1.0f / 128.0f) + 1e-6f);
#pragma unroll
        for (int d0 = 0; d0 < 4; ++d0) stg[row * 128 + d0 * 32 + r32] = (bf16)(cvtpk(v[d0] * rs * sg[d0], 0.f) & 0xffffu);
    }
    asm volatile("s_waitcnt lgkmcnt(0)" ::: "memory");
    { bf16* Yw = YA + (size_t)((tile0 + 4 * qb) * 64 + wid * 32) * 1024 + head * 128;
#pragma unroll
      for (int i = 0; i < 8; ++i) { const int row = i * 4 + (lane >> 4), ch = lane & 15; const u32x4 v = *(const LASC u32x4*)(stg + row * 128 + ch * 8); *(u32x4*)(Yw + (size_t)row * 1024 + ch * 8) = v; } }
    __syncthreads();
}

__device__ __forceinline__ void dil_task(const bf16* Qh, const bf16* Kh, const bf16* Vh, int drq0, int lq0, int L, int r, int tok_base, const LASC float* DBT, LASC float* Nsum, LASC float* Dsum, int lane) {
    const int r32 = lane & 31, hi = lane >> 5;
    bf16x8 qf[4];
#pragma unroll
    for (int ks = 0; ks < 4; ++ks) qf[ks] = *(const bf16x8*)(Qh + (size_t)(drq0 >> 6) * 4096 + (2 * ks + hi) * 512 + ((drq0 & 63) + r32) * 8);
    f32x16 o[2]; o[0] = f32x16{}; o[1] = f32x16{}; float l = 0.f;
    for (int s5 = 0; s5 < 5; ++s5) {
        const int lk0 = lq0 - 64 + 32 * s5; if (lk0 < 0 || lk0 >= L) continue;
        const int drk0 = drq0 + (lk0 - lq0);
        const int jb = lk0 - lq0 - r32 + 4 * hi + 96;
        f32x16 p;
#pragma unroll
        for (int rg = 0; rg < 16; ++rg) p[rg] = DBT[jb + (rg & 3) + 8 * (rg >> 2)];
#pragma unroll
        for (int ks = 0; ks < 4; ++ks) { const bf16x8 kf = *(const bf16x8*)(Kh + (size_t)(drk0 >> 6) * 4096 + (2 * ks + hi) * 512 + ((drk0 & 63) + r32) * 8); p = __builtin_amdgcn_mfma_f32_32x32x16_bf16(kf, qf[ks], p, 0, 0, 0); }
        float s = 0.f;
#pragma unroll
        for (int rg = 0; rg < 16; ++rg) { p[rg] = __builtin_amdgcn_exp2f(p[rg]); s += p[rg]; }
        l += s;
        const bf16x8 pa0 = pack_frag(p, 0), pa1 = pack_frag(p, 8);
#pragma unroll
        for (int db = 0; db < 2; ++db) {
            bf16x8 v0, v1; const bf16* vb = Vh + (size_t)(drk0 + 4 * hi) * 64 + 32 * db + r32;
#pragma unroll
            for (int j = 0; j < 8; ++j) { v0[j] = (short)vb[(size_t)((j & 3) + 8 * (j >> 2)) * 64]; v1[j] = (short)vb[(size_t)(16 + (j & 3) + 8 * (j >> 2)) * 64]; }
            o[db] = __builtin_amdgcn_mfma_f32_32x32x16_bf16(pa0, v0, o[db], 0, 0, 0); o[db] = __builtin_amdgcn_mfma_f32_32x32x16_bf16(pa1, v1, o[db], 0, 0, 0);
        }
    }
    l += __shfl_xor(l, 32);
    if (hi == 0) __hip_atomic_fetch_add(Dsum + tok_base + r32 * r, l, __ATOMIC_RELAXED, __HIP_MEMORY_SCOPE_WORKGROUP);
#pragma unroll
    for (int db = 0; db < 2; ++db)
#pragma unroll
        for (int rg = 0; rg < 16; ++rg) __hip_atomic_fetch_add(Nsum + (tok_base + crow(rg, hi) * r) * 64 + 32 * db + r32, o[db][rg], __ATOMIC_RELAXED, __HIP_MEMORY_SCOPE_WORKGROUP);
}
__device__ __forceinline__ void dil_unit(LASC unsigned char* lds, const bf16* DIL, bf16* YB, const float* rel_bias, int head, int span, int S, int lgS, int tid_in) {
    int tid = tid_in; asm volatile("" : "+v"(tid));
    const int lane = tid & 63; const int wid = __builtin_amdgcn_readfirstlane(tid >> 6);
    LASC float* Nsum = (LASC float*)(lds + DL_N); LASC float* Dsum = (LASC float*)(lds + DL_D); LASC float* DBT = (LASC float*)(lds + DL_T); const LASC float* SC = (const LASC float*)(lds + SC_OFF);
    const float M2 = SC[2];
    for (int i = tid; i < (512 * 64 + 512) / 4; i += 512) ((LASC f32x4*)Nsum)[i] = (f32x4){0.f, 0.f, 0.f, 0.f};
    for (int i = tid; i < 600; i += 512) { const int g = i / 200, j = i % 200 - 96; const int aj = j < 0 ? -j : j;
        DBT[i] = (aj <= 64) ? rel_bias[rel_bucket(j * (1 << (2 * g))) * 32 + 8 + 8 * g + head] * LOG2E - M2 : -1e30f; }
    __syncthreads();
    const int row0 = span * 512, seqbase = row0 & ~(S - 1), t0 = row0 & (S - 1);
    for (int tk = wid; tk < 48; tk += 8) {
        const int g = tk >> 4, j = tk & 15, lgr = 2 * g, r = 1 << lgr, L = S >> lgr;
        const int nblk = 16 >> lgr, cl = j / nblk, blk = j % nblk, lq0 = (t0 >> lgr) + 32 * blk;
        const bf16* Qh = DIL + (size_t)((g * 3 + 0) * 8 + head) * ((size_t)CH * 64); const bf16* Kh = DIL + (size_t)((g * 3 + 1) * 8 + head) * ((size_t)CH * 64); const bf16* Vh = DIL + (size_t)((g * 3 + 2) * 8 + head) * ((size_t)CH * 64);
        dil_task(Qh, Kh, Vh, seqbase + cl * L + lq0, lq0, L, r, lq0 * r + cl - t0, DBT + 200 * g, Nsum, Dsum, lane);
    }
    __syncthreads();
#pragma unroll
    for (int i = 0; i < 8; ++i) { const int row = (tid >> 3) + 64 * i, dc = tid & 7; const float inv = 1.0f / Dsum[row];
        const f32x4 a = *(const LASC f32x4*)(Nsum + row * 64 + dc * 8), b = *(const LASC f32x4*)(Nsum + row * 64 + dc * 8 + 4);
        u32x4 w; w.x = cvtpk(a[0] * inv, a[1] * inv); w.y = cvtpk(a[2] * inv, a[3] * inv); w.z = cvtpk(b[0] * inv, b[1] * inv); w.w = cvtpk(b[2] * inv, b[3] * inv);
        *(u32x4*)(YB + (size_t)(row0 + row) * 512 + head * 64 + dc * 8) = w; }
    __syncthreads();
}
}
#define LAS __attribute__((address_space(3)))
typedef unsigned short bf16;
typedef unsigned v4u __attribute__((ext_vector_type(4)));
typedef float f32x4 __attribute__((ext_vector_type(4)));
constexpr int NWAVES = 8, LDS_BYTES = 147456;
constexpr int TOK = 32768, DM = 1024, CH = 16384, FF = 4096, NIN = 9728;
constexpr size_t MiB = 1u << 20;
constexpr size_t WS_MOD = 1 * MiB, WS_SBIAS = WS_MOD + 160 * 1024, WS_ROWSS = WS_MOD + 320 * 1024;
constexpr size_t WS_WIN = 2 * MiB, WS_WBA = 21 * MiB, WS_WBB = 23 * MiB, WS_WO = 24 * MiB, WS_WUP = 26 * MiB, WS_WDN = 34 * MiB;
constexpr size_t WS_QK = 42 * MiB, WS_VA = 106 * MiB, WS_DIL = 138 * MiB, WS_GT = 282 * MiB, WS_MG = 346 * MiB, WS_END = 410 * MiB;
constexpr size_t WS_A2 = 42 * MiB, WS_H = 106 * MiB;
constexpr size_t DO_XN = 0, DO_YA = 64 * MiB, DO_YB = 96 * MiB;
#define LDS_WAIT() asm volatile("s_waitcnt lgkmcnt(0)" ::: "memory")
__device__ __forceinline__ unsigned f2bf(float f) { unsigned u = __builtin_bit_cast(unsigned, f); return (u + 0x7fffu + ((u >> 16) & 1u)) >> 16; }
__device__ __forceinline__ unsigned pk2(float lo, float hi) { return f2bf(lo) | (f2bf(hi) << 16); }
__device__ __forceinline__ float wave_sum(float v) {
#pragma unroll
    for (int o = 1; o < 64; o <<= 1) v += __shfl_xor(v, o);
    return v;
}
__device__ __forceinline__ float wave_max(float v) {
#pragma unroll
    for (int o = 1; o < 64; o <<= 1) v = fmaxf(v, __shfl_xor(v, o));
    return v;
}
template <bool PERMW> __device__ __forceinline__ void transpose_item(const float* W, int K, int N, bf16* WT, LAS float* scr, int item, int lane) {
    const int nblk = N / 32, kb = item / nblk, nb = item % nblk, k0 = 64 * kb, n0 = 32 * nb;
#pragma unroll 8
    for (int i = 0; i < 32; ++i) { const int kk = 2 * i + (lane >> 5); scr[kk * 33 + (lane & 31)] = W[(size_t)(k0 + kk) * N + n0 + (lane & 31)]; }
    LDS_WAIT(); asm volatile("" ::: "memory");
    const int c = lane & 7;
    int n0p = n0; if (PERMW) { const int lg = nb & 7; n0p = (nb & ~7) * 32 + 32 * (4 * (lg & 1) + (lg >> 1)); }
#pragma unroll
    for (int j = 0; j < 4; ++j) { const int n = (lane >> 3) + 8 * j; const LAS float* s = scr + (8 * c) * 33 + n;
        v4u o; o.x = pk2(s[0 * 33], s[1 * 33]); o.y = pk2(s[2 * 33], s[3 * 33]); o.z = pk2(s[4 * 33], s[5 * 33]); o.w = pk2(s[6 * 33], s[7 * 33]);
        *(v4u*)(WT + (size_t)(n0p + n) * K + k0 + 8 * c) = o; }
    LDS_WAIT(); asm volatile("" ::: "memory");
}
__device__ __forceinline__ void gemv6_task(const LAS float* vec, LAS f32x4* red, const float* W, int N, int col0, const float* bias, float* out, int tid) {
    const int cgp = tid & 7, ks = tid >> 3;
    f32x4 acc[6];
#pragma unroll
    for (int b = 0; b < 6; ++b) acc[b] = (f32x4){0.f, 0.f, 0.f, 0.f};
#pragma unroll 4
    for (int kk = 0; kk < 16; ++kk) { const int k = ks * 16 + kk; const f32x4 w = *(const f32x4*)(W + (size_t)k * N + col0 + 4 * cgp);
#pragma unroll
        for (int b = 0; b < 6; ++b) acc[b] += w * vec[b * 1024 + k]; }
#pragma unroll
    for (int b = 0; b < 6; ++b) red[(ks * 8 + cgp) * 6 + b] = acc[b];
    __syncthreads();
    if (tid < 192) { const int b = tid >> 5, c = tid & 31; float s = 0.f; const LAS float* rf = (const LAS float*)red;
        for (int k2 = 0; k2 < 64; ++k2) s += rf[((k2 * 8 + (c >> 2)) * 6 + b) * 4 + (c & 3)];
        out[b * N + col0 + c] = s + (bias ? bias[col0 + c] : 0.f); }
    __syncthreads();
}

struct Args { const float* in[24]; float* out; unsigned char* ws; int ph_lo, ph_hi; };
constexpr int NPHASE = 11;

__global__ void __launch_bounds__(NWAVES * 64, 2) mk_fwd(Args a) {
    extern __shared__ __attribute__((aligned(16))) unsigned char lds_raw[];
    cg::grid_group grid = cg::this_grid();
    LAS unsigned char* lds = (LAS unsigned char*)lds_raw;
    const int tid = threadIdx.x, lane = tid & 63, wave = __builtin_amdgcn_readfirstlane(tid >> 6);
    const int G = gridDim.x; const int bx = blockIdx.x; const int vcu = (G % 8 == 0) ? (bx % 8) * (G / 8) + bx / 8 : bx;
    const int gw = vcu * NWAVES + wave, NGW = G * NWAVES;
    unsigned char* ws = a.ws; unsigned char* dob = (unsigned char*)a.out;
    const float *x_p = a.in[0], *x_s = a.in[1], *c_p = a.in[2], *c_s = a.in[3], *rel_bias = a.in[4], *norm1_g = a.in[5], *w_ada = a.in[6], *b_ada = a.in[7], *w_in = a.in[8],
                *qn_a = a.in[9], *kn_a = a.in[10], *lq1 = a.in[11], *lk1 = a.in[12], *lq2 = a.in[13], *lk2 = a.in[14], *subln_g = a.in[15], *qn_b = a.in[16], *kn_b = a.in[17],
                *w_br_a = a.in[18], *w_br_b = a.in[19], *w_o = a.in[20], *norm2_g = a.in[21], *w_up = a.in[22], *w_down = a.in[23];
    float* mod = (float*)(ws + WS_MOD); float* sbias = (float*)(ws + WS_SBIAS); float* rowss = (float*)(ws + WS_ROWSS);
    bf16 *WinT = (bf16*)(ws + WS_WIN), *WbaT = (bf16*)(ws + WS_WBA), *WbbT = (bf16*)(ws + WS_WBB), *WoT = (bf16*)(ws + WS_WO), *WupT = (bf16*)(ws + WS_WUP), *WdnT = (bf16*)(ws + WS_WDN);
    bf16 *QK = (bf16*)(ws + WS_QK), *VA = (bf16*)(ws + WS_VA), *DIL = (bf16*)(ws + WS_DIL), *GT = (bf16*)(ws + WS_GT), *MG = (bf16*)(ws + WS_MG), *A2 = (bf16*)(ws + WS_A2), *HB = (bf16*)(ws + WS_H);
    bf16 *XN = (bf16*)(dob + DO_XN), *YA = (bf16*)(dob + DO_YA), *YB = (bf16*)(dob + DO_YB);
    const int lo = a.ph_lo, hi = a.ph_hi;
#ifndef PH_MASK
#define PH_MASK 0x7ff
#endif
#define PH_ON(k) ((PH_MASK >> (k)) & 1)
#define IN(k) (lo <= (k) && (k) < hi)
#define SEAM(k) do { if (IN(k) && IN((k) + 1)) grid.sync(); } while (0)

    if (PH_ON(0) && IN(0)) {
        LAS float* scr = (LAS float*)(lds + wave * 16384);
        constexpr int I_IN = (DM / 64) * (NIN / 32), I_BA = (DM / 64) * (DM / 32), I_BB = (512 / 64) * (DM / 32), I_O = I_BA, I_UP = (DM / 64) * (FF / 32), I_DN = (FF / 64) * (DM / 32);
        constexpr int NITEMS = I_IN + I_BA + I_BB + I_O + I_UP + I_DN;
        for (int it = gw; it < NITEMS; it += NGW) {
            int r = it;
            if (r < I_IN) { transpose_item<true>(w_in, DM, NIN, WinT, scr, r, lane); continue; } r -= I_IN;
            if (r < I_BA) { transpose_item<false>(w_br_a, DM, DM, WbaT, scr, r, lane); continue; } r -= I_BA;
            if (r < I_BB) { transpose_item<false>(w_br_b, 512, DM, WbbT, scr, r, lane); continue; } r -= I_BB;
            if (r < I_O) { transpose_item<false>(w_o, DM, DM, WoT, scr, r, lane); continue; } r -= I_O;
            if (r < I_UP) { transpose_item<false>(w_up, DM, FF, WupT, scr, r, lane); continue; } r -= I_UP;
            transpose_item<false>(w_down, FF, DM, WdnT, scr, r, lane);
        }
        for (int i = gw * 64 + lane; i < TOK; i += NGW * 64) rowss[i] = 0.f;
        __syncthreads();
        LAS float* vec = (LAS float*)lds; LAS f32x4* red = (LAS f32x4*)(lds + 32768);
        for (int i = tid; i < 6 * 1024; i += 512) { const int b = i >> 10, k = i & 1023; const float c = b < 4 ? c_p[b * 1024 + k] : c_s[(b - 4) * 1024 + k]; vec[i] = c / (1.0f + __expf(-c)); }
        __syncthreads();
        for (int task = vcu; task < 6144 / 32; task += G) gemv6_task(vec, red, w_ada, 6144, task * 32, b_ada, mod, tid);
        __syncthreads();
    }
    SEAM(0);
    if (PH_ON(1) && IN(1)) {
        for (int m = gw; m < TOK; m += NGW) {
            const float* xr = m < 16384 ? x_p + (size_t)m * 1024 : x_s + (size_t)(m - 16384) * 1024; const int b = pg8::batch_of(m);
            const float* sh1 = mod + b * 6144; const float* sc1 = mod + b * 6144 + 1024;
            f32x4 v[4]; float s = 0.f;
#pragma unroll
            for (int j = 0; j < 4; ++j) { v[j] = ((const f32x4*)xr)[lane + 64 * j]; s += (v[j].x * v[j].x + v[j].y * v[j].y) + (v[j].z * v[j].z + v[j].w * v[j].w); }
            const float rstd = 1.0f / sqrtf(wave_sum(s) * (1.0f / 1024.0f) + 1e-6f);
            unsigned long long* o8 = (unsigned long long*)(XN + (size_t)m * 1024) + lane;
#pragma unroll
            for (int j = 0; j < 4; ++j) { const int c = 4 * lane + 256 * j; const f32x4 g = *(const f32x4*)(norm1_g + c), sc = *(const f32x4*)(sc1 + c), sh = *(const f32x4*)(sh1 + c);
                const f32x4 h = v[j] * rstd * g * (sc + 1.0f) + sh;
                o8[64 * j] = (unsigned long long)pk2(h.x, h.y) | ((unsigned long long)pk2(h.z, h.w) << 32); }
        }
        __syncthreads();
        LAS float* vec = (LAS float*)lds; LAS f32x4* red = (LAS f32x4*)(lds + 32768);
        for (int i = tid; i < 6 * 1024; i += 512) { const int b = i >> 10, k = i & 1023; vec[i] = mod[b * 6144 + 3072 + k]; }
        __syncthreads();
        for (int task = vcu; task < FF / 32; task += G) gemv6_task(vec, red, w_up, FF, task * 32, nullptr, sbias, tid);
        __syncthreads();
    }
    SEAM(1);
#pragma unroll 1
    for (int c = 0; c < 2; ++c) {
        const int S = c == 0 ? 4096 : 8192, lgS = c == 0 ? 12 : 13;
        if (PH_ON(2) && IN(2 + 3 * c)) {
            pg8::Gemm g{XN + (size_t)c * CH * DM, WinT, CH, NIN, DM}; pg8::StaticOrder SO; SO.init(CH, NIN, G, bx);
            pg8::EpiProj E{QK, VA, DIL, GT, qn_a, kn_a, qn_b, kn_b, S, lgS};
            pg8::gemm_phase<pg8::EpiProj, pg8::StaticOrder, true, true>(lds, g, SO, E);
        }
        SEAM(2 + 3 * c);
        if (PH_ON(3) && IN(3 + 3 * c)) {
            if (wave == 0) {
                int lane_s = tid & 63; asm volatile("" : "+v"(lane_s));
#define lane lane_s
                const float a1 = wave_sum(lq1[lane] * lk1[lane]), a2 = wave_sum(lq2[lane] * lk2[lane]);
                const float gqa = wave_max(fabsf(qn_a[lane])), gka = wave_max(fabsf(kn_a[lane]));
                float gb = 0.f;
#pragma unroll
                for (int g = 0; g < 3; ++g) gb = fmaxf(gb, wave_max(fabsf(qn_b[64 * g + lane])) * wave_max(fabsf(kn_b[64 * g + lane])));
                float ba = 0.f, bb = 0.f;
                for (int i = lane; i < 1024; i += 64) { const float v = fabsf(rel_bias[i]); if ((i & 31) < 8) ba = fmaxf(ba, v); else bb = fmaxf(bb, v); }
                ba = wave_max(ba); bb = wave_max(bb);
                if (lane == 0) { LAS float* SC = (LAS float*)(lds + att::SC_OFF); SC[0] = __expf(a1) - __expf(a2) + 0.2f; SC[1] = (8.0f * gqa * gka + ba) * att::LOG2E; SC[2] = (8.0f * gb + bb) * att::LOG2E; }
#undef lane
            }
            __syncthreads();
            { const int span = vcu >> 3, head = vcu & 7;
#ifndef NO_DIL
              for (int u = vcu; u < 256; u += G) att::dil_unit(lds, DIL, YB, rel_bias, u & 7, u >> 3, S, lgS, tid);
#endif
              (void)span; (void)head; }
            { const int nqb = S / 256;
#ifndef NO_DA
              for (int u = vcu; u < 512; u += G) { const int sh = u / nqb, qb = u % nqb, seq = sh >> 3, head = sh & 7;
                  att::da_unit(lds, QK, VA, YA, rel_bias, subln_g, head, seq * (S / 64), S / 64, qb, tid); }
#endif
              (void)nqb; }
        }
        SEAM(3 + 3 * c);
        if (PH_ON(4) && IN(4 + 3 * c)) {
#ifndef NO_P3A
            { pg8::Gemm g{YB, WbbT, CH, DM, 512}; pg8::StaticOrder SO; SO.init(CH, DM, G, bx);
              pg8::EpiBr<false> E{MG + (size_t)c * CH * DM, GT + (size_t)CH * 1024};
              pg8::gemm_phase<pg8::EpiBr<false>, pg8::StaticOrder, true, true>(lds, g, SO, E); }
#endif
            asm volatile("s_waitcnt vmcnt(0)" ::: "memory"); __syncthreads();
#ifndef NO_P3B
            { pg8::Gemm g{YA, WbaT, CH, DM, DM}; pg8::StaticOrder SO; SO.init(CH, DM, G, bx);
              pg8::EpiBr<true> E{MG + (size_t)c * CH * DM, GT};
              pg8::gemm_phase<pg8::EpiBr<true>, pg8::StaticOrder, true, true>(lds, g, SO, E); }
#endif
        }
        SEAM(4 + 3 * c);
    }
    if (PH_ON(8) && IN(8)) {
        pg8::Gemm g{MG, WoT, TOK, DM, DM}; pg8::StaticOrder SO; SO.init(TOK, DM, G, bx);
        pg8::EpiWo E{x_p, x_s, a.out, A2, mod, norm2_g, rowss};
        pg8::gemm_phase<pg8::EpiWo, pg8::StaticOrder, true, true>(lds, g, SO, E);
    }
    SEAM(8);
    if (PH_ON(9) && IN(9)) {
        pg8::Gemm g{A2, WupT, TOK, FF, DM}; pg8::StaticOrder SO; SO.init(TOK, FF, G, bx);
        pg8::EpiUp E{HB, rowss, sbias};
        pg8::gemm_phase<pg8::EpiUp, pg8::StaticOrder, true, true>(lds, g, SO, E);
    }
    SEAM(9);
    if (PH_ON(10) && IN(10)) {
        pg8::Gemm g{HB, WdnT, TOK, DM, FF}; pg8::StaticOrder SO; SO.init(TOK, DM, G, bx);
        pg8::EpiDown E{a.out, mod};
        pg8::gemm_phase<pg8::EpiDown, pg8::StaticOrder, true, true>(lds, g, SO, E);
    }
#undef IN
#undef SEAM
}

extern "C" void kernel_launch(void* const* d_in, const int* in_sizes, int n_in, void* d_out, int out_size, void* d_ws, size_t ws_size, hipStream_t stream) {
    static int grid = 0;
    if (grid == 0) {
        if (n_in != 24 || out_size != TOK * DM || ws_size < WS_END) { fprintf(stderr, "kernel_launch: unexpected shapes (n_in %d, out %d, ws %zu)\n", n_in, out_size, ws_size); grid = -1; return; }
        int dev = 0, cus = 0, per_cu = 0;
        if (hipGetDevice(&dev) != hipSuccess || hipDeviceGetAttribute(&cus, hipDeviceAttributeMultiprocessorCount, dev) != hipSuccess) { grid = -1; return; }
        if (hipFuncSetAttribute((const void*)mk_fwd, hipFuncAttributeMaxDynamicSharedMemorySize, LDS_BYTES) != hipSuccess) { fprintf(stderr, "kernel_launch: hipFuncSetAttribute failed\n"); grid = -1; return; }
        if (hipOccupancyMaxActiveBlocksPerMultiprocessor(&per_cu, (const void*)mk_fwd, NWAVES * 64, LDS_BYTES) != hipSuccess || per_cu < 1) { fprintf(stderr, "kernel_launch: occupancy query says %d\n", per_cu); per_cu = 1; }
        (void)hipGetLastError();
        grid = cus;
    }
    if (grid < 0) return;
    Args a{};
    for (int i = 0; i < 24; ++i) a.in[i] = (const float*)d_in[i];
    a.out = (float*)d_out; a.ws = (unsigned char*)d_ws;
#ifndef MK_PER_PHASE
    a.ph_lo = 0; a.ph_hi = NPHASE;
    void* args[] = {&a};
    hipError_t e = hipLaunchCooperativeKernel((const void*)mk_fwd, dim3(grid), dim3(NWAVES * 64), args, LDS_BYTES, stream);
    if (e != hipSuccess) fprintf(stderr, "kernel_launch: cooperative launch failed: %s (grid %d)\n", hipGetErrorString(e), grid);
#else
    for (int p = 0; p < NPHASE; ++p) { a.ph_lo = p; a.ph_hi = p + 1; hipLaunchKernelGGL(mk_fwd, dim3(grid), dim3(NWAVES * 64), LDS_BYTES, stream, a); }
#endif
}
```

```cpp
#include <hip/hip_runtime.h>
#include <hip/hip_cooperative_groups.h>
#include <cstdio>
#include <cstdint>
namespace cg = cooperative_groups;
template <int M> __device__ __forceinline__ float swz_xor(float v) { return __builtin_bit_cast(float, __builtin_amdgcn_ds_swizzle(__builtin_bit_cast(int, v), (M << 10) | 0x1f)); }
__device__ __forceinline__ float add_x32(float v) { const unsigned b = __builtin_bit_cast(unsigned, v); auto rr = __builtin_amdgcn_permlane32_swap(b, b, false, false); return __builtin_bit_cast(float, (unsigned)rr[0]) + __builtin_bit_cast(float, (unsigned)rr[1]); }
__device__ __forceinline__ float max_x32(float v) { const unsigned b = __builtin_bit_cast(unsigned, v); auto rr = __builtin_amdgcn_permlane32_swap(b, b, false, false); return fmaxf(__builtin_bit_cast(float, (unsigned)rr[0]), __builtin_bit_cast(float, (unsigned)rr[1])); }
namespace pg8 {
#define PG8_LAS __attribute__((address_space(3)))
typedef unsigned short bf16_t;
typedef short bf16x8 __attribute__((ext_vector_type(8)));
typedef float f32x4 __attribute__((ext_vector_type(4)));
typedef unsigned u32x4 __attribute__((ext_vector_type(4)));
constexpr int BM = 256, BK = 64, HALF = 128, HTB = HALF * BK * 2  , STAGE_BYTES = 8 * HTB, NXCD = 8, WGM = 8;

__host__ __device__ __forceinline__ int lds_byte(int r, int c) { const int st = (r >> 4) * 2 + (c >> 5), rr = r & 15, cc = c & 31, ob = rr * 64 + cc * 2; return st * 1024 + (ob ^ (((ob >> 9) & 1) << 5)); }
__host__ __device__ __forceinline__ void stage_rc(int b, int& R, int& C) { const int st = b / 1024, sb = b % 1024, swz = sb ^ (((sb >> 9) & 1) << 5); R = (st >> 1) * 16 + swz / 64; C = (st & 1) * 32 + (swz % 64) / 2; }
__host__ __device__ __forceinline__ int perm32(int rho) { const int n = rho >> 4, i = rho & 15; return 8 * (i >> 2) + 4 * n + (i & 3); }

struct Unit { int pm, pn; };
struct Gemm { const bf16_t* A; const bf16_t* Bt; int M, N, K; };

struct StaticOrder {
    int nM, nN, nwg, G, c;
    __host__ __device__ void init(int M, int N, int G_, int c_) { nM = M / BM; nN = N / BM; nwg = nM * nN; G = G_; c = c_; }
    __host__ __device__ bool next(int i, Unit& u) const {
        const long L = (long)i * G + c; if (L >= nwg) return false;
        int wgid = (int)L; { const int q = nwg / NXCD, r = nwg % NXCD, xcd = wgid % NXCD, off = wgid / NXCD; wgid = (xcd < r ? xcd * (q + 1) : r * (q + 1) + (xcd - r) * q) + off; }
        const int nig = WGM * nN, gid = wgid / nig, fm = gid * WGM, gsz = (nM - fm) < WGM ? (nM - fm) : WGM;
        u.pm = fm + ((wgid % nig) % gsz); u.pn = (wgid % nig) / gsz; return true;
    }
    __device__ __forceinline__ void a_ready(const Unit&) const {}
    __device__ __forceinline__ void done(const Unit&) const {}
};
__device__ __forceinline__ unsigned cvt_pk_bf16(float lo, float hi) { unsigned r; asm volatile("v_cvt_pk_bf16_f32 %0, %1, %2" : "=v"(r) : "v"(lo), "v"(hi)); return r; }
template <class Epi, class Sched, bool ALIGN_EPI = false, bool SP2 = false>
__device__ __forceinline__ void gemm_phase(PG8_LAS unsigned char* lds, const Gemm g, const Sched& S, const Epi& E) {
    int tid_ = threadIdx.x; asm volatile("" : "+v"(tid_));
    const int tid = tid_, wid = __builtin_amdgcn_readfirstlane(tid >> 6), lane = tid & 63, wr = wid >> 2, wc = wid & 3, fr = lane & 15, fq = lane >> 4;
    const int K = g.K, nt = K / BK;
    unsigned voffA[2], voffB[2];
#pragma unroll
    for (int i = 0; i < 2; ++i) { int R, C; stage_rc(tid * 16 + i * 8192, R, C); const int Rb = Epi::PERM ? ((R & ~31) + perm32(R & 31)) : R;
        voffA[i] = (unsigned)(R * K + C) * 2u; voffB[i] = (unsigned)(Rb * K + C) * 2u; }
    const size_t kstep = (size_t)(BK * 2);
    const size_t hstep = (size_t)HALF * K * 2;
    const size_t tstep = 2 * hstep;
    const unsigned ldsw = (unsigned)wid * 1024u;
    const int aoff = lds_byte(wr * 64 + fr, fq * 8), boff = lds_byte(wc * 32 + fr, fq * 8);
#define PG8_SA(b, h) (((b) * 2 + (h)) * HTB)
#define PG8_SB(b, h) ((4 + (b) * 2 + (h)) * HTB)
#define PG8_STAGE(bufoff, gbase, voff) do { _Pragma("unroll") for (int _i = 0; _i < 2; ++_i) \
        __builtin_amdgcn_global_load_lds((const unsigned*)((const char*)(gbase) + (voff)[_i]), (PG8_LAS unsigned*)(lds + (bufoff) + ldsw + _i * 8192), 16, 0, 0); } while (0)
#define PG8_LDA(dst, b, h) do { _Pragma("unroll") for (int m = 0; m < 4; ++m) _Pragma("unroll") for (int k = 0; k < 2; ++k) dst[m][k] = *(const PG8_LAS bf16x8*)(lds + PG8_SA(b, h) + aoff + m * 2048 + k * 1024); } while (0)
#define PG8_LDB(dst, b, h) do { _Pragma("unroll") for (int n = 0; n < 2; ++n) _Pragma("unroll") for (int k = 0; k < 2; ++k) dst[n][k] = *(const PG8_LAS bf16x8*)(lds + PG8_SB(b, h) + boff + n * 2048 + k * 1024); } while (0)
#define PG8_MMA(ai, bj, At, Bt) do { __builtin_amdgcn_s_setprio(1); _Pragma("unroll") for (int m = 0; m < 4; ++m) _Pragma("unroll") for (int n = 0; n < 2; ++n) _Pragma("unroll") for (int k = 0; k < 2; ++k) \
        acc[ai][bj][m][n] = __builtin_amdgcn_mfma_f32_16x16x32_bf16(Bt[n][k], At[m][k], acc[ai][bj][m][n], 0, 0, 0); __builtin_amdgcn_s_setprio(0); } while (0)
#define PG8_WAIT_V(n) asm volatile("s_waitcnt vmcnt(" #n ")" ::: "memory")
#define PG8_WAIT_L(n) asm volatile("s_waitcnt lgkmcnt(" #n ")" ::: "memory")
#define PG8_BAR __builtin_amdgcn_s_barrier()
#define PG8_SCHED __builtin_amdgcn_sched_barrier(0)
    Unit cur, nxt; int ui = 0;
    if (!S.next(0, cur)) return;
    f32x4 acc[2][2][4][2];
#pragma unroll
    for (int a = 0; a < 2; ++a)
#pragma unroll
        for (int b = 0; b < 2; ++b)
#pragma unroll
            for (int m = 0; m < 4; ++m)
#pragma unroll
                for (int n = 0; n < 2; ++n) acc[a][b][m][n] = (f32x4){0.f, 0.f, 0.f, 0.f};
    bf16x8 At[4][2], B0[2][2], B1[2][2];
    const char* cA = (const char*)g.A + (size_t)cur.pm * tstep; const char* cB = (const char*)g.Bt + (size_t)cur.pn * tstep;
    S.a_ready(cur);
    if constexpr (SP2) {
        PG8_STAGE(PG8_SB(0, 0), cB, voffB); PG8_STAGE(PG8_SB(0, 1), cB + hstep, voffB); PG8_STAGE(PG8_SA(0, 0), cA, voffA); PG8_STAGE(PG8_SA(0, 1), cA + hstep, voffA);
        if (wr == 1) PG8_BAR;
        PG8_WAIT_V(2); PG8_BAR;
        PG8_STAGE(PG8_SB(1, 0), cB + kstep, voffB); PG8_STAGE(PG8_SA(1, 0), cA + kstep, voffA); PG8_STAGE(PG8_SB(1, 1), cB + hstep + kstep, voffB);
        PG8_WAIT_V(6); PG8_BAR;
    } else {
        PG8_STAGE(PG8_SB(0, 0), cB, voffB); PG8_STAGE(PG8_SA(0, 0), cA, voffA); PG8_STAGE(PG8_SB(0, 1), cB + hstep, voffB); PG8_STAGE(PG8_SA(0, 1), cA + hstep, voffA);
        if (wr == 1) PG8_BAR;
        PG8_WAIT_V(4); PG8_BAR;
        PG8_STAGE(PG8_SB(1, 0), cB + kstep, voffB); PG8_STAGE(PG8_SA(1, 0), cA + kstep, voffA); PG8_STAGE(PG8_SB(1, 1), cB + hstep + kstep, voffB);
        PG8_WAIT_V(6); PG8_BAR;
    }
    for (;;) {
        const bool has_next = S.next(ui + 1, nxt);
        const char* nA = has_next ? (const char*)g.A + (size_t)nxt.pm * tstep : cA; const char* nB = has_next ? (const char*)g.Bt + (size_t)nxt.pn * tstep : cB;
        for (int t = 0; t < nt; t += 2) {
            const bool last = (t == nt - 2);
            const char* a1 = cA + (size_t)(t + 1) * kstep;
            const char* a2 = last ? nA : cA + (size_t)(t + 2) * kstep; const char* b2 = last ? nB : cB + (size_t)(t + 2) * kstep;
            const char* a3 = a2 + kstep; const char* b3 = b2 + kstep;
            if (last && has_next) S.a_ready(nxt);
            if constexpr (SP2) {
            PG8_LDB(B0, 0, 0); PG8_LDB(B1, 0, 1); PG8_SCHED; PG8_LDA(At, 0, 0); PG8_STAGE(PG8_SA(1, 1), a1 + hstep, voffA);
            PG8_WAIT_V(8); PG8_WAIT_L(0); PG8_BAR; PG8_MMA(0, 0, At, B0); PG8_MMA(0, 1, At, B1); PG8_BAR; PG8_SCHED;
            PG8_LDA(At, 0, 1); PG8_STAGE(PG8_SB(0, 0), b2, voffB); PG8_STAGE(PG8_SB(0, 1), b2 + hstep, voffB); PG8_STAGE(PG8_SA(0, 0), a2, voffA);
            PG8_WAIT_V(8); PG8_WAIT_L(0); PG8_BAR; PG8_MMA(1, 0, At, B0); PG8_MMA(1, 1, At, B1); PG8_BAR; PG8_SCHED;
            PG8_LDB(B0, 1, 0); PG8_LDB(B1, 1, 1); PG8_SCHED; PG8_LDA(At, 1, 0); PG8_STAGE(PG8_SA(0, 1), a2 + hstep, voffA);
            PG8_WAIT_V(8); PG8_WAIT_L(0); PG8_BAR; PG8_MMA(0, 0, At, B0); PG8_MMA(0, 1, At, B1); PG8_BAR; PG8_SCHED;
            PG8_LDA(At, 1, 1); PG8_STAGE(PG8_SB(1, 0), b3, voffB); PG8_STAGE(PG8_SB(1, 1), b3 + hstep, voffB); PG8_STAGE(PG8_SA(1, 0), a3, voffA);
            PG8_WAIT_V(8); PG8_WAIT_L(0); PG8_BAR; PG8_MMA(1, 0, At, B0); PG8_MMA(1, 1, At, B1); PG8_BAR; PG8_SCHED;
            } else {
            PG8_LDB(B0, 0, 0); PG8_SCHED; PG8_LDA(At, 0, 0); PG8_STAGE(PG8_SA(1, 1), a1 + hstep, voffA);
            PG8_WAIT_L(8); PG8_BAR; PG8_WAIT_L(0); PG8_MMA(0, 0, At, B0); PG8_BAR; PG8_SCHED;
            PG8_LDB(B1, 0, 1); PG8_STAGE(PG8_SB(0, 0), b2, voffB);
            PG8_BAR; PG8_WAIT_L(0); PG8_MMA(0, 1, At, B1); PG8_BAR;
            PG8_LDA(At, 0, 1); PG8_STAGE(PG8_SA(0, 0), a2, voffA);
            PG8_BAR; PG8_WAIT_L(0); PG8_MMA(1, 0, At, B0); PG8_BAR; PG8_SCHED;
            PG8_STAGE(PG8_SB(0, 1), b2 + hstep, voffB);
            PG8_WAIT_V(6); PG8_BAR; PG8_MMA(1, 1, At, B1); PG8_BAR;
            PG8_LDB(B0, 1, 0); PG8_SCHED; PG8_LDA(At, 1, 0); PG8_STAGE(PG8_SA(0, 1), a2 + hstep, voffA);
            PG8_WAIT_L(8); PG8_BAR; PG8_WAIT_L(0); PG8_MMA(0, 0, At, B0); PG8_BAR; PG8_SCHED;
            PG8_LDB(B1, 1, 1); PG8_STAGE(PG8_SB(1, 0), b3, voffB);
            PG8_BAR; PG8_WAIT_L(0); PG8_MMA(0, 1, At, B1); PG8_BAR;
            PG8_LDA(At, 1, 1); PG8_STAGE(PG8_SA(1, 0), a3, voffA);
            PG8_BAR; PG8_WAIT_L(0); PG8_MMA(1, 0, At, B0); PG8_BAR; PG8_SCHED;
            PG8_STAGE(PG8_SB(1, 1), b3 + hstep, voffB);
            PG8_WAIT_V(6); PG8_BAR; PG8_MMA(1, 1, At, B1); PG8_BAR;
            }
        }
        if constexpr (ALIGN_EPI) { if (wr == 0) PG8_BAR; }
        if constexpr (!Epi::AFTER_DRAIN) { E(acc, cur, wr, wc, fr, fq); S.done(cur); }
        if (!has_next) break;
#pragma unroll
        for (int a = 0; a < 2; ++a)
#pragma unroll
            for (int b = 0; b < 2; ++b)
#pragma unroll
                for (int m = 0; m < 4; ++m)
#pragma unroll
                    for (int n = 0; n < 2; ++n) acc[a][b][m][n] = (f32x4){0.f, 0.f, 0.f, 0.f};
        cur = nxt; cA = nA; cB = nB; ++ui;
        if constexpr (ALIGN_EPI) { if (wr == 1) PG8_BAR; }
    }
    PG8_WAIT_V(0);
    if constexpr (!ALIGN_EPI) { if (wr == 0) PG8_BAR; }
    PG8_BAR;
    if constexpr (Epi::AFTER_DRAIN) { E.fused(acc, cur, wr, wc, fr, fq, lds, wid, lane); S.done(cur); }
#undef PG8_SA
#undef PG8_SB
#undef PG8_STAGE
#undef PG8_LDA
#undef PG8_LDB
#undef PG8_MMA
#undef PG8_WAIT_V
#undef PG8_WAIT_L
#undef PG8_BAR
#undef PG8_SCHED
}
constexpr int CH = 16384;
constexpr float C2Q = 0.125f * 1.4426950408889634f;
__device__ __forceinline__ u32x4 pack8(const f32x4& a, const f32x4& b) { u32x4 w; w.x = cvt_pk_bf16(a[0], a[1]); w.y = cvt_pk_bf16(a[2], a[3]); w.z = cvt_pk_bf16(b[0], b[1]); w.w = cvt_pk_bf16(b[2], b[3]); return w; }
__device__ __forceinline__ f32x4 bf4lo(const u32x4& w) { return (f32x4){__uint_as_float(w.x << 16), __uint_as_float(w.x & 0xffff0000u), __uint_as_float(w.y << 16), __uint_as_float(w.y & 0xffff0000u)}; }
__device__ __forceinline__ f32x4 bf4hi(const u32x4& w) { return (f32x4){__uint_as_float(w.z << 16), __uint_as_float(w.z & 0xffff0000u), __uint_as_float(w.w << 16), __uint_as_float(w.w & 0xffff0000u)}; }
__device__ __forceinline__ int batch_of(int m) { return m < 16384 ? (m >> 12) : 4 + ((m - 16384) >> 13); }

struct EpiProj {
    static constexpr bool PERM = true, AFTER_DRAIN = false;
    bf16_t *QK, *VA, *DIL, *GT; const float *qn_a, *kn_a, *qn_b, *kn_b; int S, lgS;
    __device__ __forceinline__ void operator()(const f32x4 (&acc)[2][2][4][2], const Unit& u, int wr, int wc, int fr, int fq) const {
        const int pn = u.pn, lrb = u.pm * BM + wr * 64 + fr;
        int kind, lgr = 0; bf16_t* dst; const float* gain = nullptr; float sc = 1.f;
        if (pn < 8) { const int which = pn >> 1, head = (pn & 1) * 4 + wc; kind = 0; gain = which < 2 ? qn_a : kn_a; sc = which < 2 ? C2Q : 1.f; dst = QK + (size_t)(which * 8 + head) * ((size_t)CH * 64); }
        else if (pn < 12) { const int head = (pn - 8) * 2 + (wc >> 1); kind = 1; dst = VA + (size_t)head * ((size_t)CH * 128) + (2 * (wc & 1)) * 2048 + 8 * fq; }
        else if (pn < 30) { const int idx = pn - 12, g = idx / 6, part = (idx % 6) >> 1, head = (idx & 1) * 4 + wc; lgr = 2 * g;
            dst = DIL + (size_t)((g * 3 + part) * 8 + head) * ((size_t)CH * 64);
            if (part < 2) { kind = 0; gain = (part == 0 ? qn_b : kn_b) + 64 * g; sc = part == 0 ? C2Q : 1.f; } else { kind = 2; dst += 8 * fq; } }
        else { const int which = (pn - 30) >> 2; kind = 3; dst = GT + (size_t)which * ((size_t)CH * 1024) + ((pn - 30) & 3) * 256 + 64 * wc + 8 * fq; }
        const int Sm = S - 1, rm = (1 << lgr) - 1, lsh = lgS - lgr;
        if (kind == 0) {
            f32x4 gv[2][2];
#pragma unroll
            for (int bj = 0; bj < 2; ++bj)
#pragma unroll
                for (int n = 0; n < 2; ++n) gv[bj][n] = *(const f32x4*)(gain + 32 * bj + 8 * fq + 4 * n) * sc;
#pragma unroll
            for (int ai = 0; ai < 2; ++ai)
#pragma unroll
                for (int m = 0; m < 4; ++m) {
                    const int lr = lrb + ai * HALF + m * 16, t = lr & Sm, dr = (lr & ~Sm) + ((t & rm) << lsh) + (t >> lgr);
                    float ss = 0.f;
#pragma unroll
                    for (int bj = 0; bj < 2; ++bj)
#pragma unroll
                        for (int n = 0; n < 2; ++n) { const f32x4 x = acc[ai][bj][m][n]; ss += (x[0] * x[0] + x[1] * x[1]) + (x[2] * x[2] + x[3] * x[3]); }
                    ss += swz_xor<16>(ss); ss = add_x32(ss);
                    const float rs = __builtin_amdgcn_rsqf(ss * (1.0f / 64.0f) + 1e-6f);
                    bf16_t* rowp = dst + (size_t)(dr >> 6) * 4096 + fq * 512 + (dr & 63) * 8;
#pragma unroll
                    for (int bj = 0; bj < 2; ++bj) *(u32x4*)(rowp + bj * 2048) = pack8(acc[ai][bj][m][0] * rs * gv[bj][0], acc[ai][bj][m][1] * rs * gv[bj][1]);
                }
        } else if (kind == 1) {
#pragma unroll
            for (int ai = 0; ai < 2; ++ai)
#pragma unroll
                for (int m = 0; m < 4; ++m) {
                    const int lr = lrb + ai * HALF + m * 16;
                    bf16_t* rowp = dst + (size_t)(lr >> 6) * 8192 + ((lr & 63) >> 4) * 512 + (lr & 15) * 32;
#pragma unroll
                    for (int bj = 0; bj < 2; ++bj) *(u32x4*)(rowp + bj * 2048) = pack8(acc[ai][bj][m][0], acc[ai][bj][m][1]);
                }
        } else if (kind == 2) {
#pragma unroll
            for (int ai = 0; ai < 2; ++ai)
#pragma unroll
                for (int m = 0; m < 4; ++m) {
                    const int lr = lrb + ai * HALF + m * 16, t = lr & Sm, dr = (lr & ~Sm) + ((t & rm) << lsh) + (t >> lgr);
                    bf16_t* rowp = dst + (size_t)dr * 64;
#pragma unroll
                    for (int bj = 0; bj < 2; ++bj) *(u32x4*)(rowp + bj * 32) = pack8(acc[ai][bj][m][0], acc[ai][bj][m][1]);
                }
        } else {
#pragma unroll
            for (int ai = 0; ai < 2; ++ai)
#pragma unroll
                for (int m = 0; m < 4; ++m) {
                    const int lr = lrb + ai * HALF + m * 16;
                    bf16_t* rowp = dst + (size_t)lr * 1024;
#pragma unroll
                    for (int bj = 0; bj < 2; ++bj) { f32x4 v0 = acc[ai][bj][m][0], v1 = acc[ai][bj][m][1];
#pragma unroll
                        for (int i = 0; i < 4; ++i) { v0[i] = __builtin_amdgcn_rcpf(1.0f + __builtin_amdgcn_exp2f(-1.4426950408889634f * v0[i])); v1[i] = __builtin_amdgcn_rcpf(1.0f + __builtin_amdgcn_exp2f(-1.4426950408889634f * v1[i])); }
                        *(u32x4*)(rowp + bj * 32) = pack8(v0, v1); }
                }
        }
    }
};
template <bool ADD> struct EpiBr {
    static constexpr bool PERM = true, AFTER_DRAIN = false;
    bf16_t* MG; const bf16_t* G;
    __device__ __forceinline__ void operator()(const f32x4 (&acc)[2][2][4][2], const Unit& u, int wr, int wc, int fr, int fq) const {
        const int row0 = u.pm * BM + wr * 64 + fr, col0 = u.pn * BM + wc * 32 + 8 * fq;
#pragma unroll
        for (int ai = 0; ai < 2; ++ai)
#pragma unroll
            for (int m = 0; m < 4; ++m) { const size_t off = (size_t)(row0 + ai * HALF + m * 16) * 1024 + col0;
#pragma unroll
                for (int bj = 0; bj < 2; ++bj) { const u32x4 gw = *(const u32x4*)(G + off + bj * HALF);
                    f32x4 v0 = acc[ai][bj][m][0] * bf4lo(gw), v1 = acc[ai][bj][m][1] * bf4hi(gw);
                    if (ADD) { const u32x4 tw = *(const u32x4*)(MG + off + bj * HALF); v0 += bf4lo(tw); v1 += bf4hi(tw); }
                    *(u32x4*)(MG + off + bj * HALF) = pack8(v0, v1); } }
    }
};
struct EpiWo {
    static constexpr bool PERM = true, AFTER_DRAIN = false;
    const float *xp, *xs; float* out; bf16_t* A2; const float *mod, *n2g; float* rowss;
    __device__ __forceinline__ void operator()(const f32x4 (&acc)[2][2][4][2], const Unit& u, int wr, int wc, int fr, int fq) const {
        const int m0 = u.pm * BM, b = batch_of(m0), row0 = m0 + wr * 64 + fr, col0 = u.pn * BM + wc * 32 + 8 * fq;
        const float* xb = m0 < 16384 ? xp : xs - (size_t)16384 * 1024;
        const float* g1p = mod + b * 6144 + 2048 + col0; const float* s2p = mod + b * 6144 + 4096 + col0; const float* ngp = n2g + col0;
        f32x4 g1[2][2], gm[2][2];
#pragma unroll
        for (int bj = 0; bj < 2; ++bj)
#pragma unroll
            for (int n = 0; n < 2; ++n) { g1[bj][n] = *(const f32x4*)(g1p + bj * HALF + 4 * n); gm[bj][n] = *(const f32x4*)(ngp + bj * HALF + 4 * n) * (*(const f32x4*)(s2p + bj * HALF + 4 * n) + 1.0f); }
#pragma unroll
        for (int ai = 0; ai < 2; ++ai)
#pragma unroll
            for (int m = 0; m < 4; ++m) { const int r = row0 + ai * HALF + m * 16; const size_t off = (size_t)r * 1024 + col0; float ss = 0.f;
#pragma unroll
                for (int bj = 0; bj < 2; ++bj) {
                    const f32x4 y0 = *(const f32x4*)(xb + off + bj * HALF) + g1[bj][0] * acc[ai][bj][m][0], y1 = *(const f32x4*)(xb + off + bj * HALF + 4) + g1[bj][1] * acc[ai][bj][m][1];
                    *(f32x4*)(out + off + bj * HALF) = y0; *(f32x4*)(out + off + bj * HALF + 4) = y1;
                    ss += (y0[0] * y0[0] + y0[1] * y0[1]) + (y0[2] * y0[2] + y0[3] * y0[3]) + (y1[0] * y1[0] + y1[1] * y1[1]) + (y1[2] * y1[2] + y1[3] * y1[3]);
                    *(u32x4*)(A2 + off + bj * HALF) = pack8(y0 * gm[bj][0], y1 * gm[bj][1]); }
                ss += swz_xor<16>(ss); ss = add_x32(ss);
                if (fq == 0) atomicAdd(rowss + r, ss); }
    }
};
struct EpiUp {
    static constexpr bool PERM = true, AFTER_DRAIN = false;
    bf16_t* H; const float *rowss, *sbias;
    __device__ __forceinline__ void operator()(const f32x4 (&acc)[2][2][4][2], const Unit& u, int wr, int wc, int fr, int fq) const {
        const int m0 = u.pm * BM, b = batch_of(m0), row0 = m0 + wr * 64 + fr, col0 = u.pn * BM + wc * 32 + 8 * fq;
        f32x4 sb[2][2];
#pragma unroll
        for (int bj = 0; bj < 2; ++bj)
#pragma unroll
            for (int n = 0; n < 2; ++n) sb[bj][n] = *(const f32x4*)(sbias + b * 4096 + col0 + bj * HALF + 4 * n);
#pragma unroll
        for (int ai = 0; ai < 2; ++ai)
#pragma unroll
            for (int m = 0; m < 4; ++m) { const int r = row0 + ai * HALF + m * 16; const float rs = __builtin_amdgcn_rsqf(rowss[r] * (1.0f / 1024.0f) + 1e-6f);
                bf16_t* rowp = H + (size_t)r * 4096 + col0;
#pragma unroll
                for (int bj = 0; bj < 2; ++bj) { f32x4 v0 = acc[ai][bj][m][0] * rs + sb[bj][0], v1 = acc[ai][bj][m][1] * rs + sb[bj][1];
#pragma unroll
                    for (int i = 0; i < 4; ++i) { v0[i] = fmaxf(v0[i], 0.f); v1[i] = fmaxf(v1[i], 0.f); }
                    *(u32x4*)(rowp + bj * HALF) = pack8(v0 * v0, v1 * v1); } }
    }
};
struct EpiDown {
    static constexpr bool PERM = true, AFTER_DRAIN = false;
    float* out; const float* mod;
    __device__ __forceinline__ void operator()(const f32x4 (&acc)[2][2][4][2], const Unit& u, int wr, int wc, int fr, int fq) const {
        const int m0 = u.pm * BM, b = batch_of(m0), row0 = m0 + wr * 64 + fr, col0 = u.pn * BM + wc * 32 + 8 * fq;
        const float* g2p = mod + b * 6144 + 5120 + col0;
        f32x4 g2[2][2];
#pragma unroll
        for (int bj = 0; bj < 2; ++bj)
#pragma unroll
            for (int n = 0; n < 2; ++n) g2[bj][n] = *(const f32x4*)(g2p + bj * HALF + 4 * n);
#pragma unroll
        for (int ai = 0; ai < 2; ++ai)
#pragma unroll
            for (int m = 0; m < 4; ++m) { float* rowp = out + (size_t)(row0 + ai * HALF + m * 16) * 1024 + col0;
#pragma unroll
                for (int bj = 0; bj < 2; ++bj) { *(f32x4*)(rowp + bj * HALF) = *(const f32x4*)(rowp + bj * HALF) + g2[bj][0] * acc[ai][bj][m][0]; *(f32x4*)(rowp + bj * HALF + 4) = *(const f32x4*)(rowp + bj * HALF + 4) + g2[bj][1] * acc[ai][bj][m][1]; } }
    }
};
}
namespace att {
#define LASC __attribute__((address_space(3)))
typedef unsigned short bf16;
typedef short bf16x8 __attribute__((ext_vector_type(8)));
typedef short s16x4 __attribute__((ext_vector_type(4)));
typedef short v4i16_t __attribute__((ext_vector_type(4)));
typedef float f32x16 __attribute__((ext_vector_type(16)));
typedef float f32x4 __attribute__((ext_vector_type(4)));
typedef unsigned u32x4 __attribute__((ext_vector_type(4)));
typedef float f32x2_t __attribute__((ext_vector_type(2))); typedef __bf16 bf16x2_t __attribute__((ext_vector_type(2)));
constexpr int CH = 16384;
constexpr float LOG2E = 1.4426950408889634f;
__device__ __forceinline__ int crow(int r, int hi) { return (r & 3) + 8 * (r >> 2) + 4 * hi; }
__device__ __forceinline__ unsigned cvtpk(float lo, float hi) { f32x2_t v = {lo, hi}; bf16x2_t b = __builtin_convertvector(v, bf16x2_t); return __builtin_bit_cast(unsigned, b); }
__device__ __forceinline__ s16x4 vtr(const LASC unsigned char* p) { return __builtin_bit_cast(s16x4, __builtin_amdgcn_ds_read_tr16_b64_v4i16((LASC v4i16_t*)p)); }
#ifndef BK_SH
#define BK_SH 0
#endif
__device__ __forceinline__ int rel_bucket(int rel) {
    const int n = rel < 0 ? -rel : rel; const int ret = rel > 0 ? 16 : 0;
    int v;
    if (n < 8) v = n; else if (n < 12) v = 8; else if (n < 16 + BK_SH) v = 9; else if (n < 23) v = 10; else if (n < 32 + BK_SH) v = 11; else if (n < 46) v = 12; else if (n < 64 + BK_SH) v = 13; else if (n < 91) v = 14; else v = 15;
    return ret + v;
}
__device__ __forceinline__ bf16x8 pack_frag(const f32x16& p, int base) {
    u32x4 w; w.x = cvtpk(p[base], p[base + 1]); w.y = cvtpk(p[base + 2], p[base + 3]); w.z = cvtpk(p[base + 4], p[base + 5]); w.w = cvtpk(p[base + 6], p[base + 7]);
    return __builtin_bit_cast(bf16x8, w);
}
constexpr int DA_K = 0, DA_V = 32768;
constexpr int DA_Q = 81920;
constexpr int DA_BT = 147456;
constexpr int DA_WS = 149504;
constexpr int SC_OFF = 155648;
constexpr int DL_N = 0, DL_D = 131072, DL_T = 131072 + 2048;

__device__ __forceinline__ void da_epilogue(LASC unsigned char* lds, bf16* YA, const float* subln_g, f32x16 (&o1)[4], f32x16 (&o2)[4], float l1, float l2, float lam, int head, int tile0, int qb, int wid);
#define SBAR() __builtin_amdgcn_sched_barrier(0)
__device__ __forceinline__ int lane_now() { int l; asm volatile("v_mbcnt_lo_u32_b32 %0, -1, 0\n\tv_mbcnt_hi_u32_b32 %0, -1, %0" : "=v"(l)); return l; }
__device__ __forceinline__ void da_unit(LASC unsigned char* lds, const bf16* QK, const bf16* VA, bf16* YA, const float* rel_bias, const float* subln_g,
                                        int head, int tile0, int NT, int qb, int tid_in) {
    int tid = tid_in; asm volatile("" : "+v"(tid));
    const int lane = tid & 63, r32 = lane & 31, hi = lane >> 5; const int wid = __builtin_amdgcn_readfirstlane(tid >> 6);
    LASC float* BT = (LASC float*)(lds + DA_BT); const LASC float* SC = (const LASC float*)(lds + SC_OFF);
    const float lam = __builtin_bit_cast(float, __builtin_amdgcn_readfirstlane(__builtin_bit_cast(int, SC[0])));
    if (tid < 448) { const int rel = tid - 224; BT[tid] = rel_bias[rel_bucket(rel) * 32 + head] * LOG2E; }
    const bf16* Q1h = QK + (size_t)(0 * 8 + head) * ((size_t)CH * 64); const bf16* Q2h = QK + (size_t)(1 * 8 + head) * ((size_t)CH * 64);
    const bf16* K1h = QK + (size_t)(2 * 8 + head) * ((size_t)CH * 64) + (size_t)tile0 * 4096; const bf16* K2h = QK + (size_t)(3 * 8 + head) * ((size_t)CH * 64) + (size_t)tile0 * 4096;
    const bf16* Vh = VA + (size_t)head * ((size_t)CH * 128) + (size_t)tile0 * 8192;
#define DA_DMA(t) do { const unsigned lo_ = (unsigned)lane_now() * 16u; LASC unsigned char* dk_ = lds + DA_K + ((t) & 1) * 16384 + wid * 1024; LASC unsigned char* dv_ = lds + DA_V + ((t) % 3) * 16384 + wid * 1024; \
        const char* k1_ = (const char*)K1h + (size_t)(t) * 8192 + wid * 1024; const char* k2_ = (const char*)K2h + (size_t)(t) * 8192 + wid * 1024; const char* v_ = (const char*)Vh + (size_t)(t) * 16384 + wid * 1024;     \
        __builtin_amdgcn_global_load_lds((const unsigned*)(k1_ + lo_), (LASC unsigned*)(dk_), 16, 0, 0); \
        __builtin_amdgcn_global_load_lds((const unsigned*)(k2_ + lo_), (LASC unsigned*)(dk_ + 8192), 16, 0, 0); \
        __builtin_amdgcn_global_load_lds((const unsigned*)(v_ + lo_), (LASC unsigned*)(dv_), 16, 0, 0); \
        __builtin_amdgcn_global_load_lds((const unsigned*)(v_ + 8192 + lo_), (LASC unsigned*)(dv_ + 8192), 16, 0, 0); } while (0)
    DA_DMA(0);
    LASC unsigned char* qlds = lds + DA_Q + wid * 8192 + lane * 16;
    { const int tq = tile0 + 4 * qb + (wid >> 1), rq = (wid & 1) * 32 + r32;
#pragma unroll
      for (int ks = 0; ks < 4; ++ks) { *(LASC bf16x8*)(qlds + ks * 1024) = *(const bf16x8*)(Q1h + (size_t)tq * 4096 + (2 * ks + hi) * 512 + rq * 8);
                                       *(LASC bf16x8*)(qlds + 4096 + ks * 1024) = *(const bf16x8*)(Q2h + (size_t)tq * 4096 + (2 * ks + hi) * 512 + rq * 8); } }
    f32x16 o1[4], o2[4];
#pragma unroll
    for (int d = 0; d < 4; ++d) { o1[d] = f32x16{}; o2[d] = f32x16{}; }
    float l1 = 0.f, l2 = 0.f;
    asm volatile("s_waitcnt vmcnt(0)" ::: "memory");
    __syncthreads();
    const int qw0 = 256 * qb + 32 * wid;
    const int tL = (qw0 >= 191) ? ((qw0 - 191) >> 6) : -1, tR = (qw0 + 159 + 63) >> 6;
    const float fLN = __builtin_bit_cast(float, __builtin_amdgcn_readfirstlane(__builtin_bit_cast(int, __builtin_amdgcn_exp2f(BT[0])))), fNR = __builtin_bit_cast(float, __builtin_amdgcn_readfirstlane(__builtin_bit_cast(int, __builtin_amdgcn_exp2f(-BT[447]))));
    bf16x8 paA1[2], paA2[2], paB1[2], paB2[2];
#pragma unroll
    for (int i = 0; i < 2; ++i) { paB1[i] = bf16x8{}; paB2[i] = bf16x8{}; }
#define DA_NEARC(S_, HALF_) do { const LASC float* bt_ = BT + (64 * t + 32 * (HALF_) - (qw0 + r32) + 4 * hi + 224); \
        _Pragma("unroll") for (int r = 0; r < 16; ++r) S_[r] = bt_[(r & 3) + 8 * (r >> 2)]; } while (0)
#define DA_VRD(DST, F_) do { const s16x4 lo_ = vtr(vp + ((F_) >> 1) * 4096 + ((F_) & 1) * 1024), hh_ = vtr(vp + ((F_) >> 1) * 4096 + ((F_) & 1) * 1024 + 512); DST = (bf16x8){lo_[0], lo_[1], lo_[2], lo_[3], hh_[0], hh_[1], hh_[2], hh_[3]}; } while (0)
#define DA_STEP(KS, HALF, VP, PI1, PI2, PO1, PO2) do { \
        f32x16 s1, s2; const LASC unsigned char* vp; \
        { const int lv_ = lane_now(); vp = (VP) + ((lv_ >> 4) & 1) * 32 + (lv_ & 3) * 8 + (4 * (lv_ >> 5) + ((lv_ & 15) >> 2)) * 64; } \
        { const int ln_ = lane_now(), r32 = ln_ & 31, hi = ln_ >> 5; const LASC unsigned char* kb = (KS) + hi * 1024 + ((HALF) * 32 + r32) * 16; const LASC unsigned char* qlds = lds + DA_Q + wid * 8192 + ln_ * 16; \
          bf16x8 kf[4], qf[4]; \
          _Pragma("unroll") for (int ks = 0; ks < 4; ++ks) { kf[ks] = *(const LASC bf16x8*)(kb + ks * 2048); qf[ks] = *(const LASC bf16x8*)(qlds + ks * 1024); } \
          if (near) { DA_NEARC(s1, HALF); s1 = __builtin_amdgcn_mfma_f32_32x32x16_bf16(kf[0], qf[0], s1, 0, 0, 0); } \
          else s1 = __builtin_amdgcn_mfma_f32_32x32x16_bf16(kf[0], qf[0], (f32x16){}, 0, 0, 0); \
          _Pragma("unroll") for (int ks = 1; ks < 4; ++ks) s1 = __builtin_amdgcn_mfma_f32_32x32x16_bf16(kf[ks], qf[ks], s1, 0, 0, 0); \
          SBAR(); \
          _Pragma("unroll") for (int ks = 0; ks < 4; ++ks) { kf[ks] = *(const LASC bf16x8*)(kb + 8192 + ks * 2048); qf[ks] = *(const LASC bf16x8*)(qlds + 4096 + ks * 1024); } \
          DA_VRD(vf[0], 0); \
          if (near) { DA_NEARC(s2, HALF); s2 = __builtin_amdgcn_mfma_f32_32x32x16_bf16(kf[0], qf[0], s2, 0, 0, 0); } \
          else s2 = __builtin_amdgcn_mfma_f32_32x32x16_bf16(kf[0], qf[0], (f32x16){}, 0, 0, 0); \
          _Pragma("unroll") for (int ks = 1; ks < 4; ++ks) s2 = __builtin_amdgcn_mfma_f32_32x32x16_bf16(kf[ks], qf[ks], s2, 0, 0, 0); } \
        SBAR(); \
        { float sa = 0.f, sb = 0.f; u32x4 w1a, w1b, w2a, w2b; \
            \
          _Pragma("unroll") for (int g = 0; g < 16; ++g) { const int f = g >> 1, d0 = f >> 1, ks = f & 1, sm = g & 1; \
              if (sm == 0) { if (f + 1 < 8) DA_VRD(vf[(f + 1) & 1], f + 1); o1[d0] = __builtin_amdgcn_mfma_f32_32x32x16_bf16(PI1[ks], vf[f & 1], o1[d0], 0, 0, 0); } \
              else o2[d0] = __builtin_amdgcn_mfma_f32_32x32x16_bf16(PI2[ks], vf[f & 1], o2[d0], 0, 0, 0); \
              if (g < 8) { const float e0 = __builtin_amdgcn_exp2f(s1[2 * g]), e1 = __builtin_amdgcn_exp2f(s1[2 * g + 1]); sa += e0; sa += e1; unsigned w = cvtpk(e0, e1); asm volatile("" : "+v"(w), "+v"(sa)); if (g < 4) w1a[g] = w; else w1b[g - 4] = w; } \
              else { const int g2 = g - 8; const float e0 = __builtin_amdgcn_exp2f(s2[2 * g2]), e1 = __builtin_amdgcn_exp2f(s2[2 * g2 + 1]); sb += e0; sb += e1; unsigned w = cvtpk(e0, e1); asm volatile("" : "+v"(w), "+v"(sb)); if (g2 < 4) w2a[g2] = w; else w2b[g2 - 4] = w; } \
              SBAR(); } \
          l1 += sa; l2 += sb; \
          PO1[0] = __builtin_bit_cast(bf16x8, w1a); PO1[1] = __builtin_bit_cast(bf16x8, w1b); PO2[0] = __builtin_bit_cast(bf16x8, w2a); PO2[1] = __builtin_bit_cast(bf16x8, w2b); } \
    } while (0)
    bf16x8 vf[2];
    for (int t = 0; t < NT; ++t) {
        if (t + 1 < NT) DA_DMA(t + 1);
        const bool near = (t > tL) && (t < tR);
        const bool trans = (t == tL + 1 && tL >= 0) || (t == tR);
        const float f = (t == tR) ? fNR : fLN;
        const LASC unsigned char* ks_ = lds + DA_K + (t & 1) * 16384;
        const int tp = t > 0 ? t - 1 : 0;
        const LASC unsigned char* vprev = lds + DA_V + (tp % 3) * 16384 + (t > 0 ? 2048 : 0);
        const LASC unsigned char* vcur = lds + DA_V + (t % 3) * 16384;
        if (trans) { l1 *= f; l2 *= f; }
        DA_STEP(ks_, 0, vprev, paB1, paB2, paA1, paA2);
        if (trans) {
#pragma unroll
            for (int d = 0; d < 4; ++d) { o1[d] *= f; o2[d] *= f; } }
        DA_STEP(ks_, 1, vcur, paA1, paA2, paB1, paB2);
        asm volatile("s_waitcnt vmcnt(0)" ::: "memory");
        __syncthreads();
    }
    { const int ln_ = lane_now(); const LASC unsigned char* vp = lds + DA_V + ((NT - 1) % 3) * 16384 + 2048 + ((ln_ >> 4) & 1) * 32 + (ln_ & 3) * 8 + (4 * (ln_ >> 5) + ((ln_ & 15) >> 2)) * 64;
#pragma unroll
      for (int d0 = 0; d0 < 4; ++d0)
#pragma unroll
          for (int ks = 0; ks < 2; ++ks) { const s16x4 lo = vtr(vp + d0 * 4096 + ks * 1024), hh = vtr(vp + d0 * 4096 + ks * 1024 + 512); const bf16x8 vf = (bf16x8){lo[0], lo[1], lo[2], lo[3], hh[0], hh[1], hh[2], hh[3]};
              o1[d0] = __builtin_amdgcn_mfma_f32_32x32x16_bf16(paB1[ks], vf, o1[d0], 0, 0, 0); o2[d0] = __builtin_amdgcn_mfma_f32_32x32x16_bf16(paB2[ks], vf, o2[d0], 0, 0, 0); } }
    __syncthreads();
#undef DA_DMA
#undef DA_STEP
#undef DA_NEARC
#undef DA_VRD
    da_epilogue(lds, YA, subln_g, o1, o2, l1, l2, lam, head, tile0, qb, wid);
}
__device__ __forceinline__ void da_epilogue(LASC unsigned char* lds, bf16* YA, const float* subln_g, f32x16 (&o1)[4], f32x16 (&o2)[4], float l1, float l2, float lam, int head, int tile0, int qb, int wid) {
    const int lane = lane_now(), r32 = lane & 31, hi = lane >> 5;
    LASC float* wsf = (LASC float*)(lds + DA_WS) + wid * 128;
    l1 = add_x32(l1); l2 = add_x32(l2);
    if (hi == 0) { wsf[r32] = l1; wsf[32 + r32] = l2; }
    asm volatile("s_waitcnt lgkmcnt(0)" ::: "memory");
    float sg[4];
#pragma unroll
    for (int d0 = 0; d0 < 4; ++d0) sg[d0] = subln_g[32 * d0 + r32] * 0.8f;
    LASC bf16* stg = (LASC bf16*)(lds + wid * 8192);
#pragma unroll
    for (int r = 0; r < 16; ++r) {
        const int row = crow(r, hi); const float i1 = __builtin_amdgcn_rcpf(wsf[row]), i2 = lam * __builtin_amdgcn_rcpf(wsf[32 + row]);
        float v[4]; float ss = 0.f;
#pragma unroll
        for (int d0 = 0; d0 < 4; ++d0) { v[d0] = o1[d0][r] * i1 - o2[d0][r] * i2; ss += v[d0] * v[d0]; }
        ss += swz_xor<1>(ss); ss += swz_xor<2>(ss); ss += swz_xor<4>(ss); ss += swz_xor<8>(ss); ss += swz_xor<16>(ss);
        const float rs = __builtin_amdgcn_rsqf(ss * (1.0f / 128.0f) + 1e-6f);
#pragma unroll
        for (int d0 = 0; d0 < 4; ++d0) stg[row * 128 + d0 * 32 + r32] = (bf16)(cvtpk(v[d0] * rs * sg[d0], 0.f) & 0xffffu);
    }
    asm volatile("s_waitcnt lgkmcnt(0)" ::: "memory");
    { bf16* Yw = YA + (size_t)((tile0 + 4 * qb) * 64 + wid * 32) * 1024 + head * 128;
#pragma unroll
      for (int i = 0; i < 8; ++i) { const int row = i * 4 + (lane >> 4), ch = lane & 15; const u32x4 v = *(const LASC u32x4*)(stg + row * 128 + ch * 8); *(u32x4*)(Yw + (size_t)row * 1024 + ch * 8) = v; } }
    __syncthreads();
}

__device__ __forceinline__ void dil_task(const bf16* Qh, const bf16* Kh, const bf16* Vh, int drq0, int lq0, int L, int r, int tok_base, const LASC float* DBT, LASC float* Nsum, LASC float* Dsum, int lane) {
    const int r32 = lane & 31, hi = lane >> 5;
    bf16x8 qf[4];
#pragma unroll
    for (int ks = 0; ks < 4; ++ks) qf[ks] = *(const bf16x8*)(Qh + (size_t)(drq0 >> 6) * 4096 + (2 * ks + hi) * 512 + ((drq0 & 63) + r32) * 8);
    f32x16 o[2]; o[0] = f32x16{}; o[1] = f32x16{}; float l = 0.f;
    for (int s5 = 0; s5 < 5; ++s5) {
        const int lk0 = lq0 - 64 + 32 * s5; if (lk0 < 0 || lk0 >= L) continue;
        const int drk0 = drq0 + (lk0 - lq0);
        const int jb = lk0 - lq0 - r32 + 4 * hi + 96;
        f32x16 p;
#pragma unroll
        for (int rg = 0; rg < 16; ++rg) p[rg] = DBT[jb + (rg & 3) + 8 * (rg >> 2)];
#pragma unroll
        for (int ks = 0; ks < 4; ++ks) { const bf16x8 kf = *(const bf16x8*)(Kh + (size_t)(drk0 >> 6) * 4096 + (2 * ks + hi) * 512 + ((drk0 & 63) + r32) * 8); p = __builtin_amdgcn_mfma_f32_32x32x16_bf16(kf, qf[ks], p, 0, 0, 0); }
        float s = 0.f;
#pragma unroll
        for (int rg = 0; rg < 16; ++rg) { p[rg] = __builtin_amdgcn_exp2f(p[rg]); s += p[rg]; }
        l += s;
        const bf16x8 pa0 = pack_frag(p, 0), pa1 = pack_frag(p, 8);
#pragma unroll
        for (int db = 0; db < 2; ++db) {
            bf16x8 v0, v1; const bf16* vb = Vh + (size_t)(drk0 + 4 * hi) * 64 + 32 * db + r32;
#pragma unroll
            for (int j = 0; j < 8; ++j) { v0[j] = (short)vb[(size_t)((j & 3) + 8 * (j >> 2)) * 64]; v1[j] = (short)vb[(size_t)(16 + (j & 3) + 8 * (j >> 2)) * 64]; }
            o[db] = __builtin_amdgcn_mfma_f32_32x32x16_bf16(pa0, v0, o[db], 0, 0, 0); o[db] = __builtin_amdgcn_mfma_f32_32x32x16_bf16(pa1, v1, o[db], 0, 0, 0);
        }
    }
    l = add_x32(l);
    if (hi == 0) __hip_atomic_fetch_add(Dsum + tok_base + r32 * r, l, __ATOMIC_RELAXED, __HIP_MEMORY_SCOPE_WORKGROUP);
#pragma unroll
    for (int db = 0; db < 2; ++db)
#pragma unroll
        for (int rg = 0; rg < 16; ++rg) __hip_atomic_fetch_add(Nsum + (tok_base + crow(rg, hi) * r) * 64 + 32 * db + r32, o[db][rg], __ATOMIC_RELAXED, __HIP_MEMORY_SCOPE_WORKGROUP);
}
__device__ __forceinline__ void dil_unit(LASC unsigned char* lds, const bf16* DIL, bf16* YB, const float* rel_bias, int head, int span, int S, int lgS, int tid_in) {
    int tid = tid_in; asm volatile("" : "+v"(tid));
    const int lane = tid & 63; const int wid = __builtin_amdgcn_readfirstlane(tid >> 6);
    LASC float* Nsum = (LASC float*)(lds + DL_N); LASC float* Dsum = (LASC float*)(lds + DL_D); LASC float* DBT = (LASC float*)(lds + DL_T); const LASC float* SC = (const LASC float*)(lds + SC_OFF);
    const float M2 = SC[2];
    for (int i = tid; i < (512 * 64 + 512) / 4; i += 512) ((LASC f32x4*)Nsum)[i] = (f32x4){0.f, 0.f, 0.f, 0.f};
    for (int i = tid; i < 600; i += 512) { const int g = i / 200, j = i % 200 - 96; const int aj = j < 0 ? -j : j;
        DBT[i] = (aj <= 64) ? rel_bias[rel_bucket(j * (1 << (2 * g))) * 32 + 8 + 8 * g + head] * LOG2E - M2 : -1e30f; }
    __syncthreads();
    const int row0 = span * 512, seqbase = row0 & ~(S - 1), t0 = row0 & (S - 1);
    for (int tk = wid; tk < 48; tk += 8) {
        const int g = tk >> 4, j = tk & 15, lgr = 2 * g, r = 1 << lgr, L = S >> lgr;
        const int nblk = 16 >> lgr, cl = j / nblk, blk = j % nblk, lq0 = (t0 >> lgr) + 32 * blk;
        const bf16* Qh = DIL + (size_t)((g * 3 + 0) * 8 + head) * ((size_t)CH * 64); const bf16* Kh = DIL + (size_t)((g * 3 + 1) * 8 + head) * ((size_t)CH * 64); const bf16* Vh = DIL + (size_t)((g * 3 + 2) * 8 + head) * ((size_t)CH * 64);
        dil_task(Qh, Kh, Vh, seqbase + cl * L + lq0, lq0, L, r, lq0 * r + cl - t0, DBT + 200 * g, Nsum, Dsum, lane);
    }
    __syncthreads();
#pragma unroll
    for (int i = 0; i < 8; ++i) { const int row = (tid >> 3) + 64 * i, dc = tid & 7; const float inv = 1.0f / Dsum[row];
        const f32x4 a = *(const LASC f32x4*)(Nsum + row * 64 + dc * 8), b = *(const LASC f32x4*)(Nsum + row * 64 + dc * 8 + 4);
        u32x4 w; w.x = cvtpk(a[0] * inv, a[1] * inv); w.y = cvtpk(a[2] * inv, a[3] * inv); w.z = cvtpk(b[0] * inv, b[1] * inv); w.w = cvtpk(b[2] * inv, b[3] * inv);
        *(u32x4*)(YB + (size_t)(row0 + row) * 512 + head * 64 + dc * 8) = w; }
    __syncthreads();
}
}
#define LAS __attribute__((address_space(3)))
typedef unsigned short bf16;
typedef unsigned v4u __attribute__((ext_vector_type(4)));
typedef float f32x4 __attribute__((ext_vector_type(4)));
constexpr int NWAVES = 8, LDS_BYTES = 163840, BST_OFF = 163840 - 64;
constexpr int TOK = 32768, DM = 1024, CH = 16384, FF = 4096, NIN = 9728;
constexpr size_t MiB = 1u << 20;
constexpr size_t WS_MOD = 1 * MiB, WS_SBIAS = WS_MOD + 160 * 1024, WS_ROWSS = WS_MOD + 320 * 1024;
constexpr size_t WS_WIN = 2 * MiB, WS_WBA = 21 * MiB, WS_WBB = 23 * MiB, WS_WO = 24 * MiB, WS_WUP = 26 * MiB, WS_WDN = 34 * MiB;
constexpr size_t WS_QK = 42 * MiB, WS_VA = 106 * MiB, WS_DIL = 138 * MiB, WS_GT = 282 * MiB, WS_MG = 346 * MiB, WS_END = 410 * MiB;
constexpr size_t WS_A2 = 42 * MiB, WS_H = 106 * MiB;
constexpr size_t DO_XN = 0, DO_YA = 64 * MiB, DO_YB = 96 * MiB;
#define LDS_WAIT() asm volatile("s_waitcnt lgkmcnt(0)" ::: "memory")
#define XB_TMO      128
#define XB_XCNT(j)  (256  + 64 * (j))
#define XB_XSUB(j)  (1280 + 64 * (j))
#define XB_XGEN(j)  (2304 + 64 * (j))
#define XB_TOP      3328
#define XB_TOPGEN   3392
#define XCD_BAR_WORDS 3456
#define XB_SPIN_CAP (1u << 18)

__device__ __forceinline__ unsigned xb_ld(unsigned* p)              { return __hip_atomic_load(p, __ATOMIC_RELAXED, __HIP_MEMORY_SCOPE_AGENT); }
__device__ __forceinline__ unsigned xb_add(unsigned* p, unsigned v) { return __hip_atomic_fetch_add(p, v, __ATOMIC_RELAXED, __HIP_MEMORY_SCOPE_AGENT); }
__device__ __forceinline__ unsigned xb_xcc_id() { return (unsigned)__builtin_amdgcn_s_getreg((3 << 11) | 20) & 0xFu; }
#define XB_SPIN(cond, bar) do { unsigned _sp = 0; while (cond) { __builtin_amdgcn_s_sleep(1); \
    if ((++_sp & 255u) == 0u) { if (xb_ld(&(bar)[XB_TMO])) break; if (_sp > XB_SPIN_CAP) { atomicAdd(&(bar)[XB_TMO], 1u); break; } } } } while (0)

struct XcdBarrier {
    unsigned* bar; unsigned x;
    volatile LAS unsigned* st;
};

__device__ __forceinline__ XcdBarrier xcd_barrier_post(unsigned* bar, volatile LAS unsigned* st) {
    XcdBarrier b; b.bar = bar; b.x = xb_xcc_id(); b.st = st;
    if (threadIdx.x == 0) (void)xb_add(&bar[XB_XCNT(b.x)], 1u);
    return b;
}
__device__ __forceinline__ void xcd_barrier_complete(unsigned* bar, unsigned x, unsigned& nloc, unsigned& nx) {
    const unsigned G = gridDim.x * gridDim.y * gridDim.z;
    unsigned sum, cnt, mine, sp = 0u;
    for (;;) {
        sum = 0u; cnt = 0u; mine = 0u;
#pragma unroll
        for (unsigned j = 0; j < 16; ++j) { const unsigned c = xb_ld(&bar[XB_XCNT(j)]); sum += c; cnt += (c > 0u) ? 1u : 0u; mine = (j == x) ? c : mine; }
        if (sum == G) break;
        __builtin_amdgcn_s_sleep(1);
        if ((++sp & 255u) == 0u) { if (xb_ld(&bar[XB_TMO])) break; if (sp > XB_SPIN_CAP) { atomicAdd(&bar[XB_TMO], 1u); break; } }
    }
    nloc = mine > 0u ? mine : 1u; nx = cnt > 0u ? cnt : 1u;
}

__device__ __forceinline__ void xcd_barrier(const XcdBarrier& b) {
    asm volatile("s_waitcnt vmcnt(0)" ::: "memory");
    __syncthreads();
    if (threadIdx.x == 0) {
        unsigned* bar = b.bar;
        __builtin_amdgcn_s_waitcnt(0);
        unsigned nloc = b.st[0], nx = b.st[1];
        if (nloc == 0u) { xcd_barrier_complete(bar, b.x, nloc, nx); b.st[0] = nloc; b.st[1] = nx; }
        const unsigned old = xb_add(&bar[XB_XSUB(b.x)], 1u);
        const unsigned gen = old / nloc;
        if (old + 1u == (gen + 1u) * nloc) {
            __builtin_amdgcn_fence(__ATOMIC_RELEASE, "agent");
            asm volatile("s_waitcnt vmcnt(0)" ::: "memory");
            const unsigned og = xb_add(&bar[XB_TOP], 1u);
            const unsigned tg = og / nx;
            if (og + 1u == (tg + 1u) * nx) xb_add(&bar[XB_TOPGEN], 1u);
            else XB_SPIN(xb_ld(&bar[XB_TOPGEN]) == tg, bar);
            __builtin_amdgcn_fence(__ATOMIC_ACQUIRE, "agent");
            xb_add(&bar[XB_XGEN(b.x)], 1u);
            asm volatile("s_waitcnt vmcnt(0)" ::: "memory");
        } else {
            XB_SPIN(xb_ld(&bar[XB_XGEN(b.x)]) == gen, bar);
            __builtin_amdgcn_fence(__ATOMIC_ACQUIRE, "agent");
            asm volatile("s_waitcnt vmcnt(0)" ::: "memory");
        }
    }
    __syncthreads();
}

__device__ __forceinline__ unsigned f2bf(float f) { unsigned u = __builtin_bit_cast(unsigned, f); return (u + 0x7fffu + ((u >> 16) & 1u)) >> 16; }
__device__ __forceinline__ unsigned pk2(float lo, float hi) { return f2bf(lo) | (f2bf(hi) << 16); }
__device__ __forceinline__ float wave_sum(float v) {
    v += swz_xor<1>(v); v += swz_xor<2>(v); v += swz_xor<4>(v); v += swz_xor<8>(v); v += swz_xor<16>(v);
    return add_x32(v);
}
__device__ __forceinline__ float wave_max(float v) {
    v = fmaxf(v, swz_xor<1>(v)); v = fmaxf(v, swz_xor<2>(v)); v = fmaxf(v, swz_xor<4>(v)); v = fmaxf(v, swz_xor<8>(v)); v = fmaxf(v, swz_xor<16>(v));
    return max_x32(v);
}
template <bool PERMW> __device__ __forceinline__ void transpose_item(const float* W, int K, int N, bf16* WT, LAS float* scr, int item, int lane) {
    const int nblk = N / 32, kb = item / nblk, nb = item % nblk, k0 = 64 * kb, n0 = 32 * nb;
#pragma unroll 8
    for (int i = 0; i < 32; ++i) { const int kk = 2 * i + (lane >> 5); scr[kk * 33 + (lane & 31)] = W[(size_t)(k0 + kk) * N + n0 + (lane & 31)]; }
    LDS_WAIT(); asm volatile("" ::: "memory");
    const int c = lane & 7;
    int n0p = n0; if (PERMW) { const int lg = nb & 7; n0p = (nb & ~7) * 32 + 32 * (4 * (lg & 1) + (lg >> 1)); }
#pragma unroll
    for (int j = 0; j < 4; ++j) { const int n = (lane >> 3) + 8 * j; const LAS float* s = scr + (8 * c) * 33 + n;
        v4u o; o.x = pk2(s[0 * 33], s[1 * 33]); o.y = pk2(s[2 * 33], s[3 * 33]); o.z = pk2(s[4 * 33], s[5 * 33]); o.w = pk2(s[6 * 33], s[7 * 33]);
        *(v4u*)(WT + (size_t)(n0p + n) * K + k0 + 8 * c) = o; }
    LDS_WAIT(); asm volatile("" ::: "memory");
}
__device__ __forceinline__ void gemv6_task(const LAS float* vec, LAS f32x4* red, const float* W, int N, int col0, const float* bias, float* out, int tid) {
    const int cgp = tid & 7, ks = tid >> 3;
    f32x4 acc[6];
#pragma unroll
    for (int b = 0; b < 6; ++b) acc[b] = (f32x4){0.f, 0.f, 0.f, 0.f};
#pragma unroll 4
    for (int kk = 0; kk < 16; ++kk) { const int k = ks * 16 + kk; const f32x4 w = *(const f32x4*)(W + (size_t)k * N + col0 + 4 * cgp);
#pragma unroll
        for (int b = 0; b < 6; ++b) acc[b] += w * vec[b * 1024 + k]; }
#pragma unroll
    for (int b = 0; b < 6; ++b) red[(ks * 8 + cgp) * 6 + b] = acc[b];
    __syncthreads();
    if (tid < 192) { const int b = tid >> 5, c = tid & 31; float s = 0.f; const LAS float* rf = (const LAS float*)red;
        for (int k2 = 0; k2 < 64; ++k2) s += rf[((k2 * 8 + (c >> 2)) * 6 + b) * 4 + (c & 3)];
        out[b * N + col0 + c] = s + (bias ? bias[col0 + c] : 0.f); }
    __syncthreads();
}

struct Args { const float* in[24]; float* out; unsigned char* ws; int ph_lo, ph_hi; };
constexpr int NPHASE = 11;

__global__ void __launch_bounds__(NWAVES * 64, 2) mk_fwd(Args a) {
    extern __shared__ __attribute__((aligned(16))) unsigned char lds_raw[];
    cg::grid_group grid = cg::this_grid();
    LAS unsigned char* lds = (LAS unsigned char*)lds_raw;
    const int wave = __builtin_amdgcn_readfirstlane((int)threadIdx.x >> 6);
#define lane (att::lane_now())
#define tid ((wave << 6) | att::lane_now())
    const int G = gridDim.x; const int bx = blockIdx.x; const int vcu = (G % 8 == 0) ? (bx % 8) * (G / 8) + bx / 8 : bx;
    const int gw = vcu * NWAVES + wave, NGW = G * NWAVES;
    unsigned char* ws = a.ws; unsigned char* dob = (unsigned char*)a.out;
    const float *x_p = a.in[0], *x_s = a.in[1], *c_p = a.in[2], *c_s = a.in[3], *rel_bias = a.in[4], *norm1_g = a.in[5], *w_ada = a.in[6], *b_ada = a.in[7], *w_in = a.in[8],
                *qn_a = a.in[9], *kn_a = a.in[10], *lq1 = a.in[11], *lk1 = a.in[12], *lq2 = a.in[13], *lk2 = a.in[14], *subln_g = a.in[15], *qn_b = a.in[16], *kn_b = a.in[17],
                *w_br_a = a.in[18], *w_br_b = a.in[19], *w_o = a.in[20], *norm2_g = a.in[21], *w_up = a.in[22], *w_down = a.in[23];
    float* mod = (float*)(ws + WS_MOD); float* sbias = (float*)(ws + WS_SBIAS); float* rowss = (float*)(ws + WS_ROWSS);
    bf16 *WinT = (bf16*)(ws + WS_WIN), *WbaT = (bf16*)(ws + WS_WBA), *WbbT = (bf16*)(ws + WS_WBB), *WoT = (bf16*)(ws + WS_WO), *WupT = (bf16*)(ws + WS_WUP), *WdnT = (bf16*)(ws + WS_WDN);
    bf16 *QK = (bf16*)(ws + WS_QK), *VA = (bf16*)(ws + WS_VA), *DIL = (bf16*)(ws + WS_DIL), *GT = (bf16*)(ws + WS_GT), *MG = (bf16*)(ws + WS_MG), *A2 = (bf16*)(ws + WS_A2), *HB = (bf16*)(ws + WS_H);
    bf16 *XN = (bf16*)(dob + DO_XN), *YA = (bf16*)(dob + DO_YA), *YB = (bf16*)(dob + DO_YB);
    const int lo = a.ph_lo, hi = a.ph_hi;
    volatile LAS unsigned* bst = (volatile LAS unsigned*)(lds + BST_OFF);
    if (threadIdx.x < 4) bst[threadIdx.x] = 0u;
    __syncthreads();
    const XcdBarrier xbar = xcd_barrier_post((unsigned*)ws, bst);
#ifndef PH_MASK
#define PH_MASK 0x7ff
#endif
#define PH_ON(k) ((PH_MASK >> (k)) & 1)
#ifndef PH_REP
#define PH_REP 0
#endif
#define NREP(k) ((((PH_REP) >> (k)) & 1) ? 2 : 1)
#define IN(k) (lo <= (k) && (k) < hi)
#ifndef XSYNC
#define XSYNC 0
#endif
#define SEAM(k) do { if (IN(k) && IN((k) + 1)) { if ((k) == 0) grid.sync(); else xcd_barrier(xbar); for (int xs_ = 0; xs_ < XSYNC; ++xs_) xcd_barrier(xbar); } } while (0)

    if (PH_ON(0) && IN(0)) for (int rep_ = 0; rep_ < NREP(0); ++rep_) {
        LAS float* scr = (LAS float*)(lds + wave * 16384);
        constexpr int I_IN = (DM / 64) * (NIN / 32), I_BA = (DM / 64) * (DM / 32), I_BB = (512 / 64) * (DM / 32), I_O = I_BA, I_UP = (DM / 64) * (FF / 32), I_DN = (FF / 64) * (DM / 32);
        constexpr int NITEMS = I_IN + I_BA + I_BB + I_O + I_UP + I_DN;
        for (int it = gw; it < NITEMS; it += NGW) {
            int r = it;
            if (r < I_IN) { transpose_item<true>(w_in, DM, NIN, WinT, scr, r, lane); continue; } r -= I_IN;
            if (r < I_BA) { transpose_item<false>(w_br_a, DM, DM, WbaT, scr, r, lane); continue; } r -= I_BA;
            if (r < I_BB) { transpose_item<false>(w_br_b, 512, DM, WbbT, scr, r, lane); continue; } r -= I_BB;
            if (r < I_O) { transpose_item<false>(w_o, DM, DM, WoT, scr, r, lane); continue; } r -= I_O;
            if (r < I_UP) { transpose_item<false>(w_up, DM, FF, WupT, scr, r, lane); continue; } r -= I_UP;
            transpose_item<false>(w_down, FF, DM, WdnT, scr, r, lane);
        }
        for (int i = gw * 64 + lane; i < TOK; i += NGW * 64) rowss[i] = 0.f;
        __syncthreads();
        LAS float* vec = (LAS float*)lds; LAS f32x4* red = (LAS f32x4*)(lds + 32768);
        for (int i = tid; i < 6 * 1024; i += 512) { const int b = i >> 10, k = i & 1023; const float c = b < 4 ? c_p[b * 1024 + k] : c_s[(b - 4) * 1024 + k]; vec[i] = c / (1.0f + __expf(-c)); }
        __syncthreads();
        for (int task = vcu; task < 6144 / 32; task += G) gemv6_task(vec, red, w_ada, 6144, task * 32, b_ada, mod, tid);
        __syncthreads();
    }
    SEAM(0);
    if (PH_ON(1) && IN(1)) for (int rep_ = 0; rep_ < NREP(1); ++rep_) {
        for (int m = gw; m < TOK; m += NGW) {
            const float* xr = m < 16384 ? x_p + (size_t)m * 1024 : x_s + (size_t)(m - 16384) * 1024; const int b = pg8::batch_of(m);
            const float* sh1 = mod + b * 6144; const float* sc1 = mod + b * 6144 + 1024;
            f32x4 v[4]; float s = 0.f;
#pragma unroll
            for (int j = 0; j < 4; ++j) { v[j] = ((const f32x4*)xr)[lane + 64 * j]; s += (v[j].x * v[j].x + v[j].y * v[j].y) + (v[j].z * v[j].z + v[j].w * v[j].w); }
            const float rstd = 1.0f / sqrtf(wave_sum(s) * (1.0f / 1024.0f) + 1e-6f);
            unsigned long long* o8 = (unsigned long long*)(XN + (size_t)m * 1024) + lane;
#pragma unroll
            for (int j = 0; j < 4; ++j) { const int c = 4 * lane + 256 * j; const f32x4 g = *(const f32x4*)(norm1_g + c), sc = *(const f32x4*)(sc1 + c), sh = *(const f32x4*)(sh1 + c);
                const f32x4 h = v[j] * rstd * g * (sc + 1.0f) + sh;
                o8[64 * j] = (unsigned long long)pk2(h.x, h.y) | ((unsigned long long)pk2(h.z, h.w) << 32); }
        }
        __syncthreads();
        LAS float* vec = (LAS float*)lds; LAS f32x4* red = (LAS f32x4*)(lds + 32768);
        for (int i = tid; i < 6 * 1024; i += 512) { const int b = i >> 10, k = i & 1023; vec[i] = mod[b * 6144 + 3072 + k]; }
        __syncthreads();
        for (int task = vcu; task < FF / 32; task += G) gemv6_task(vec, red, w_up, FF, task * 32, nullptr, sbias, tid);
        __syncthreads();
    }
    SEAM(1);
#pragma unroll 1
    for (int c = 0; c < 2; ++c) {
        const int S = c == 0 ? 4096 : 8192, lgS = c == 0 ? 12 : 13;
        if (PH_ON(2) && IN(2 + 3 * c)) for (int rep_ = 0; rep_ < NREP(2); ++rep_) {
            pg8::Gemm g{XN + (size_t)c * CH * DM, WinT, CH, NIN, DM}; pg8::StaticOrder SO; SO.init(CH, NIN, G, bx);
            pg8::EpiProj E{QK, VA, DIL, GT, qn_a, kn_a, qn_b, kn_b, S, lgS};
            pg8::gemm_phase<pg8::EpiProj, pg8::StaticOrder, true, true>(lds, g, SO, E);
        }
        SEAM(2 + 3 * c);
        if (PH_ON(3) && IN(3 + 3 * c)) for (int rep_ = 0; rep_ < NREP(3); ++rep_) {
            if (wave == 0) {
                const int ln = lane;
                const float a1 = wave_sum(lq1[ln] * lk1[ln]), a2 = wave_sum(lq2[ln] * lk2[ln]);
                const float gqa = wave_max(fabsf(qn_a[ln])), gka = wave_max(fabsf(kn_a[ln]));
                float gb = 0.f;
#pragma unroll
                for (int g = 0; g < 3; ++g) gb = fmaxf(gb, wave_max(fabsf(qn_b[64 * g + ln])) * wave_max(fabsf(kn_b[64 * g + ln])));
                float ba = 0.f, bb = 0.f;
                for (int i = ln; i < 1024; i += 64) { const float v = fabsf(rel_bias[i]); if ((i & 31) < 8) ba = fmaxf(ba, v); else bb = fmaxf(bb, v); }
                ba = wave_max(ba); bb = wave_max(bb);
                if (ln == 0) { LAS float* SC = (LAS float*)(lds + att::SC_OFF); SC[0] = __expf(a1) - __expf(a2) + 0.2f; SC[1] = (8.0f * gqa * gka + ba) * att::LOG2E; SC[2] = (8.0f * gb + bb) * att::LOG2E; }
            }
            __syncthreads();
            { const int span = vcu >> 3, head = vcu & 7;
#ifndef NO_DIL
#ifndef REP_DIL
#define REP_DIL 1
#endif
              for (int rd_ = 0; rd_ < REP_DIL; ++rd_)
              for (int u = vcu; u < 256; u += G) att::dil_unit(lds, DIL, YB, rel_bias, u & 7, u >> 3, S, lgS, tid);
#endif
              (void)span; (void)head; }
            { const int nqb = S / 256;
#ifndef NO_DA
              for (int u = vcu; u < 512; u += G) { const int sh = u / nqb, qb = u % nqb, seq = sh >> 3, head = sh & 7;
                  att::da_unit(lds, QK, VA, YA, rel_bias, subln_g, head, seq * (S / 64), S / 64, qb, tid); }
#endif
              (void)nqb; }
        }
        SEAM(3 + 3 * c);
        if (PH_ON(4) && IN(4 + 3 * c)) for (int rep_ = 0; rep_ < NREP(4); ++rep_) {
#ifndef NO_P3A
            { pg8::Gemm g{YB, WbbT, CH, DM, 512}; pg8::StaticOrder SO; SO.init(CH, DM, G, bx);
              pg8::EpiBr<false> E{MG + (size_t)c * CH * DM, GT + (size_t)CH * 1024};
              pg8::gemm_phase<pg8::EpiBr<false>, pg8::StaticOrder, true, true>(lds, g, SO, E); }
#endif
            asm volatile("s_waitcnt vmcnt(0)" ::: "memory"); __syncthreads();
#ifndef NO_P3B
            { pg8::Gemm g{YA, WbaT, CH, DM, DM}; pg8::StaticOrder SO; SO.init(CH, DM, G, bx);
              pg8::EpiBr<true> E{MG + (size_t)c * CH * DM, GT};
              pg8::gemm_phase<pg8::EpiBr<true>, pg8::StaticOrder, true, true>(lds, g, SO, E); }
#endif
        }
        SEAM(4 + 3 * c);
    }
    if (PH_ON(8) && IN(8)) for (int rep_ = 0; rep_ < NREP(8); ++rep_) {
        pg8::Gemm g{MG, WoT, TOK, DM, DM}; pg8::StaticOrder SO; SO.init(TOK, DM, G, bx);
        pg8::EpiWo E{x_p, x_s, a.out, A2, mod, norm2_g, rowss};
        pg8::gemm_phase<pg8::EpiWo, pg8::StaticOrder, true, true>(lds, g, SO, E);
    }
    SEAM(8);
    if (PH_ON(9) && IN(9)) for (int rep_ = 0; rep_ < NREP(9); ++rep_) {
        pg8::Gemm g{A2, WupT, TOK, FF, DM}; pg8::StaticOrder SO; SO.init(TOK, FF, G, bx);
        pg8::EpiUp E{HB, rowss, sbias};
        pg8::gemm_phase<pg8::EpiUp, pg8::StaticOrder, true, true>(lds, g, SO, E);
    }
    SEAM(9);
    if (PH_ON(10) && IN(10)) for (int rep_ = 0; rep_ < NREP(10); ++rep_) {
        pg8::Gemm g{HB, WdnT, TOK, DM, FF}; pg8::StaticOrder SO; SO.init(TOK, DM, G, bx);
        pg8::EpiDown E{a.out, mod};
        pg8::gemm_phase<pg8::EpiDown, pg8::StaticOrder, true, true>(lds, g, SO, E);
    }
#undef IN
#undef SEAM
#undef lane
#undef tid
}

extern "C" void kernel_launch(void* const* d_in, const int* in_sizes, int n_in, void* d_out, int out_size, void* d_ws, size_t ws_size, hipStream_t stream) {
    static int grid = 0;
    if (grid == 0) {
        if (n_in != 24 || out_size != TOK * DM || ws_size < WS_END) { fprintf(stderr, "kernel_launch: unexpected shapes (n_in %d, out %d, ws %zu)\n", n_in, out_size, ws_size); grid = -1; return; }
        int dev = 0, cus = 0, per_cu = 0;
        if (hipGetDevice(&dev) != hipSuccess || hipDeviceGetAttribute(&cus, hipDeviceAttributeMultiprocessorCount, dev) != hipSuccess) { grid = -1; return; }
        if (hipFuncSetAttribute((const void*)mk_fwd, hipFuncAttributeMaxDynamicSharedMemorySize, LDS_BYTES) != hipSuccess) { fprintf(stderr, "kernel_launch: hipFuncSetAttribute failed\n"); grid = -1; return; }
        if (hipOccupancyMaxActiveBlocksPerMultiprocessor(&per_cu, (const void*)mk_fwd, NWAVES * 64, LDS_BYTES) != hipSuccess || per_cu < 1) { fprintf(stderr, "kernel_launch: occupancy query says %d\n", per_cu); per_cu = 1; }
        (void)hipGetLastError();
        grid = cus;
    }
    if (grid < 0) return;
    if (hipMemsetAsync(d_ws, 0, 65536, stream) != hipSuccess) { fprintf(stderr, "kernel_launch: hipMemsetAsync failed\n"); return; }
    Args a{};
    for (int i = 0; i < 24; ++i) a.in[i] = (const float*)d_in[i];
    a.out = (float*)d_out; a.ws = (unsigned char*)d_ws;
#ifndef MK_PER_PHASE
    a.ph_lo = 0; a.ph_hi = NPHASE;
    void* args[] = {&a};
    hipError_t e = hipLaunchCooperativeKernel((const void*)mk_fwd, dim3(grid), dim3(NWAVES * 64), args, LDS_BYTES, stream);
    if (e != hipSuccess) fprintf(stderr, "kernel_launch: cooperative launch failed: %s (grid %d)\n", hipGetErrorString(e), grid);
#else
    for (int p = 0; p < NPHASE; ++p) { a.ph_lo = p; a.ph_hi = p + 1; hipLaunchKernelGGL(mk_fwd, dim3(grid), dim3(NWAVES * 64), LDS_BYTES, stream, a); }
#endif
}
```

```cpp
#include <hip/hip_runtime.h>
#include <hip/hip_cooperative_groups.h>
#include <cstdio>
#include <cstdint>
namespace cg = cooperative_groups;
template <int M> __device__ __forceinline__ float swz_xor(float v) { return __builtin_bit_cast(float, __builtin_amdgcn_ds_swizzle(__builtin_bit_cast(int, v), (M << 10) | 0x1f)); }
__device__ __forceinline__ float add_x32(float v) { const unsigned b = __builtin_bit_cast(unsigned, v); auto rr = __builtin_amdgcn_permlane32_swap(b, b, false, false); return __builtin_bit_cast(float, (unsigned)rr[0]) + __builtin_bit_cast(float, (unsigned)rr[1]); }
__device__ __forceinline__ float max_x32(float v) { const unsigned b = __builtin_bit_cast(unsigned, v); auto rr = __builtin_amdgcn_permlane32_swap(b, b, false, false); return fmaxf(__builtin_bit_cast(float, (unsigned)rr[0]), __builtin_bit_cast(float, (unsigned)rr[1])); }
namespace pg8 {
#define PG8_LAS __attribute__((address_space(3)))
typedef unsigned short bf16_t;
typedef short bf16x8 __attribute__((ext_vector_type(8)));
typedef float f32x4 __attribute__((ext_vector_type(4)));
typedef unsigned u32x4 __attribute__((ext_vector_type(4)));
constexpr int BM = 256, BK = 64, HALF = 128, HTB = HALF * BK * 2  , STAGE_BYTES = 8 * HTB, NXCD = 8, WGM = 8;

__host__ __device__ __forceinline__ int lds_byte(int r, int c) { const int st = (r >> 4) * 2 + (c >> 5), rr = r & 15, cc = c & 31, ob = rr * 64 + cc * 2; return st * 1024 + (ob ^ (((ob >> 9) & 1) << 5)); }
__host__ __device__ __forceinline__ void stage_rc(int b, int& R, int& C) { const int st = b / 1024, sb = b % 1024, swz = sb ^ (((sb >> 9) & 1) << 5); R = (st >> 1) * 16 + swz / 64; C = (st & 1) * 32 + (swz % 64) / 2; }
__host__ __device__ __forceinline__ int perm32(int rho) { const int n = rho >> 4, i = rho & 15; return 8 * (i >> 2) + 4 * n + (i & 3); }

struct Unit { int pm, pn; };
struct Gemm { const bf16_t* A; const bf16_t* Bt; int M, N, K; };

struct StaticOrder {
    int nM, nN, nwg, G, c;
    __host__ __device__ void init(int M, int N, int G_, int c_) { nM = M / BM; nN = N / BM; nwg = nM * nN; G = G_; c = c_; }
    __host__ __device__ bool next(int i, Unit& u) const {
        const long L = (long)i * G + c; if (L >= nwg) return false;
        int wgid = (int)L; { const int q = nwg / NXCD, r = nwg % NXCD, xcd = wgid % NXCD, off = wgid / NXCD; wgid = (xcd < r ? xcd * (q + 1) : r * (q + 1) + (xcd - r) * q) + off; }
        const int nig = WGM * nN, gid = wgid / nig, fm = gid * WGM, gsz = (nM - fm) < WGM ? (nM - fm) : WGM;
        u.pm = fm + ((wgid % nig) % gsz); u.pn = (wgid % nig) / gsz; return true;
    }
    __device__ __forceinline__ void a_ready(const Unit&) const {}
    __device__ __forceinline__ void done(const Unit&) const {}
};
__device__ __forceinline__ unsigned cvt_pk_bf16(float lo, float hi) { unsigned r; asm volatile("v_cvt_pk_bf16_f32 %0, %1, %2" : "=v"(r) : "v"(lo), "v"(hi)); return r; }
template <class Epi, class Sched, bool ALIGN_EPI = false, bool SP2 = false>
__device__ __forceinline__ void gemm_phase(PG8_LAS unsigned char* lds, const Gemm g, const Sched& S, const Epi& E) {
    int tid_ = threadIdx.x; asm volatile("" : "+v"(tid_));
    const int tid = tid_, wid = __builtin_amdgcn_readfirstlane(tid >> 6), lane = tid & 63, wr = wid >> 2, wc = wid & 3, fr = lane & 15, fq = lane >> 4;
    const int K = g.K, nt = K / BK;
    unsigned voffA[2], voffB[2];
#pragma unroll
    for (int i = 0; i < 2; ++i) { int R, C; stage_rc(tid * 16 + i * 8192, R, C); const int Rb = Epi::PERM ? ((R & ~31) + perm32(R & 31)) : R;
        voffA[i] = (unsigned)(R * K + C) * 2u; voffB[i] = (unsigned)(Rb * K + C) * 2u; }
    const size_t kstep = (size_t)(BK * 2);
    const size_t hstep = (size_t)HALF * K * 2;
    const size_t tstep = 2 * hstep;
    const unsigned ldsw = (unsigned)wid * 1024u;
    const int aoff = lds_byte(wr * 64 + fr, fq * 8), boff = lds_byte(wc * 32 + fr, fq * 8);
#define PG8_SA(b, h) (((b) * 2 + (h)) * HTB)
#define PG8_SB(b, h) ((4 + (b) * 2 + (h)) * HTB)
#define PG8_STAGE(bufoff, gbase, voff) do { _Pragma("unroll") for (int _i = 0; _i < 2; ++_i) \
        __builtin_amdgcn_global_load_lds((const unsigned*)((const char*)(gbase) + (voff)[_i]), (PG8_LAS unsigned*)(lds + (bufoff) + ldsw + _i * 8192), 16, 0, 0); } while (0)
#define PG8_LDA(dst, b, h) do { _Pragma("unroll") for (int m = 0; m < 4; ++m) _Pragma("unroll") for (int k = 0; k < 2; ++k) dst[m][k] = *(const PG8_LAS bf16x8*)(lds + PG8_SA(b, h) + aoff + m * 2048 + k * 1024); } while (0)
#define PG8_LDB(dst, b, h) do { _Pragma("unroll") for (int n = 0; n < 2; ++n) _Pragma("unroll") for (int k = 0; k < 2; ++k) dst[n][k] = *(const PG8_LAS bf16x8*)(lds + PG8_SB(b, h) + boff + n * 2048 + k * 1024); } while (0)
#define PG8_MMA(ai, bj, At, Bt) do { __builtin_amdgcn_s_setprio(1); _Pragma("unroll") for (int m = 0; m < 4; ++m) _Pragma("unroll") for (int n = 0; n < 2; ++n) _Pragma("unroll") for (int k = 0; k < 2; ++k) \
        acc[ai][bj][m][n] = __builtin_amdgcn_mfma_f32_16x16x32_bf16(Bt[n][k], At[m][k], acc[ai][bj][m][n], 0, 0, 0); __builtin_amdgcn_s_setprio(0); } while (0)
#define PG8_WAIT_V(n) asm volatile("s_waitcnt vmcnt(" #n ")" ::: "memory")
#define PG8_WAIT_L(n) asm volatile("s_waitcnt lgkmcnt(" #n ")" ::: "memory")
#define PG8_BAR __builtin_amdgcn_s_barrier()
#define PG8_SCHED __builtin_amdgcn_sched_barrier(0)
    Unit cur, nxt; int ui = 0;
    if (!S.next(0, cur)) return;
    f32x4 acc[2][2][4][2];
#pragma unroll
    for (int a = 0; a < 2; ++a)
#pragma unroll
        for (int b = 0; b < 2; ++b)
#pragma unroll
            for (int m = 0; m < 4; ++m)
#pragma unroll
                for (int n = 0; n < 2; ++n) acc[a][b][m][n] = (f32x4){0.f, 0.f, 0.f, 0.f};
    bf16x8 At[4][2], B0[2][2], B1[2][2];
    const char* cA = (const char*)g.A + (size_t)cur.pm * tstep; const char* cB = (const char*)g.Bt + (size_t)cur.pn * tstep;
    S.a_ready(cur);
    if constexpr (SP2) {
        PG8_STAGE(PG8_SB(0, 0), cB, voffB); PG8_STAGE(PG8_SB(0, 1), cB + hstep, voffB); PG8_STAGE(PG8_SA(0, 0), cA, voffA); PG8_STAGE(PG8_SA(0, 1), cA + hstep, voffA);
        if (wr == 1) PG8_BAR;
        PG8_WAIT_V(2); PG8_BAR;
        PG8_STAGE(PG8_SB(1, 0), cB + kstep, voffB); PG8_STAGE(PG8_SA(1, 0), cA + kstep, voffA); PG8_STAGE(PG8_SB(1, 1), cB + hstep + kstep, voffB);
        PG8_WAIT_V(6); PG8_BAR;
    } else {
        PG8_STAGE(PG8_SB(0, 0), cB, voffB); PG8_STAGE(PG8_SA(0, 0), cA, voffA); PG8_STAGE(PG8_SB(0, 1), cB + hstep, voffB); PG8_STAGE(PG8_SA(0, 1), cA + hstep, voffA);
        if (wr == 1) PG8_BAR;
        PG8_WAIT_V(4); PG8_BAR;
        PG8_STAGE(PG8_SB(1, 0), cB + kstep, voffB); PG8_STAGE(PG8_SA(1, 0), cA + kstep, voffA); PG8_STAGE(PG8_SB(1, 1), cB + hstep + kstep, voffB);
        PG8_WAIT_V(6); PG8_BAR;
    }
    for (;;) {
        const bool has_next = S.next(ui + 1, nxt);
        const char* nA = has_next ? (const char*)g.A + (size_t)nxt.pm * tstep : cA; const char* nB = has_next ? (const char*)g.Bt + (size_t)nxt.pn * tstep : cB;
        for (int t = 0; t < nt; t += 2) {
            const bool last = (t == nt - 2);
            const char* a1 = cA + (size_t)(t + 1) * kstep;
            const char* a2 = last ? nA : cA + (size_t)(t + 2) * kstep; const char* b2 = last ? nB : cB + (size_t)(t + 2) * kstep;
            const char* a3 = a2 + kstep; const char* b3 = b2 + kstep;
            if (last && has_next) S.a_ready(nxt);
            if constexpr (SP2) {
            PG8_LDB(B0, 0, 0); PG8_LDB(B1, 0, 1); PG8_SCHED; PG8_LDA(At, 0, 0); PG8_STAGE(PG8_SA(1, 1), a1 + hstep, voffA);
            PG8_WAIT_V(8); PG8_WAIT_L(0); PG8_BAR; PG8_MMA(0, 0, At, B0); PG8_MMA(0, 1, At, B1); PG8_BAR; PG8_SCHED;
            PG8_LDA(At, 0, 1); PG8_STAGE(PG8_SB(0, 0), b2, voffB); PG8_STAGE(PG8_SB(0, 1), b2 + hstep, voffB); PG8_STAGE(PG8_SA(0, 0), a2, voffA);
            PG8_WAIT_V(8); PG8_WAIT_L(0); PG8_BAR; PG8_MMA(1, 0, At, B0); PG8_MMA(1, 1, At, B1); PG8_BAR; PG8_SCHED;
            PG8_LDB(B0, 1, 0); PG8_LDB(B1, 1, 1); PG8_SCHED; PG8_LDA(At, 1, 0); PG8_STAGE(PG8_SA(0, 1), a2 + hstep, voffA);
            PG8_WAIT_V(8); PG8_WAIT_L(0); PG8_BAR; PG8_MMA(0, 0, At, B0); PG8_MMA(0, 1, At, B1); PG8_BAR; PG8_SCHED;
            PG8_LDA(At, 1, 1); PG8_STAGE(PG8_SB(1, 0), b3, voffB); PG8_STAGE(PG8_SB(1, 1), b3 + hstep, voffB); PG8_STAGE(PG8_SA(1, 0), a3, voffA);
            PG8_WAIT_V(8); PG8_WAIT_L(0); PG8_BAR; PG8_MMA(1, 0, At, B0); PG8_MMA(1, 1, At, B1); PG8_BAR; PG8_SCHED;
            } else {
            PG8_LDB(B0, 0, 0); PG8_SCHED; PG8_LDA(At, 0, 0); PG8_STAGE(PG8_SA(1, 1), a1 + hstep, voffA);
            PG8_WAIT_L(8); PG8_BAR; PG8_WAIT_L(0); PG8_MMA(0, 0, At, B0); PG8_BAR; PG8_SCHED;
            PG8_LDB(B1, 0, 1); PG8_STAGE(PG8_SB(0, 0), b2, voffB);
            PG8_BAR; PG8_WAIT_L(0); PG8_MMA(0, 1, At, B1); PG8_BAR;
            PG8_LDA(At, 0, 1); PG8_STAGE(PG8_SA(0, 0), a2, voffA);
            PG8_BAR; PG8_WAIT_L(0); PG8_MMA(1, 0, At, B0); PG8_BAR; PG8_SCHED;
            PG8_STAGE(PG8_SB(0, 1), b2 + hstep, voffB);
            PG8_WAIT_V(6); PG8_BAR; PG8_MMA(1, 1, At, B1); PG8_BAR;
            PG8_LDB(B0, 1, 0); PG8_SCHED; PG8_LDA(At, 1, 0); PG8_STAGE(PG8_SA(0, 1), a2 + hstep, voffA);
            PG8_WAIT_L(8); PG8_BAR; PG8_WAIT_L(0); PG8_MMA(0, 0, At, B0); PG8_BAR; PG8_SCHED;
            PG8_LDB(B1, 1, 1); PG8_STAGE(PG8_SB(1, 0), b3, voffB);
            PG8_BAR; PG8_WAIT_L(0); PG8_MMA(0, 1, At, B1); PG8_BAR;
            PG8_LDA(At, 1, 1); PG8_STAGE(PG8_SA(1, 0), a3, voffA);
            PG8_BAR; PG8_WAIT_L(0); PG8_MMA(1, 0, At, B0); PG8_BAR; PG8_SCHED;
            PG8_STAGE(PG8_SB(1, 1), b3 + hstep, voffB);
            PG8_WAIT_V(6); PG8_BAR; PG8_MMA(1, 1, At, B1); PG8_BAR;
            }
        }
        if constexpr (ALIGN_EPI) { if (wr == 0) PG8_BAR; }
        if constexpr (!Epi::AFTER_DRAIN) { E(acc, cur, wr, wc, fr, fq); S.done(cur); }
        if (!has_next) break;
#pragma unroll
        for (int a = 0; a < 2; ++a)
#pragma unroll
            for (int b = 0; b < 2; ++b)
#pragma unroll
                for (int m = 0; m < 4; ++m)
#pragma unroll
                    for (int n = 0; n < 2; ++n) acc[a][b][m][n] = (f32x4){0.f, 0.f, 0.f, 0.f};
        cur = nxt; cA = nA; cB = nB; ++ui;
        if constexpr (ALIGN_EPI) { if (wr == 1) PG8_BAR; }
    }
    PG8_WAIT_V(0);
    if constexpr (!ALIGN_EPI) { if (wr == 0) PG8_BAR; }
    PG8_BAR;
    if constexpr (Epi::AFTER_DRAIN) { E.fused(acc, cur, wr, wc, fr, fq, lds, wid, lane); S.done(cur); }
#undef PG8_SA
#undef PG8_SB
#undef PG8_STAGE
#undef PG8_LDA
#undef PG8_LDB
#undef PG8_MMA
#undef PG8_WAIT_V
#undef PG8_WAIT_L
#undef PG8_BAR
#undef PG8_SCHED
}
constexpr int CH = 16384;
constexpr float C2Q = 0.125f * 1.4426950408889634f;
__device__ __forceinline__ u32x4 pack8(const f32x4& a, const f32x4& b) { u32x4 w; w.x = cvt_pk_bf16(a[0], a[1]); w.y = cvt_pk_bf16(a[2], a[3]); w.z = cvt_pk_bf16(b[0], b[1]); w.w = cvt_pk_bf16(b[2], b[3]); return w; }
__device__ __forceinline__ f32x4 bf4lo(const u32x4& w) { return (f32x4){__uint_as_float(w.x << 16), __uint_as_float(w.x & 0xffff0000u), __uint_as_float(w.y << 16), __uint_as_float(w.y & 0xffff0000u)}; }
__device__ __forceinline__ f32x4 bf4hi(const u32x4& w) { return (f32x4){__uint_as_float(w.z << 16), __uint_as_float(w.z & 0xffff0000u), __uint_as_float(w.w << 16), __uint_as_float(w.w & 0xffff0000u)}; }
__device__ __forceinline__ int batch_of(int m) { return m < 16384 ? (m >> 12) : 4 + ((m - 16384) >> 13); }

struct EpiProj {
    static constexpr bool PERM = true, AFTER_DRAIN = false;
    bf16_t *QK, *VA, *DIL, *GT; const float *qn_a, *kn_a, *qn_b, *kn_b; int S, lgS;
    __device__ __forceinline__ void operator()(const f32x4 (&acc)[2][2][4][2], const Unit& u, int wr, int wc, int fr, int fq) const {
        const int pn = u.pn, lrb = u.pm * BM + wr * 64 + fr;
        int kind, lgr = 0; bf16_t* dst; const float* gain = nullptr; float sc = 1.f;
        if (pn < 8) { const int which = pn >> 1, head = (pn & 1) * 4 + wc; kind = 0; gain = which < 2 ? qn_a : kn_a; sc = which < 2 ? C2Q : 1.f; dst = QK + (size_t)(which * 8 + head) * ((size_t)CH * 64); }
        else if (pn < 12) { const int head = (pn - 8) * 2 + (wc >> 1); kind = 1; dst = VA + (size_t)head * ((size_t)CH * 128) + (2 * (wc & 1)) * 2048 + 8 * fq; }
        else if (pn < 30) { const int idx = pn - 12, g = idx / 6, part = (idx % 6) >> 1, head = (idx & 1) * 4 + wc; lgr = 2 * g;
            dst = DIL + (size_t)((g * 3 + part) * 8 + head) * ((size_t)CH * 64);
            if (part < 2) { kind = 0; gain = (part == 0 ? qn_b : kn_b) + 64 * g; sc = part == 0 ? C2Q : 1.f; } else { kind = 2; dst += 8 * fq; } }
        else { const int which = (pn - 30) >> 2; kind = 3; dst = GT + (size_t)which * ((size_t)CH * 1024) + ((pn - 30) & 3) * 256 + 64 * wc + 8 * fq; }
        const int Sm = S - 1, rm = (1 << lgr) - 1, lsh = lgS - lgr;
        if (kind == 0) {
            f32x4 gv[2][2];
#pragma unroll
            for (int bj = 0; bj < 2; ++bj)
#pragma unroll
                for (int n = 0; n < 2; ++n) gv[bj][n] = *(const f32x4*)(gain + 32 * bj + 8 * fq + 4 * n) * sc;
#pragma unroll
            for (int ai = 0; ai < 2; ++ai)
#pragma unroll
                for (int m = 0; m < 4; ++m) {
                    const int lr = lrb + ai * HALF + m * 16, t = lr & Sm, dr = (lr & ~Sm) + ((t & rm) << lsh) + (t >> lgr);
                    float ss = 0.f;
#pragma unroll
                    for (int bj = 0; bj < 2; ++bj)
#pragma unroll
                        for (int n = 0; n < 2; ++n) { const f32x4 x = acc[ai][bj][m][n]; ss += (x[0] * x[0] + x[1] * x[1]) + (x[2] * x[2] + x[3] * x[3]); }
                    ss += swz_xor<16>(ss); ss = add_x32(ss);
                    const float rs = __builtin_amdgcn_rsqf(ss * (1.0f / 64.0f) + 1e-6f);
                    bf16_t* rowp = dst + (size_t)(dr >> 6) * 4096 + fq * 512 + (dr & 63) * 8;
#pragma unroll
                    for (int bj = 0; bj < 2; ++bj) *(u32x4*)(rowp + bj * 2048) = pack8(acc[ai][bj][m][0] * rs * gv[bj][0], acc[ai][bj][m][1] * rs * gv[bj][1]);
                }
        } else if (kind == 1) {
#pragma unroll
            for (int ai = 0; ai < 2; ++ai)
#pragma unroll
                for (int m = 0; m < 4; ++m) {
                    const int lr = lrb + ai * HALF + m * 16;
                    bf16_t* rowp = dst + (size_t)(lr >> 6) * 8192 + ((lr & 63) >> 4) * 512 + (lr & 15) * 32;
#pragma unroll
                    for (int bj = 0; bj < 2; ++bj) *(u32x4*)(rowp + bj * 2048) = pack8(acc[ai][bj][m][0], acc[ai][bj][m][1]);
                }
        } else if (kind == 2) {
#pragma unroll
            for (int ai = 0; ai < 2; ++ai)
#pragma unroll
                for (int m = 0; m < 4; ++m) {
                    const int lr = lrb + ai * HALF + m * 16, t = lr & Sm, dr = (lr & ~Sm) + ((t & rm) << lsh) + (t >> lgr);
                    bf16_t* rowp = dst + (size_t)dr * 64;
#pragma unroll
                    for (int bj = 0; bj < 2; ++bj) *(u32x4*)(rowp + bj * 32) = pack8(acc[ai][bj][m][0], acc[ai][bj][m][1]);
                }
        } else {
#pragma unroll
            for (int ai = 0; ai < 2; ++ai)
#pragma unroll
                for (int m = 0; m < 4; ++m) {
                    const int lr = lrb + ai * HALF + m * 16;
                    bf16_t* rowp = dst + (size_t)lr * 1024;
#pragma unroll
                    for (int bj = 0; bj < 2; ++bj) { f32x4 v0 = acc[ai][bj][m][0], v1 = acc[ai][bj][m][1];
#pragma unroll
                        for (int i = 0; i < 4; ++i) { v0[i] = __builtin_amdgcn_rcpf(1.0f + __builtin_amdgcn_exp2f(-1.4426950408889634f * v0[i])); v1[i] = __builtin_amdgcn_rcpf(1.0f + __builtin_amdgcn_exp2f(-1.4426950408889634f * v1[i])); }
                        *(u32x4*)(rowp + bj * 32) = pack8(v0, v1); }
                }
        }
    }
};
template <bool ADD> struct EpiBr {
    static constexpr bool PERM = true, AFTER_DRAIN = false;
    bf16_t* MG; const bf16_t* G;
    __device__ __forceinline__ void operator()(const f32x4 (&acc)[2][2][4][2], const Unit& u, int wr, int wc, int fr, int fq) const {
        const int row0 = u.pm * BM + wr * 64 + fr, col0 = u.pn * BM + wc * 32 + 8 * fq;
#pragma unroll
        for (int ai = 0; ai < 2; ++ai)
#pragma unroll
            for (int m = 0; m < 4; ++m) { const size_t off = (size_t)(row0 + ai * HALF + m * 16) * 1024 + col0;
#pragma unroll
                for (int bj = 0; bj < 2; ++bj) { const u32x4 gw = *(const u32x4*)(G + off + bj * HALF);
                    f32x4 v0 = acc[ai][bj][m][0] * bf4lo(gw), v1 = acc[ai][bj][m][1] * bf4hi(gw);
                    if (ADD) { const u32x4 tw = *(const u32x4*)(MG + off + bj * HALF); v0 += bf4lo(tw); v1 += bf4hi(tw); }
                    *(u32x4*)(MG + off + bj * HALF) = pack8(v0, v1); } }
    }
};
struct EpiWo {
    static constexpr bool PERM = true, AFTER_DRAIN = false;
    const float *xp, *xs; float* out; bf16_t* A2; const float *mod, *n2g; float* rowss;
    __device__ __forceinline__ void operator()(const f32x4 (&acc)[2][2][4][2], const Unit& u, int wr, int wc, int fr, int fq) const {
        const int m0 = u.pm * BM, b = batch_of(m0), row0 = m0 + wr * 64 + fr, col0 = u.pn * BM + wc * 32 + 8 * fq;
        const float* xb = m0 < 16384 ? xp : xs - (size_t)16384 * 1024;
        const float* g1p = mod + b * 6144 + 2048 + col0; const float* s2p = mod + b * 6144 + 4096 + col0; const float* ngp = n2g + col0;
        f32x4 g1[2][2], gm[2][2];
#pragma unroll
        for (int bj = 0; bj < 2; ++bj)
#pragma unroll
            for (int n = 0; n < 2; ++n) { g1[bj][n] = *(const f32x4*)(g1p + bj * HALF + 4 * n); gm[bj][n] = *(const f32x4*)(ngp + bj * HALF + 4 * n) * (*(const f32x4*)(s2p + bj * HALF + 4 * n) + 1.0f); }
#pragma unroll
        for (int ai = 0; ai < 2; ++ai)
#pragma unroll
            for (int m = 0; m < 4; ++m) { const int r = row0 + ai * HALF + m * 16; const size_t off = (size_t)r * 1024 + col0; float ss = 0.f;
#pragma unroll
                for (int bj = 0; bj < 2; ++bj) {
                    const f32x4 y0 = *(const f32x4*)(xb + off + bj * HALF) + g1[bj][0] * acc[ai][bj][m][0], y1 = *(const f32x4*)(xb + off + bj * HALF + 4) + g1[bj][1] * acc[ai][bj][m][1];
                    *(f32x4*)(out + off + bj * HALF) = y0; *(f32x4*)(out + off + bj * HALF + 4) = y1;
                    ss += (y0[0] * y0[0] + y0[1] * y0[1]) + (y0[2] * y0[2] + y0[3] * y0[3]) + (y1[0] * y1[0] + y1[1] * y1[1]) + (y1[2] * y1[2] + y1[3] * y1[3]);
                    *(u32x4*)(A2 + off + bj * HALF) = pack8(y0 * gm[bj][0], y1 * gm[bj][1]); }
                ss += swz_xor<16>(ss); ss = add_x32(ss);
                if (fq == 0) atomicAdd(rowss + r, ss); }
    }
};
struct EpiUp {
    static constexpr bool PERM = true, AFTER_DRAIN = false;
    bf16_t* H; const float *rowss, *sbias;
    __device__ __forceinline__ void operator()(const f32x4 (&acc)[2][2][4][2], const Unit& u, int wr, int wc, int fr, int fq) const {
        const int m0 = u.pm * BM, b = batch_of(m0), row0 = m0 + wr * 64 + fr, col0 = u.pn * BM + wc * 32 + 8 * fq;
        f32x4 sb[2][2];
#pragma unroll
        for (int bj = 0; bj < 2; ++bj)
#pragma unroll
            for (int n = 0; n < 2; ++n) sb[bj][n] = *(const f32x4*)(sbias + b * 4096 + col0 + bj * HALF + 4 * n);
#pragma unroll
        for (int ai = 0; ai < 2; ++ai)
#pragma unroll
            for (int m = 0; m < 4; ++m) { const int r = row0 + ai * HALF + m * 16; const float rs = __builtin_amdgcn_rsqf(rowss[r] * (1.0f / 1024.0f) + 1e-6f);
                bf16_t* rowp = H + (size_t)r * 4096 + col0;
#pragma unroll
                for (int bj = 0; bj < 2; ++bj) { f32x4 v0 = acc[ai][bj][m][0] * rs + sb[bj][0], v1 = acc[ai][bj][m][1] * rs + sb[bj][1];
#pragma unroll
                    for (int i = 0; i < 4; ++i) { v0[i] = fmaxf(v0[i], 0.f); v1[i] = fmaxf(v1[i], 0.f); }
                    *(u32x4*)(rowp + bj * HALF) = pack8(v0 * v0, v1 * v1); } }
    }
};
struct EpiDown {
    static constexpr bool PERM = true, AFTER_DRAIN = false;
    float* out; const float* mod;
    __device__ __forceinline__ void operator()(const f32x4 (&acc)[2][2][4][2], const Unit& u, int wr, int wc, int fr, int fq) const {
        const int m0 = u.pm * BM, b = batch_of(m0), row0 = m0 + wr * 64 + fr, col0 = u.pn * BM + wc * 32 + 8 * fq;
        const float* g2p = mod + b * 6144 + 5120 + col0;
        f32x4 g2[2][2];
#pragma unroll
        for (int bj = 0; bj < 2; ++bj)
#pragma unroll
            for (int n = 0; n < 2; ++n) g2[bj][n] = *(const f32x4*)(g2p + bj * HALF + 4 * n);
#pragma unroll
        for (int ai = 0; ai < 2; ++ai)
#pragma unroll
            for (int m = 0; m < 4; ++m) { float* rowp = out + (size_t)(row0 + ai * HALF + m * 16) * 1024 + col0;
#pragma unroll
                for (int bj = 0; bj < 2; ++bj) { *(f32x4*)(rowp + bj * HALF) = *(const f32x4*)(rowp + bj * HALF) + g2[bj][0] * acc[ai][bj][m][0]; *(f32x4*)(rowp + bj * HALF + 4) = *(const f32x4*)(rowp + bj * HALF + 4) + g2[bj][1] * acc[ai][bj][m][1]; } }
    }
};
}
namespace att {
#define LASC __attribute__((address_space(3)))
typedef unsigned short bf16;
typedef short bf16x8 __attribute__((ext_vector_type(8)));
typedef short s16x4 __attribute__((ext_vector_type(4)));
typedef short v4i16_t __attribute__((ext_vector_type(4)));
typedef float f32x16 __attribute__((ext_vector_type(16)));
typedef float f32x4 __attribute__((ext_vector_type(4)));
typedef unsigned u32x4 __attribute__((ext_vector_type(4)));
typedef float f32x2_t __attribute__((ext_vector_type(2))); typedef __bf16 bf16x2_t __attribute__((ext_vector_type(2)));
constexpr int CH = 16384;
constexpr float LOG2E = 1.4426950408889634f;
__device__ __forceinline__ int crow(int r, int hi) { return (r & 3) + 8 * (r >> 2) + 4 * hi; }
__device__ __forceinline__ unsigned cvtpk(float lo, float hi) { f32x2_t v = {lo, hi}; bf16x2_t b = __builtin_convertvector(v, bf16x2_t); return __builtin_bit_cast(unsigned, b); }
__device__ __forceinline__ s16x4 vtr(const LASC unsigned char* p) { return __builtin_bit_cast(s16x4, __builtin_amdgcn_ds_read_tr16_b64_v4i16((LASC v4i16_t*)p)); }
#ifndef BK_SH
#define BK_SH 0
#endif
__device__ __forceinline__ int rel_bucket(int rel) {
    const int n = rel < 0 ? -rel : rel; const int ret = rel > 0 ? 16 : 0;
    int v;
    if (n < 8) v = n; else if (n < 12) v = 8; else if (n < 16 + BK_SH) v = 9; else if (n < 23) v = 10; else if (n < 32 + BK_SH) v = 11; else if (n < 46) v = 12; else if (n < 64 + BK_SH) v = 13; else if (n < 91) v = 14; else v = 15;
    return ret + v;
}
__device__ __forceinline__ bf16x8 pack_frag(const f32x16& p, int base) {
    u32x4 w; w.x = cvtpk(p[base], p[base + 1]); w.y = cvtpk(p[base + 2], p[base + 3]); w.z = cvtpk(p[base + 4], p[base + 5]); w.w = cvtpk(p[base + 6], p[base + 7]);
    return __builtin_bit_cast(bf16x8, w);
}
constexpr int DA_K = 0, DA_V = 32768;
constexpr int DA_Q = 81920;
constexpr int DA_BT = 147456;
constexpr int DA_WS = 149504;
constexpr int SC_OFF = 155648;
constexpr int DL_VS = 136192;
constexpr int DL_N = 0, DL_D = 131072, DL_T = 131072 + 2048;

__device__ __forceinline__ void da_epilogue(LASC unsigned char* lds, bf16* YA, const float* subln_g, f32x16 (&o1)[4], f32x16 (&o2)[4], float l1, float l2, float lam, int head, int tile0, int qb, int wid);
#define SBAR() __builtin_amdgcn_sched_barrier(0)
__device__ __forceinline__ int lane_now() { int l; asm volatile("v_mbcnt_lo_u32_b32 %0, -1, 0\n\tv_mbcnt_hi_u32_b32 %0, -1, %0" : "=v"(l)); return l; }
__device__ __forceinline__ void da_unit(LASC unsigned char* lds, const bf16* QK, const bf16* VA, bf16* YA, const float* rel_bias, const float* subln_g,
                                        int head, int tile0, int NT, int qb, int tid_in) {
    int tid = tid_in; asm volatile("" : "+v"(tid));
    const int lane = tid & 63, r32 = lane & 31, hi = lane >> 5; const int wid = __builtin_amdgcn_readfirstlane(tid >> 6);
    LASC float* BT = (LASC float*)(lds + DA_BT); const LASC float* SC = (const LASC float*)(lds + SC_OFF);
    const float lam = __builtin_bit_cast(float, __builtin_amdgcn_readfirstlane(__builtin_bit_cast(int, SC[0])));
    if (tid < 448) { const int rel = tid - 224; BT[tid] = rel_bias[rel_bucket(rel) * 32 + head] * LOG2E; }
    const bf16* Q1h = QK + (size_t)(0 * 8 + head) * ((size_t)CH * 64); const bf16* Q2h = QK + (size_t)(1 * 8 + head) * ((size_t)CH * 64);
    const bf16* K1h = QK + (size_t)(2 * 8 + head) * ((size_t)CH * 64) + (size_t)tile0 * 4096; const bf16* K2h = QK + (size_t)(3 * 8 + head) * ((size_t)CH * 64) + (size_t)tile0 * 4096;
    const bf16* Vh = VA + (size_t)head * ((size_t)CH * 128) + (size_t)tile0 * 8192;
#define DA_GLDS(SRC, DST) do { unsigned keep_; const unsigned dst_ = (unsigned)__builtin_amdgcn_readfirstlane((int)(unsigned)(uintptr_t)(DST)); \
        asm volatile("s_mov_b32 %0, m0\n\ts_mov_b32 m0, %2\n\ts_nop 0\n\tglobal_load_lds_dwordx4 %1, off\n\ts_mov_b32 m0, %0" : "=&s"(keep_) : "v"(SRC), "s"(dst_) : "memory"); } while (0)
#define DA_DMA(t) do { const unsigned lo_ = (unsigned)lane_now() * 16u; LASC unsigned char* dk_ = lds + DA_K + ((t) & 1) * 16384 + wid * 1024; LASC unsigned char* dv_ = lds + DA_V + ((t) % 3) * 16384 + wid * 1024; \
        const char* k1_ = (const char*)K1h + (size_t)(t) * 8192 + wid * 1024; const char* k2_ = (const char*)K2h + (size_t)(t) * 8192 + wid * 1024; const char* v_ = (const char*)Vh + (size_t)(t) * 16384 + wid * 1024;     \
        DA_GLDS(k1_ + lo_, dk_); DA_GLDS(k2_ + lo_, dk_ + 8192); DA_GLDS(v_ + lo_, dv_); DA_GLDS(v_ + 8192 + lo_, dv_ + 8192); } while (0)
    DA_DMA(0);
    LASC unsigned char* qlds = lds + DA_Q + wid * 8192 + lane * 16;
    { const int tq = tile0 + 4 * qb + (wid >> 1), rq = (wid & 1) * 32 + r32;
#pragma unroll
      for (int ks = 0; ks < 4; ++ks) { *(LASC bf16x8*)(qlds + ks * 1024) = *(const bf16x8*)(Q1h + (size_t)tq * 4096 + (2 * ks + hi) * 512 + rq * 8);
                                       *(LASC bf16x8*)(qlds + 4096 + ks * 1024) = *(const bf16x8*)(Q2h + (size_t)tq * 4096 + (2 * ks + hi) * 512 + rq * 8); } }
    f32x16 o1[4], o2[4];
#pragma unroll
    for (int d = 0; d < 4; ++d) { o1[d] = f32x16{}; o2[d] = f32x16{}; }
    float l1 = 0.f, l2 = 0.f;
    asm volatile("s_waitcnt vmcnt(0)" ::: "memory");
    __syncthreads();
    const int qw0 = 256 * qb + 32 * wid;
    const int tL = (qw0 >= 191) ? ((qw0 - 191) >> 6) : -1, tR = (qw0 + 159 + 63) >> 6;
    const float fLN = __builtin_bit_cast(float, __builtin_amdgcn_readfirstlane(__builtin_bit_cast(int, __builtin_amdgcn_exp2f(BT[0])))), fNR = __builtin_bit_cast(float, __builtin_amdgcn_readfirstlane(__builtin_bit_cast(int, __builtin_amdgcn_exp2f(-BT[447]))));
    bf16x8 paA1[2], paA2[2], paB1[2], paB2[2];
#pragma unroll
    for (int i = 0; i < 2; ++i) { paB1[i] = bf16x8{}; paB2[i] = bf16x8{}; }
#define DA_NEARC(S_, HALF_) do { const LASC float* bt_ = BT + (64 * t + 32 * (HALF_) - (qw0 + r32) + 4 * hi + 224); \
        _Pragma("unroll") for (int r = 0; r < 16; ++r) S_[r] = bt_[(r & 3) + 8 * (r >> 2)]; } while (0)
#define DA_VRD(DST, F_) do { const s16x4 lo_ = vtr(vp + ((F_) >> 1) * 4096 + ((F_) & 1) * 1024), hh_ = vtr(vp + ((F_) >> 1) * 4096 + ((F_) & 1) * 1024 + 512); DST = (bf16x8){lo_[0], lo_[1], lo_[2], lo_[3], hh_[0], hh_[1], hh_[2], hh_[3]}; } while (0)
#ifdef DA_XVALU
#define DA_XV(g) do { float x0_ = __builtin_amdgcn_exp2f(s2[(g)] * 0.5f), x1_ = __builtin_amdgcn_exp2f(s2[(g)] * 0.25f); asm volatile("" :: "v"(x0_), "v"(x1_)); } while (0)
#else
#define DA_XV(g) do {} while (0)
#endif
#define DA_STEP(KS, HALF, VP, PI1, PI2, PO1, PO2) do { \
        f32x16 s1, s2; const LASC unsigned char* vp; const LASC unsigned char* kb; const LASC unsigned char* qlds; int r32, hi; \
        { const int ln_ = lane_now(); r32 = ln_ & 31; hi = ln_ >> 5; kb = (KS) + hi * 1024 + ((HALF) * 32 + r32) * 16; qlds = lds + DA_Q + wid * 8192 + ln_ * 16; \
          vp = (VP) + ((ln_ >> 4) & 1) * 32 + (ln_ & 3) * 8 + (4 * hi + ((ln_ & 15) >> 2)) * 64; } \
        { bf16x8 kfB[4], qfB[4]; \
          if ((HALF) == 0) { _Pragma("unroll") for (int ks = 0; ks < 4; ++ks) kfA[ks] = *(const LASC bf16x8*)(kb + ks * 2048); }     \
          _Pragma("unroll") for (int ks = 0; ks < 4; ++ks) { kfB[ks] = *(const LASC bf16x8*)(kb + 8192 + ks * 2048); qfB[ks] = *(const LASC bf16x8*)(qlds + 4096 + ks * 1024); }     \
          if (near) { DA_NEARC(s1, HALF); s1 = __builtin_amdgcn_mfma_f32_32x32x16_bf16(kfA[0], qfA[0], s1, 0, 0, 0); } \
          else s1 = __builtin_amdgcn_mfma_f32_32x32x16_bf16(kfA[0], qfA[0], (f32x16){}, 0, 0, 0); \
          _Pragma("unroll") for (int ks = 1; ks < 4; ++ks) s1 = __builtin_amdgcn_mfma_f32_32x32x16_bf16(kfA[ks], qfA[ks], s1, 0, 0, 0); \
          SBAR(); \
          DA_VRD(vf[0], 0); \
          if (near) { DA_NEARC(s2, HALF); s2 = __builtin_amdgcn_mfma_f32_32x32x16_bf16(kfB[0], qfB[0], s2, 0, 0, 0); } \
          else s2 = __builtin_amdgcn_mfma_f32_32x32x16_bf16(kfB[0], qfB[0], (f32x16){}, 0, 0, 0); \
          _Pragma("unroll") for (int ks = 1; ks < 4; ++ks) s2 = __builtin_amdgcn_mfma_f32_32x32x16_bf16(kfB[ks], qfB[ks], s2, 0, 0, 0); } \
        SBAR(); \
        { float sa = 0.f, sb = 0.f; u32x4 w1a, w1b, w2a, w2b; \
            \
          _Pragma("unroll") for (int g = 0; g < 16; ++g) { const int f = g >> 1, d0 = f >> 1, ks = f & 1, sm = g & 1; \
              if (sm == 0) { if (f + 1 < 8) DA_VRD(vf[(f + 1) & 1], f + 1); o1[d0] = __builtin_amdgcn_mfma_f32_32x32x16_bf16(PI1[ks], vf[f & 1], o1[d0], 0, 0, 0); } \
              else o2[d0] = __builtin_amdgcn_mfma_f32_32x32x16_bf16(PI2[ks], vf[f & 1], o2[d0], 0, 0, 0); \
              DA_XV(g); \
              if (g == 8) { _Pragma("unroll") for (int k2 = 0; k2 < 4; ++k2) { qfA[k2] = *(const LASC bf16x8*)(qlds + k2 * 1024); if ((HALF) == 0) kfA[k2] = *(const LASC bf16x8*)(kb + 512 + k2 * 2048); } } \
              if (g < 8) { const float e0 = __builtin_amdgcn_exp2f(s1[2 * g]), e1 = __builtin_amdgcn_exp2f(s1[2 * g + 1]); sa += e0; sa += e1; unsigned w = cvtpk(e0, e1); asm volatile("" : "+v"(w), "+v"(sa)); if (g < 4) w1a[g] = w; else w1b[g - 4] = w; } \
              else { const int g2 = g - 8; const float e0 = __builtin_amdgcn_exp2f(s2[2 * g2]), e1 = __builtin_amdgcn_exp2f(s2[2 * g2 + 1]); sb += e0; sb += e1; unsigned w = cvtpk(e0, e1); asm volatile("" : "+v"(w), "+v"(sb)); if (g2 < 4) w2a[g2] = w; else w2b[g2 - 4] = w; } \
              SBAR(); } \
          l1 += sa; l2 += sb; \
          PO1[0] = __builtin_bit_cast(bf16x8, w1a); PO1[1] = __builtin_bit_cast(bf16x8, w1b); PO2[0] = __builtin_bit_cast(bf16x8, w2a); PO2[1] = __builtin_bit_cast(bf16x8, w2b); } \
    } while (0)
    bf16x8 kfA[4], qfA[4];
    { const int ln_ = lane_now(); const LASC unsigned char* q0_ = lds + DA_Q + wid * 8192 + ln_ * 16;
#pragma unroll
      for (int ks = 0; ks < 4; ++ks) qfA[ks] = *(const LASC bf16x8*)(q0_ + ks * 1024); }
    bf16x8 vf[2];
    for (int t = 0; t < NT; ++t) {
        if (t + 1 < NT) DA_DMA(t + 1);
        const bool near = (t > tL) && (t < tR);
        const bool trans = (t == tL + 1 && tL >= 0) || (t == tR);
        const float f = (t == tR) ? fNR : fLN;
        const LASC unsigned char* ks_ = lds + DA_K + (t & 1) * 16384;
        const int tp = t > 0 ? t - 1 : 0;
        const LASC unsigned char* vprev = lds + DA_V + (tp % 3) * 16384 + (t > 0 ? 2048 : 0);
        const LASC unsigned char* vcur = lds + DA_V + (t % 3) * 16384;
        if (trans) { l1 *= f; l2 *= f; }
        DA_STEP(ks_, 0, vprev, paB1, paB2, paA1, paA2);
        if (trans) {
#pragma unroll
            for (int d = 0; d < 4; ++d) { o1[d] *= f; o2[d] *= f; } }
#ifdef DA_XBAR
        __syncthreads();
#endif
        DA_STEP(ks_, 1, vcur, paA1, paA2, paB1, paB2);
        asm volatile("s_waitcnt vmcnt(0)" ::: "memory");
        __syncthreads();
    }
    { const int ln_ = lane_now(); const LASC unsigned char* vp = lds + DA_V + ((NT - 1) % 3) * 16384 + 2048 + ((ln_ >> 4) & 1) * 32 + (ln_ & 3) * 8 + (4 * (ln_ >> 5) + ((ln_ & 15) >> 2)) * 64;
#pragma unroll
      for (int d0 = 0; d0 < 4; ++d0)
#pragma unroll
          for (int ks = 0; ks < 2; ++ks) { const s16x4 lo = vtr(vp + d0 * 4096 + ks * 1024), hh = vtr(vp + d0 * 4096 + ks * 1024 + 512); const bf16x8 vf = (bf16x8){lo[0], lo[1], lo[2], lo[3], hh[0], hh[1], hh[2], hh[3]};
              o1[d0] = __builtin_amdgcn_mfma_f32_32x32x16_bf16(paB1[ks], vf, o1[d0], 0, 0, 0); o2[d0] = __builtin_amdgcn_mfma_f32_32x32x16_bf16(paB2[ks], vf, o2[d0], 0, 0, 0); } }
    __syncthreads();
#undef DA_DMA
#undef DA_GLDS
#undef DA_STEP
#undef DA_NEARC
#undef DA_VRD
    da_epilogue(lds, YA, subln_g, o1, o2, l1, l2, lam, head, tile0, qb, wid);
}
__device__ __forceinline__ void da_epilogue(LASC unsigned char* lds, bf16* YA, const float* subln_g, f32x16 (&o1)[4], f32x16 (&o2)[4], float l1, float l2, float lam, int head, int tile0, int qb, int wid) {
    const int lane = lane_now(), r32 = lane & 31, hi = lane >> 5;
    LASC float* wsf = (LASC float*)(lds + DA_WS) + wid * 128;
    l1 = add_x32(l1); l2 = add_x32(l2);
    if (hi == 0) { wsf[r32] = l1; wsf[32 + r32] = l2; }
    asm volatile("s_waitcnt lgkmcnt(0)" ::: "memory");
    float sg[4];
#pragma unroll
    for (int d0 = 0; d0 < 4; ++d0) sg[d0] = subln_g[32 * d0 + r32] * 0.8f;
    LASC bf16* stg = (LASC bf16*)(lds + wid * 8192);
#pragma unroll
    for (int r = 0; r < 16; ++r) {
        const int row = crow(r, hi); const float i1 = __builtin_amdgcn_rcpf(wsf[row]), i2 = lam * __builtin_amdgcn_rcpf(wsf[32 + row]);
        float v[4]; float ss = 0.f;
#pragma unroll
        for (int d0 = 0; d0 < 4; ++d0) { v[d0] = o1[d0][r] * i1 - o2[d0][r] * i2; ss += v[d0] * v[d0]; }
        ss += swz_xor<1>(ss); ss += swz_xor<2>(ss); ss += swz_xor<4>(ss); ss += swz_xor<8>(ss); ss += swz_xor<16>(ss);
        const float rs = __builtin_amdgcn_rsqf(ss * (1.0f / 128.0f) + 1e-6f);
#pragma unroll
        for (int d0 = 0; d0 < 4; ++d0) stg[row * 128 + d0 * 32 + r32] = (bf16)(cvtpk(v[d0] * rs * sg[d0], 0.f) & 0xffffu);
    }
    asm volatile("s_waitcnt lgkmcnt(0)" ::: "memory");
    { bf16* Yw = YA + (size_t)((tile0 + 4 * qb) * 64 + wid * 32) * 1024 + head * 128;
#pragma unroll
      for (int i = 0; i < 8; ++i) { const int row = i * 4 + (lane >> 4), ch = lane & 15; const u32x4 v = *(const LASC u32x4*)(stg + row * 128 + ch * 8); *(u32x4*)(Yw + (size_t)row * 1024 + ch * 8) = v; } }
    __syncthreads();
}

#ifndef DIL_NPRE
#define DIL_NPRE 5
#endif
template <bool PRE, bool ACC> __device__ __forceinline__ void dil_task(const bf16* Qh, const bf16* Kh, const bf16* Vh, int drq0, int lq0, int L, int r, int tok_base, const LASC float* DBT, LASC float* Nsum, LASC float* Dsum, LASC unsigned char* vst, int lane) {
    const int r32 = lane & 31, hi = lane >> 5;
    bf16x8 qf[4];
#pragma unroll
    for (int ks = 0; ks < 4; ++ks) qf[ks] = *(const bf16x8*)(Qh + (size_t)(drq0 >> 6) * 4096 + (2 * ks + hi) * 512 + ((drq0 & 63) + r32) * 8);
    bf16x8 kf[5][4];
#pragma unroll
    for (int s5 = 0; s5 < 5; ++s5) { const int lk0 = lq0 - 64 + 32 * s5; const int lkc = min(max(lk0, 0), L - 32); const int drk0 = drq0 + (lkc - lq0);
#pragma unroll
        for (int ks = 0; ks < 4; ++ks) kf[s5][ks] = *(const bf16x8*)(Kh + (size_t)(drk0 >> 6) * 4096 + (2 * ks + hi) * 512 + ((drk0 & 63) + r32) * 8); }
#ifdef DIL_KWAIT
    asm volatile("s_waitcnt vmcnt(0)" ::: "memory");
#endif
    f32x16 o[2]; o[0] = f32x16{}; o[1] = f32x16{}; float l = 0.f;
    const int vrow = lane >> 3, vch = lane & 7;
    LASC unsigned char* vw = vst + (vch >> 2) * 1024 + vrow * 64 + (vch & 3) * 16;
    const LASC unsigned char* vr = vst + ((lane >> 4) & 1) * 32 + (lane & 3) * 8 + (4 * hi + ((lane & 15) >> 2)) * 64;
#pragma unroll
    for (int s5 = 0; s5 < 5; ++s5) {
        const int lk0 = lq0 - 64 + 32 * s5; if (lk0 < 0 || lk0 >= L) continue;
        const int drk0 = drq0 - 64 + 32 * s5;
        const bf16* vg = Vh + (size_t)(drk0 + vrow) * 64 + vch * 8;
        const u32x4 v00 = *(const u32x4*)(vg), v01 = *(const u32x4*)(vg + 8 * 64), v10 = *(const u32x4*)(vg + 16 * 64), v11 = *(const u32x4*)(vg + 24 * 64);
        const int jb = lk0 - lq0 - r32 + 4 * hi + 96;
        f32x16 p;
#pragma unroll
        for (int rg = 0; rg < 16; ++rg) p[rg] = DBT[jb + (rg & 3) + 8 * (rg >> 2)];
        if (!PRE || s5 >= DIL_NPRE) { _Pragma("unroll") for (int ks = 0; ks < 4; ++ks) { const bf16x8 kq = *(const bf16x8*)(Kh + (size_t)(drk0 >> 6) * 4096 + (2 * ks + hi) * 512 + ((drk0 & 63) + r32) * 8); p = __builtin_amdgcn_mfma_f32_32x32x16_bf16(kq, qf[ks], p, 0, 0, 0); } }
        else { _Pragma("unroll") for (int ks = 0; ks < 4; ++ks) p = __builtin_amdgcn_mfma_f32_32x32x16_bf16(kf[s5][ks], qf[ks], p, 0, 0, 0); }
        float s = 0.f;
#pragma unroll
        for (int rg = 0; rg < 16; ++rg) { p[rg] = __builtin_amdgcn_exp2f(p[rg]); s += p[rg]; }
        l += s;
        const bf16x8 pa0 = pack_frag(p, 0), pa1 = pack_frag(p, 8);
#ifdef DIL_GATHER
#pragma unroll
        for (int db = 0; db < 2; ++db) {
            bf16x8 g0, g1; const bf16* vb = Vh + (size_t)(drk0 + 4 * hi) * 64 + 32 * db + r32;
#pragma unroll
            for (int j = 0; j < 8; ++j) { g0[j] = (short)vb[(size_t)((j & 3) + 8 * (j >> 2)) * 64]; g1[j] = (short)vb[(size_t)(16 + (j & 3) + 8 * (j >> 2)) * 64]; }
            o[db] = __builtin_amdgcn_mfma_f32_32x32x16_bf16(pa0, g0, o[db], 0, 0, 0); o[db] = __builtin_amdgcn_mfma_f32_32x32x16_bf16(pa1, g1, o[db], 0, 0, 0);
        }
#else
#pragma unroll
        for (int ss = 0; ss < 2; ++ss) {
            *(LASC u32x4*)(vw) = ss == 0 ? v00 : v10; *(LASC u32x4*)(vw + 512) = ss == 0 ? v01 : v11;
#ifdef DIL_WAITW
            asm volatile("s_waitcnt lgkmcnt(0)" ::: "memory");
#endif
#pragma unroll
            for (int db = 0; db < 2; ++db) { const s16x4 lo = vtr(vr + db * 1024), hh = vtr(vr + db * 1024 + 512); const bf16x8 vf = (bf16x8){lo[0], lo[1], lo[2], lo[3], hh[0], hh[1], hh[2], hh[3]};
                o[db] = __builtin_amdgcn_mfma_f32_32x32x16_bf16(ss == 0 ? pa0 : pa1, vf, o[db], 0, 0, 0); }
#ifdef DIL_SBAR
            __builtin_amdgcn_sched_barrier(0);
#endif
        }
#endif
    }
    l = add_x32(l);
    if (hi == 0) { LASC float* dp = Dsum + tok_base + r32 * r; *dp = ACC ? *dp + l : l; }
#pragma unroll
    for (int db = 0; db < 2; ++db)
#pragma unroll
        for (int rg = 0; rg < 16; ++rg) { LASC float* np = Nsum + (tok_base + crow(rg, hi) * r) * 64 + 32 * db + r32; *np = ACC ? *np + o[db][rg] : o[db][rg]; }
}
template <bool PRE> __device__ __forceinline__ void dil_unit(LASC unsigned char* lds, const bf16* DIL, bf16* YB, const float* rel_bias, int head, int span, int S, int lgS, int tid_in) {
    int tid = tid_in; asm volatile("" : "+v"(tid));
    const int lane = tid & 63; const int wid = __builtin_amdgcn_readfirstlane(tid >> 6);
    LASC float* Nsum = (LASC float*)(lds + DL_N); LASC float* Dsum = (LASC float*)(lds + DL_D); LASC float* DBT = (LASC float*)(lds + DL_T); const LASC float* SC = (const LASC float*)(lds + SC_OFF);
    const float M2 = SC[2];
#ifdef DIL_DELAY
    for (int dd_ = 0; dd_ < DIL_DELAY; ++dd_) __builtin_amdgcn_s_sleep(127);
#endif
    for (int i = tid; i < 600; i += 512) { const int g = i / 200, j = i % 200 - 96; const int aj = j < 0 ? -j : j;
        DBT[i] = (aj <= 64) ? rel_bias[rel_bucket(j * (1 << (2 * g))) * 32 + 8 + 8 * g + head] * LOG2E - M2 : -1e30f; }
    __syncthreads();
    const int row0 = span * 512, seqbase = row0 & ~(S - 1), t0 = row0 & (S - 1);
#pragma unroll
    for (int g = 0; g < 3; ++g) {
        const int lgr = 2 * g, r = 1 << lgr, L = S >> lgr, nblk = 16 >> lgr;
        const bf16* Qh = DIL + (size_t)((g * 3 + 0) * 8 + head) * ((size_t)CH * 64); const bf16* Kh = DIL + (size_t)((g * 3 + 1) * 8 + head) * ((size_t)CH * 64); const bf16* Vh = DIL + (size_t)((g * 3 + 2) * 8 + head) * ((size_t)CH * 64);
        for (int j = wid; j < 16; j += 8) { const int cl = j / nblk, blk = j % nblk, lq0 = (t0 >> lgr) + 32 * blk;
            if (g == 0) dil_task<PRE, false>(Qh, Kh, Vh, seqbase + cl * L + lq0, lq0, L, r, lq0 * r + cl - t0, DBT + 200 * g, Nsum, Dsum, lds + DL_VS + wid * 2048, lane);
            else dil_task<PRE, true>(Qh, Kh, Vh, seqbase + cl * L + lq0, lq0, L, r, lq0 * r + cl - t0, DBT + 200 * g, Nsum, Dsum, lds + DL_VS + wid * 2048, lane); }
        if (g < 2) __syncthreads();
    }
    __syncthreads();
#pragma unroll
    for (int i = 0; i < 8; ++i) { const int row = (tid >> 3) + 64 * i, dc = tid & 7; const float inv = 1.0f / Dsum[row];
        const f32x4 a = *(const LASC f32x4*)(Nsum + row * 64 + dc * 8), b = *(const LASC f32x4*)(Nsum + row * 64 + dc * 8 + 4);
        u32x4 w; w.x = cvtpk(a[0] * inv, a[1] * inv); w.y = cvtpk(a[2] * inv, a[3] * inv); w.z = cvtpk(b[0] * inv, b[1] * inv); w.w = cvtpk(b[2] * inv, b[3] * inv);
        *(u32x4*)(YB + (size_t)(row0 + row) * 512 + head * 64 + dc * 8) = w; }
    __syncthreads();
}
}
#define LAS __attribute__((address_space(3)))
typedef unsigned short bf16;
typedef unsigned v4u __attribute__((ext_vector_type(4)));
typedef float f32x4 __attribute__((ext_vector_type(4)));
constexpr int NWAVES = 8, LDS_BYTES = 163840, BST_OFF = 163840 - 64;
constexpr int TOK = 32768, DM = 1024, CH = 16384, FF = 4096, NIN = 9728;
constexpr size_t MiB = 1u << 20;
constexpr size_t WS_MOD = 1 * MiB, WS_SBIAS = WS_MOD + 160 * 1024, WS_ROWSS = WS_MOD + 320 * 1024;
constexpr size_t WS_WIN = 2 * MiB, WS_WBA = 21 * MiB, WS_WBB = 23 * MiB, WS_WO = 24 * MiB, WS_WUP = 26 * MiB, WS_WDN = 34 * MiB;
constexpr size_t WS_QK = 42 * MiB, WS_VA = 106 * MiB, WS_DIL = 138 * MiB, WS_GT = 282 * MiB, WS_MG = 346 * MiB, WS_END = 410 * MiB;
constexpr size_t WS_A2 = 42 * MiB, WS_H = 106 * MiB;
constexpr size_t DO_XN = 0, DO_YA = 64 * MiB, DO_YB = 96 * MiB;
#define LDS_WAIT() asm volatile("s_waitcnt lgkmcnt(0)" ::: "memory")
#define XB_TMO      128
#define XB_XCNT(j)  (256  + 64 * (j))
#define XB_XSUB(j)  (1280 + 64 * (j))
#define XB_XGEN(j)  (2304 + 64 * (j))
#define XB_TOP      3328
#define XB_TOPGEN   3392
#define XCD_BAR_WORDS 3456
#define XB_SPIN_CAP (1u << 18)

__device__ __forceinline__ unsigned xb_ld(unsigned* p)              { return __hip_atomic_load(p, __ATOMIC_RELAXED, __HIP_MEMORY_SCOPE_AGENT); }
__device__ __forceinline__ unsigned xb_add(unsigned* p, unsigned v) { return __hip_atomic_fetch_add(p, v, __ATOMIC_RELAXED, __HIP_MEMORY_SCOPE_AGENT); }
__device__ __forceinline__ unsigned xb_xcc_id() { return (unsigned)__builtin_amdgcn_s_getreg((3 << 11) | 20) & 0xFu; }
#define XB_SPIN(cond, bar) do { unsigned _sp = 0; while (cond) { __builtin_amdgcn_s_sleep(1); \
    if ((++_sp & 255u) == 0u) { if (xb_ld(&(bar)[XB_TMO])) break; if (_sp > XB_SPIN_CAP) { atomicAdd(&(bar)[XB_TMO], 1u); break; } } } } while (0)

struct XcdBarrier {
    unsigned* bar; unsigned x;
    volatile LAS unsigned* st;
};

__device__ __forceinline__ XcdBarrier xcd_barrier_post(unsigned* bar, volatile LAS unsigned* st) {
    XcdBarrier b; b.bar = bar; b.x = xb_xcc_id(); b.st = st;
    if (threadIdx.x == 0) (void)xb_add(&bar[XB_XCNT(b.x)], 1u);
    return b;
}
__device__ __forceinline__ void xcd_barrier_complete(unsigned* bar, unsigned x, unsigned& nloc, unsigned& nx) {
    const unsigned G = gridDim.x * gridDim.y * gridDim.z;
    unsigned sum, cnt, mine, sp = 0u;
    for (;;) {
        sum = 0u; cnt = 0u; mine = 0u;
#pragma unroll
        for (unsigned j = 0; j < 16; ++j) { const unsigned c = xb_ld(&bar[XB_XCNT(j)]); sum += c; cnt += (c > 0u) ? 1u : 0u; mine = (j == x) ? c : mine; }
        if (sum == G) break;
        __builtin_amdgcn_s_sleep(1);
        if ((++sp & 255u) == 0u) { if (xb_ld(&bar[XB_TMO])) break; if (sp > XB_SPIN_CAP) { atomicAdd(&bar[XB_TMO], 1u); break; } }
    }
    nloc = mine > 0u ? mine : 1u; nx = cnt > 0u ? cnt : 1u;
}

__device__ __forceinline__ void xcd_barrier(const XcdBarrier& b) {
    asm volatile("s_waitcnt vmcnt(0)" ::: "memory");
    __syncthreads();
    if (threadIdx.x == 0) {
        unsigned* bar = b.bar;
        __builtin_amdgcn_s_waitcnt(0);
        unsigned nloc = b.st[0], nx = b.st[1];
        if (nloc == 0u) { xcd_barrier_complete(bar, b.x, nloc, nx); b.st[0] = nloc; b.st[1] = nx; }
        const unsigned old = xb_add(&bar[XB_XSUB(b.x)], 1u);
        const unsigned gen = old / nloc;
        if (old + 1u == (gen + 1u) * nloc) {
            __builtin_amdgcn_fence(__ATOMIC_RELEASE, "agent");
            asm volatile("s_waitcnt vmcnt(0)" ::: "memory");
            const unsigned og = xb_add(&bar[XB_TOP], 1u);
            const unsigned tg = og / nx;
            if (og + 1u == (tg + 1u) * nx) xb_add(&bar[XB_TOPGEN], 1u);
            else XB_SPIN(xb_ld(&bar[XB_TOPGEN]) == tg, bar);
            __builtin_amdgcn_fence(__ATOMIC_ACQUIRE, "agent");
            xb_add(&bar[XB_XGEN(b.x)], 1u);
            asm volatile("s_waitcnt vmcnt(0)" ::: "memory");
        } else {
            XB_SPIN(xb_ld(&bar[XB_XGEN(b.x)]) == gen, bar);
            __builtin_amdgcn_fence(__ATOMIC_ACQUIRE, "agent");
            asm volatile("s_waitcnt vmcnt(0)" ::: "memory");
        }
    }
    __syncthreads();
}

__device__ __forceinline__ unsigned f2bf(float f) { unsigned u = __builtin_bit_cast(unsigned, f); return (u + 0x7fffu + ((u >> 16) & 1u)) >> 16; }
__device__ __forceinline__ unsigned pk2(float lo, float hi) { return f2bf(lo) | (f2bf(hi) << 16); }
__device__ __forceinline__ float wave_sum(float v) {
    v += swz_xor<1>(v); v += swz_xor<2>(v); v += swz_xor<4>(v); v += swz_xor<8>(v); v += swz_xor<16>(v);
    return add_x32(v);
}
__device__ __forceinline__ float wave_max(float v) {
    v = fmaxf(v, swz_xor<1>(v)); v = fmaxf(v, swz_xor<2>(v)); v = fmaxf(v, swz_xor<4>(v)); v = fmaxf(v, swz_xor<8>(v)); v = fmaxf(v, swz_xor<16>(v));
    return max_x32(v);
}
template <bool PERMW> __device__ __forceinline__ void transpose_item(const float* W, int K, int N, bf16* WT, LAS float* scr, int item, int lane) {
    const int nblk = N / 32, kb = item / nblk, nb = item % nblk, k0 = 64 * kb, n0 = 32 * nb;
#pragma unroll 8
    for (int i = 0; i < 32; ++i) { const int kk = 2 * i + (lane >> 5); scr[kk * 33 + (lane & 31)] = W[(size_t)(k0 + kk) * N + n0 + (lane & 31)]; }
    LDS_WAIT(); asm volatile("" ::: "memory");
    const int c = lane & 7;
    int n0p = n0; if (PERMW) { const int lg = nb & 7; n0p = (nb & ~7) * 32 + 32 * (4 * (lg & 1) + (lg >> 1)); }
#pragma unroll
    for (int j = 0; j < 4; ++j) { const int n = (lane >> 3) + 8 * j; const LAS float* s = scr + (8 * c) * 33 + n;
        v4u o; o.x = pk2(s[0 * 33], s[1 * 33]); o.y = pk2(s[2 * 33], s[3 * 33]); o.z = pk2(s[4 * 33], s[5 * 33]); o.w = pk2(s[6 * 33], s[7 * 33]);
        *(v4u*)(WT + (size_t)(n0p + n) * K + k0 + 8 * c) = o; }
    LDS_WAIT(); asm volatile("" ::: "memory");
}
__device__ __forceinline__ void gemv6_task(const LAS float* vec, LAS f32x4* red, const float* W, int N, int col0, const float* bias, float* out, int tid) {
    const int cgp = tid & 7, ks = tid >> 3;
    f32x4 acc[6];
#pragma unroll
    for (int b = 0; b < 6; ++b) acc[b] = (f32x4){0.f, 0.f, 0.f, 0.f};
#pragma unroll 4
    for (int kk = 0; kk < 16; ++kk) { const int k = ks * 16 + kk; const f32x4 w = *(const f32x4*)(W + (size_t)k * N + col0 + 4 * cgp);
#pragma unroll
        for (int b = 0; b < 6; ++b) acc[b] += w * vec[b * 1024 + k]; }
#pragma unroll
    for (int b = 0; b < 6; ++b) red[(ks * 8 + cgp) * 6 + b] = acc[b];
    __syncthreads();
    if (tid < 192) { const int b = tid >> 5, c = tid & 31; float s = 0.f; const LAS float* rf = (const LAS float*)red;
        for (int k2 = 0; k2 < 64; ++k2) s += rf[((k2 * 8 + (c >> 2)) * 6 + b) * 4 + (c & 3)];
        out[b * N + col0 + c] = s + (bias ? bias[col0 + c] : 0.f); }
    __syncthreads();
}

struct Args { const float* in[24]; float* out; unsigned char* ws; int ph_lo, ph_hi; };
constexpr int NPHASE = 11;

__global__ void __launch_bounds__(NWAVES * 64, 2) mk_fwd(Args a) {
    extern __shared__ __attribute__((aligned(16))) unsigned char lds_raw[];
    cg::grid_group grid = cg::this_grid();
    LAS unsigned char* lds = (LAS unsigned char*)lds_raw;
    const int wave = __builtin_amdgcn_readfirstlane((int)threadIdx.x >> 6);
#define lane (att::lane_now())
#define tid ((wave << 6) | att::lane_now())
    const int G = gridDim.x; const int bx = blockIdx.x; const int vcu = (G % 8 == 0) ? (bx % 8) * (G / 8) + bx / 8 : bx;
    const int gw = vcu * NWAVES + wave, NGW = G * NWAVES;
    unsigned char* ws = a.ws; unsigned char* dob = (unsigned char*)a.out;
    const float *x_p = a.in[0], *x_s = a.in[1], *c_p = a.in[2], *c_s = a.in[3], *rel_bias = a.in[4], *norm1_g = a.in[5], *w_ada = a.in[6], *b_ada = a.in[7], *w_in = a.in[8],
                *qn_a = a.in[9], *kn_a = a.in[10], *lq1 = a.in[11], *lk1 = a.in[12], *lq2 = a.in[13], *lk2 = a.in[14], *subln_g = a.in[15], *qn_b = a.in[16], *kn_b = a.in[17],
                *w_br_a = a.in[18], *w_br_b = a.in[19], *w_o = a.in[20], *norm2_g = a.in[21], *w_up = a.in[22], *w_down = a.in[23];
    float* mod = (float*)(ws + WS_MOD); float* sbias = (float*)(ws + WS_SBIAS); float* rowss = (float*)(ws + WS_ROWSS);
    bf16 *WinT = (bf16*)(ws + WS_WIN), *WbaT = (bf16*)(ws + WS_WBA), *WbbT = (bf16*)(ws + WS_WBB), *WoT = (bf16*)(ws + WS_WO), *WupT = (bf16*)(ws + WS_WUP), *WdnT = (bf16*)(ws + WS_WDN);
    bf16 *QK = (bf16*)(ws + WS_QK), *VA = (bf16*)(ws + WS_VA), *DIL = (bf16*)(ws + WS_DIL), *GT = (bf16*)(ws + WS_GT), *MG = (bf16*)(ws + WS_MG), *A2 = (bf16*)(ws + WS_A2), *HB = (bf16*)(ws + WS_H);
    bf16 *XN = (bf16*)(dob + DO_XN), *YA = (bf16*)(dob + DO_YA), *YB = (bf16*)(dob + DO_YB);
    const int lo = a.ph_lo, hi = a.ph_hi;
    volatile LAS unsigned* bst = (volatile LAS unsigned*)(lds + BST_OFF);
    if (threadIdx.x < 4) bst[threadIdx.x] = 0u;
    __syncthreads();
    const XcdBarrier xbar = xcd_barrier_post((unsigned*)ws, bst);
#ifndef PH_MASK
#define PH_MASK 0x7ff
#endif
#define PH_ON(k) ((PH_MASK >> (k)) & 1)
#ifndef PH_REP
#define PH_REP 0
#endif
#define NREP(k) ((((PH_REP) >> (k)) & 1) ? 2 : 1)
#define IN(k) (lo <= (k) && (k) < hi)
#ifndef XSYNC
#define XSYNC 0
#endif
#define SEAM(k) do { if (IN(k) && IN((k) + 1)) { if ((k) == 0) grid.sync(); else xcd_barrier(xbar); for (int xs_ = 0; xs_ < XSYNC; ++xs_) xcd_barrier(xbar); } } while (0)

    if (PH_ON(0) && IN(0)) for (int rep_ = 0; rep_ < NREP(0); ++rep_) {
        LAS float* scr = (LAS float*)(lds + wave * 16384);
        constexpr int I_IN = (DM / 64) * (NIN / 32), I_BA = (DM / 64) * (DM / 32), I_BB = (512 / 64) * (DM / 32), I_O = I_BA, I_UP = (DM / 64) * (FF / 32), I_DN = (FF / 64) * (DM / 32);
        constexpr int NITEMS = I_IN + I_BA + I_BB + I_O + I_UP + I_DN;
        for (int it = gw; it < NITEMS; it += NGW) {
            int r = it;
            if (r < I_IN) { transpose_item<true>(w_in, DM, NIN, WinT, scr, r, lane); continue; } r -= I_IN;
            if (r < I_BA) { transpose_item<false>(w_br_a, DM, DM, WbaT, scr, r, lane); continue; } r -= I_BA;
            if (r < I_BB) { transpose_item<false>(w_br_b, 512, DM, WbbT, scr, r, lane); continue; } r -= I_BB;
            if (r < I_O) { transpose_item<false>(w_o, DM, DM, WoT, scr, r, lane); continue; } r -= I_O;
            if (r < I_UP) { transpose_item<false>(w_up, DM, FF, WupT, scr, r, lane); continue; } r -= I_UP;
            transpose_item<false>(w_down, FF, DM, WdnT, scr, r, lane);
        }
        for (int i = gw * 64 + lane; i < TOK; i += NGW * 64) rowss[i] = 0.f;
        __syncthreads();
        LAS float* vec = (LAS float*)lds; LAS f32x4* red = (LAS f32x4*)(lds + 32768);
        for (int i = tid; i < 6 * 1024; i += 512) { const int b = i >> 10, k = i & 1023; const float c = b < 4 ? c_p[b * 1024 + k] : c_s[(b - 4) * 1024 + k]; vec[i] = c / (1.0f + __expf(-c)); }
        __syncthreads();
        for (int task = vcu; task < 6144 / 32; task += G) gemv6_task(vec, red, w_ada, 6144, task * 32, b_ada, mod, tid);
        __syncthreads();
    }
    SEAM(0);
    if (PH_ON(1) && IN(1)) for (int rep_ = 0; rep_ < NREP(1); ++rep_) {
        for (int m = gw; m < TOK; m += NGW) {
            const float* xr = m < 16384 ? x_p + (size_t)m * 1024 : x_s + (size_t)(m - 16384) * 1024; const int b = pg8::batch_of(m);
            const float* sh1 = mod + b * 6144; const float* sc1 = mod + b * 6144 + 1024;
            f32x4 v[4]; float s = 0.f;
#pragma unroll
            for (int j = 0; j < 4; ++j) { v[j] = ((const f32x4*)xr)[lane + 64 * j]; s += (v[j].x * v[j].x + v[j].y * v[j].y) + (v[j].z * v[j].z + v[j].w * v[j].w); }
            const float rstd = 1.0f / sqrtf(wave_sum(s) * (1.0f / 1024.0f) + 1e-6f);
            unsigned long long* o8 = (unsigned long long*)(XN + (size_t)m * 1024) + lane;
#pragma unroll
            for (int j = 0; j < 4; ++j) { const int c = 4 * lane + 256 * j; const f32x4 g = *(const f32x4*)(norm1_g + c), sc = *(const f32x4*)(sc1 + c), sh = *(const f32x4*)(sh1 + c);
                const f32x4 h = v[j] * rstd * g * (sc + 1.0f) + sh;
                o8[64 * j] = (unsigned long long)pk2(h.x, h.y) | ((unsigned long long)pk2(h.z, h.w) << 32); }
        }
        __syncthreads();
        LAS float* vec = (LAS float*)lds; LAS f32x4* red = (LAS f32x4*)(lds + 32768);
        for (int i = tid; i < 6 * 1024; i += 512) { const int b = i >> 10, k = i & 1023; vec[i] = mod[b * 6144 + 3072 + k]; }
        __syncthreads();
        for (int task = vcu; task < FF / 32; task += G) gemv6_task(vec, red, w_up, FF, task * 32, nullptr, sbias, tid);
        __syncthreads();
    }
    SEAM(1);
#pragma unroll 1
    for (int c = 0; c < 2; ++c) {
        const int S = c == 0 ? 4096 : 8192, lgS = c == 0 ? 12 : 13;
        if (PH_ON(2) && IN(2 + 3 * c)) for (int rep_ = 0; rep_ < NREP(2); ++rep_) {
            pg8::Gemm g{XN + (size_t)c * CH * DM, WinT, CH, NIN, DM}; pg8::StaticOrder SO; SO.init(CH, NIN, G, bx);
            pg8::EpiProj E{QK, VA, DIL, GT, qn_a, kn_a, qn_b, kn_b, S, lgS};
            pg8::gemm_phase<pg8::EpiProj, pg8::StaticOrder, true, true>(lds, g, SO, E);
        }
        SEAM(2 + 3 * c);
        if (PH_ON(3) && IN(3 + 3 * c)) for (int rep_ = 0; rep_ < NREP(3); ++rep_) {
            if (wave == 0) {
                const int ln = lane;
                const float a1 = wave_sum(lq1[ln] * lk1[ln]), a2 = wave_sum(lq2[ln] * lk2[ln]);
                const float gqa = wave_max(fabsf(qn_a[ln])), gka = wave_max(fabsf(kn_a[ln]));
                float gb = 0.f;
#pragma unroll
                for (int g = 0; g < 3; ++g) gb = fmaxf(gb, wave_max(fabsf(qn_b[64 * g + ln])) * wave_max(fabsf(kn_b[64 * g + ln])));
                float ba = 0.f, bb = 0.f;
                for (int i = ln; i < 1024; i += 64) { const float v = fabsf(rel_bias[i]); if ((i & 31) < 8) ba = fmaxf(ba, v); else bb = fmaxf(bb, v); }
                ba = wave_max(ba); bb = wave_max(bb);
                if (ln == 0) { LAS float* SC = (LAS float*)(lds + att::SC_OFF); SC[0] = __expf(a1) - __expf(a2) + 0.2f; SC[1] = (8.0f * gqa * gka + ba) * att::LOG2E; SC[2] = (8.0f * gb + bb) * att::LOG2E; }
            }
            __syncthreads();
            { const int span = vcu >> 3, head = vcu & 7;
#ifndef NO_DIL
#ifndef REP_DIL
#define REP_DIL 1
#endif
              for (int rd_ = 0; rd_ < REP_DIL; ++rd_)
#ifndef DIL_MODE
#define DIL_MODE 0
#endif
              if (DIL_MODE >= 1) for (int u = vcu; u < 256; u += G) att::dil_unit<true>(lds, DIL, YB, rel_bias, u & 7, u >> 3, S, lgS, tid);
              if (DIL_MODE != 1) for (int u = vcu; u < 256; u += G) att::dil_unit<false>(lds, DIL, YB, rel_bias, u & 7, u >> 3, S, lgS, tid);
#endif
              (void)span; (void)head; }
            { const int nqb = S / 256;
#ifndef NO_DA
              for (int u = vcu; u < 512; u += G) { const int sh = u / nqb, qb = u % nqb, seq = sh >> 3, head = sh & 7;
                  att::da_unit(lds, QK, VA, YA, rel_bias, subln_g, head, seq * (S / 64), S / 64, qb, tid); }
#endif
              (void)nqb; }
        }
        SEAM(3 + 3 * c);
        if (PH_ON(4) && IN(4 + 3 * c)) for (int rep_ = 0; rep_ < NREP(4); ++rep_) {
#ifndef NO_P3A
            { pg8::Gemm g{YB, WbbT, CH, DM, 512}; pg8::StaticOrder SO; SO.init(CH, DM, G, bx);
              pg8::EpiBr<false> E{MG + (size_t)c * CH * DM, GT + (size_t)CH * 1024};
              pg8::gemm_phase<pg8::EpiBr<false>, pg8::StaticOrder, true, true>(lds, g, SO, E); }
#endif
            asm volatile("s_waitcnt vmcnt(0)" ::: "memory"); __syncthreads();
#ifndef NO_P3B
            { pg8::Gemm g{YA, WbaT, CH, DM, DM}; pg8::StaticOrder SO; SO.init(CH, DM, G, bx);
              pg8::EpiBr<true> E{MG + (size_t)c * CH * DM, GT};
              pg8::gemm_phase<pg8::EpiBr<true>, pg8::StaticOrder, true, true>(lds, g, SO, E); }
#endif
        }
        SEAM(4 + 3 * c);
    }
    if (PH_ON(8) && IN(8)) for (int rep_ = 0; rep_ < NREP(8); ++rep_) {
        pg8::Gemm g{MG, WoT, TOK, DM, DM}; pg8::StaticOrder SO; SO.init(TOK, DM, G, bx);
        pg8::EpiWo E{x_p, x_s, a.out, A2, mod, norm2_g, rowss};
        pg8::gemm_phase<pg8::EpiWo, pg8::StaticOrder, true, true>(lds, g, SO, E);
    }
    SEAM(8);
    if (PH_ON(9) && IN(9)) for (int rep_ = 0; rep_ < NREP(9); ++rep_) {
        pg8::Gemm g{A2, WupT, TOK, FF, DM}; pg8::StaticOrder SO; SO.init(TOK, FF, G, bx);
        pg8::EpiUp E{HB, rowss, sbias};
        pg8::gemm_phase<pg8::EpiUp, pg8::StaticOrder, true, true>(lds, g, SO, E);
    }
    SEAM(9);
    if (PH_ON(10) && IN(10)) for (int rep_ = 0; rep_ < NREP(10); ++rep_) {
        pg8::Gemm g{HB, WdnT, TOK, DM, FF}; pg8::StaticOrder SO; SO.init(TOK, DM, G, bx);
        pg8::EpiDown E{a.out, mod};
        pg8::gemm_phase<pg8::EpiDown, pg8::StaticOrder, true, true>(lds, g, SO, E);
    }
#undef IN
#undef SEAM
#undef lane
#undef tid
}

extern "C" void kernel_launch(void* const* d_in, const int* in_sizes, int n_in, void* d_out, int out_size, void* d_ws, size_t ws_size, hipStream_t stream) {
    static int grid = 0;
    if (grid == 0) {
        if (n_in != 24 || out_size != TOK * DM || ws_size < WS_END) { fprintf(stderr, "kernel_launch: unexpected shapes (n_in %d, out %d, ws %zu)\n", n_in, out_size, ws_size); grid = -1; return; }
        int dev = 0, cus = 0, per_cu = 0;
        if (hipGetDevice(&dev) != hipSuccess || hipDeviceGetAttribute(&cus, hipDeviceAttributeMultiprocessorCount, dev) != hipSuccess) { grid = -1; return; }
        if (hipFuncSetAttribute((const void*)mk_fwd, hipFuncAttributeMaxDynamicSharedMemorySize, LDS_BYTES) != hipSuccess) { fprintf(stderr, "kernel_launch: hipFuncSetAttribute failed\n"); grid = -1; return; }
        if (hipOccupancyMaxActiveBlocksPerMultiprocessor(&per_cu, (const void*)mk_fwd, NWAVES * 64, LDS_BYTES) != hipSuccess || per_cu < 1) { fprintf(stderr, "kernel_launch: occupancy query says %d\n", per_cu); per_cu = 1; }
        (void)hipGetLastError();
        grid = cus;
    }
    if (grid < 0) return;
    if (hipMemsetAsync(d_ws, 0, 65536, stream) != hipSuccess) { fprintf(stderr, "kernel_launch: hipMemsetAsync failed\n"); return; }
    Args a{};
    for (int i = 0; i < 24; ++i) a.in[i] = (const float*)d_in[i];
    a.out = (float*)d_out; a.ws = (unsigned char*)d_ws;
#ifndef MK_PER_PHASE
    a.ph_lo = 0; a.ph_hi = NPHASE;
    void* args[] = {&a};
    hipError_t e = hipLaunchCooperativeKernel((const void*)mk_fwd, dim3(grid), dim3(NWAVES * 64), args, LDS_BYTES, stream);
    if (e != hipSuccess) fprintf(stderr, "kernel_launch: cooperative launch failed: %s (grid %d)\n", hipGetErrorString(e), grid);
#else
    for (int p = 0; p < NPHASE; ++p) { a.ph_lo = p; a.ph_hi = p + 1; hipLaunchKernelGGL(mk_fwd, dim3(grid), dim3(NWAVES * 64), LDS_BYTES, stream, a); }
#endif
}
```

```cpp
#include <hip/hip_runtime.h>
#include <hip/hip_cooperative_groups.h>
#include <cstdio>
#include <cstdint>
namespace cg = cooperative_groups;
template <int M> __device__ __forceinline__ float swz_xor(float v) { return __builtin_bit_cast(float, __builtin_amdgcn_ds_swizzle(__builtin_bit_cast(int, v), (M << 10) | 0x1f)); }
__device__ __forceinline__ float add_x32(float v) { const unsigned b = __builtin_bit_cast(unsigned, v); auto rr = __builtin_amdgcn_permlane32_swap(b, b, false, false); return __builtin_bit_cast(float, (unsigned)rr[0]) + __builtin_bit_cast(float, (unsigned)rr[1]); }
__device__ __forceinline__ float max_x32(float v) { const unsigned b = __builtin_bit_cast(unsigned, v); auto rr = __builtin_amdgcn_permlane32_swap(b, b, false, false); return fmaxf(__builtin_bit_cast(float, (unsigned)rr[0]), __builtin_bit_cast(float, (unsigned)rr[1])); }
namespace pg8 {
#define PG8_LAS __attribute__((address_space(3)))
typedef unsigned short bf16_t;
typedef short bf16x8 __attribute__((ext_vector_type(8)));
typedef float f32x4 __attribute__((ext_vector_type(4)));
typedef unsigned u32x4 __attribute__((ext_vector_type(4)));
constexpr int BM = 256, BK = 64, HALF = 128, HTB = HALF * BK * 2  , STAGE_BYTES = 8 * HTB, NXCD = 8, WGM = 8;

__host__ __device__ __forceinline__ int lds_byte(int r, int c) { const int st = (r >> 4) * 2 + (c >> 5), rr = r & 15, cc = c & 31, ob = rr * 64 + cc * 2; return st * 1024 + (ob ^ (((ob >> 9) & 1) << 5)); }
__host__ __device__ __forceinline__ void stage_rc(int b, int& R, int& C) { const int st = b / 1024, sb = b % 1024, swz = sb ^ (((sb >> 9) & 1) << 5); R = (st >> 1) * 16 + swz / 64; C = (st & 1) * 32 + (swz % 64) / 2; }
__host__ __device__ __forceinline__ int perm32(int rho) { const int n = rho >> 4, i = rho & 15; return 8 * (i >> 2) + 4 * n + (i & 3); }

struct Unit { int pm, pn; };
struct Gemm { const bf16_t* A; const bf16_t* Bt; int M, N, K; int atile = 0; int lda = 0, ldb = 0; };
#ifndef ATILE_ON
#define PG8_ATILE 0
#define PG8_ABJ 128
__host__ __device__ __forceinline__ size_t a_tiled(int row, int col, int K) { return (size_t)row * K + col; }
#else
#define PG8_ATILE 1
#define PG8_ABJ (16 * 128)
__host__ __device__ __forceinline__ size_t a_tiled(int row, int col, int K) { return ((size_t)(row >> 4) * (K >> 3) + (col >> 3)) * 128 + (row & 15) * 8 + (col & 7); }
#endif

struct StaticOrder {
    int nM, nN, nwg, G, c;
    __host__ __device__ void init(int M, int N, int G_, int c_) { nM = M / BM; nN = N / BM; nwg = nM * nN; G = G_; c = c_; }
    __host__ __device__ bool next(int i, Unit& u) const {
        const long L = (long)i * G + c; if (L >= nwg) return false;
        int wgid = (int)L; { const int q = nwg / NXCD, r = nwg % NXCD, xcd = wgid % NXCD; int off = wgid / NXCD;
#ifndef SO_NOMIX
            if (r == 0) { const int rot = ((xcd >> 1) * (q >> 2)) & ~7; off = (off + rot) % q; if (xcd & 1) off = q - 1 - off; }
#endif
            wgid = (xcd < r ? xcd * (q + 1) : r * (q + 1) + (xcd - r) * q) + off; }
        const int nig = WGM * nN, gid = wgid / nig, fm = gid * WGM, gsz = (nM - fm) < WGM ? (nM - fm) : WGM;
        u.pm = fm + ((wgid % nig) % gsz); u.pn = (wgid % nig) / gsz; return true;
    }
    __device__ __forceinline__ void a_ready(const Unit&) const {}
    __device__ __forceinline__ void done(const Unit&) const {}
};
typedef __bf16 pk_bf16x2_t __attribute__((ext_vector_type(2)));
typedef float pk_f32x2_t __attribute__((ext_vector_type(2)));
__device__ __forceinline__ unsigned cvt_pk_bf16(float lo, float hi) { pk_f32x2_t v = {lo, hi}; return __builtin_bit_cast(unsigned, __builtin_convertvector(v, pk_bf16x2_t)); }
template <class Epi, class Sched, bool ALIGN_EPI = false, bool SP2 = false>
__device__ __forceinline__ void gemm_phase(PG8_LAS unsigned char* lds, const Gemm g, const Sched& S, const Epi& E) {
    int tid_ = threadIdx.x; asm volatile("" : "+v"(tid_));
    const int tid = tid_, wid = __builtin_amdgcn_readfirstlane(tid >> 6), lane = tid & 63, wr = wid >> 2, wc = wid & 3, fr = lane & 15, fq = lane >> 4;
    const int K = g.K, nt = K / BK, lda = g.lda ? g.lda : K, ldb = g.ldb ? g.ldb : K;
    unsigned voffA[2], voffB[2];
#pragma unroll
    for (int i = 0; i < 2; ++i) { int R, C; stage_rc(tid * 16 + i * 8192, R, C); const int Rb = Epi::PERM ? ((R & ~31) + perm32(R & 31)) : R;
        voffA[i] = g.atile ? (unsigned)(((R >> 4) * (K >> 3) + (C >> 3)) * 256 + (R & 15) * 16) : (unsigned)(R * lda + C) * 2u; voffB[i] = (unsigned)(Rb * ldb + C) * 2u; }
    unsigned voffAc[2], voffAn[2]; size_t hstepAc, hstepAn;
#define PG8_APERM_SET(VO, HS, LGR) do { const int lg_ = (LGR); _Pragma("unroll") for (int i = 0; i < 2; ++i) { int R, C; stage_rc(tid * 16 + i * 8192, R, C); \
        const int Rp = lg_ ? ((R >> (8 - lg_)) + ((R & ((1 << (8 - lg_)) - 1)) << lg_)) : R; VO[i] = (unsigned)(Rp * K + C) * 2u; } \
        HS = (size_t)(lg_ ? (1 << (lg_ - 1)) : HALF) * K * 2; } while (0)
    const size_t kstep = (size_t)(BK * 2);
    const size_t hstep = (size_t)HALF * ldb * 2;
    const size_t tstep = 2 * hstep;
    const size_t kstepA = g.atile ? (size_t)2048 : kstep, hstepT = g.atile ? (size_t)K * 256 : (size_t)HALF * lda * 2, tstepA = 2 * hstepT;
    const unsigned ldsw = (unsigned)wid * 1024u;
    const int aoff = lds_byte(wr * 64 + fr, fq * 8), boff = lds_byte(wc * 32 + fr, fq * 8);
#define PG8_SA(b, h) (((b) * 2 + (h)) * HTB)
#define PG8_SB(b, h) ((4 + (b) * 2 + (h)) * HTB)
#define PG8_STAGE(bufoff, gbase, voff) do { _Pragma("unroll") for (int _i = 0; _i < 2; ++_i) \
        __builtin_amdgcn_global_load_lds((const unsigned*)((const char*)(gbase) + (voff)[_i]), (PG8_LAS unsigned*)(lds + (bufoff) + ldsw + _i * 8192), 16, 0, 0); } while (0)
#define PG8_LDA(dst, b, h) do { _Pragma("unroll") for (int m = 0; m < 4; ++m) _Pragma("unroll") for (int k = 0; k < 2; ++k) dst[m][k] = *(const PG8_LAS bf16x8*)(lds + PG8_SA(b, h) + aoff + m * 2048 + k * 1024); } while (0)
#define PG8_LDB(dst, b, h) do { _Pragma("unroll") for (int n = 0; n < 2; ++n) _Pragma("unroll") for (int k = 0; k < 2; ++k) dst[n][k] = *(const PG8_LAS bf16x8*)(lds + PG8_SB(b, h) + boff + n * 2048 + k * 1024); } while (0)
#define PG8_MMA(ai, bj, At, Bt) do { __builtin_amdgcn_s_setprio(1); _Pragma("unroll") for (int m = 0; m < 4; ++m) _Pragma("unroll") for (int n = 0; n < 2; ++n) _Pragma("unroll") for (int k = 0; k < 2; ++k) \
        acc[ai][bj][m][n] = __builtin_amdgcn_mfma_f32_16x16x32_bf16(Bt[n][k], At[m][k], acc[ai][bj][m][n], 0, 0, 0); __builtin_amdgcn_s_setprio(0); } while (0)
#define PG8_WAIT_V(n) asm volatile("s_waitcnt vmcnt(" #n ")" ::: "memory")
#define PG8_WAIT_L(n) asm volatile("s_waitcnt lgkmcnt(" #n ")" ::: "memory")
#define PG8_BAR __builtin_amdgcn_s_barrier()
#define PG8_SCHED __builtin_amdgcn_sched_barrier(0)
    Unit cur, nxt; int ui = 0;
    if (!S.next(0, cur)) return;
    f32x4 acc[2][2][4][2];
    if constexpr (Epi::INIT) E.init(acc, cur, wr, wc, fr, fq);
    else {
#pragma unroll
    for (int a = 0; a < 2; ++a)
#pragma unroll
        for (int b = 0; b < 2; ++b)
#pragma unroll
            for (int m = 0; m < 4; ++m)
#pragma unroll
                for (int n = 0; n < 2; ++n) acc[a][b][m][n] = (f32x4){0.f, 0.f, 0.f, 0.f};
    }
    bf16x8 At[4][2], B0[2][2], B1[2][2];
    const char* cA = (const char*)g.A + (size_t)cur.pm * tstepA + E.a_off(cur); const char* cB = (const char*)g.Bt + (size_t)cur.pn * tstep + E.bt_off(cur);
    if constexpr (Epi::APERM) { PG8_APERM_SET(voffAc, hstepAc, E.a_lgr(cur)); } else { voffAc[0] = voffA[0]; voffAc[1] = voffA[1]; hstepAc = hstepT; }
    S.a_ready(cur);
    if constexpr (SP2) {
        PG8_STAGE(PG8_SB(0, 0), cB, voffB); PG8_STAGE(PG8_SB(0, 1), cB + hstep, voffB); PG8_STAGE(PG8_SA(0, 0), cA, voffAc); PG8_STAGE(PG8_SA(0, 1), cA + hstepAc, voffAc);
        if (wr == 1) PG8_BAR;
        PG8_WAIT_V(2); PG8_BAR;
        PG8_STAGE(PG8_SB(1, 0), cB + kstep, voffB); PG8_STAGE(PG8_SA(1, 0), cA + kstepA, voffAc); PG8_STAGE(PG8_SB(1, 1), cB + hstep + kstep, voffB);
        PG8_WAIT_V(6); PG8_BAR;
    } else {
        PG8_STAGE(PG8_SB(0, 0), cB, voffB); PG8_STAGE(PG8_SA(0, 0), cA, voffA); PG8_STAGE(PG8_SB(0, 1), cB + hstep, voffB); PG8_STAGE(PG8_SA(0, 1), cA + hstep, voffA);
        if (wr == 1) PG8_BAR;
        PG8_WAIT_V(4); PG8_BAR;
        PG8_STAGE(PG8_SB(1, 0), cB + kstep, voffB); PG8_STAGE(PG8_SA(1, 0), cA + kstep, voffA); PG8_STAGE(PG8_SB(1, 1), cB + hstep + kstep, voffB);
        PG8_WAIT_V(6); PG8_BAR;
    }
    for (;;) {
        const bool has_next = S.next(ui + 1, nxt);
        const char* nA = has_next ? (const char*)g.A + (size_t)nxt.pm * tstepA + E.a_off(nxt) : cA; const char* nB = has_next ? (const char*)g.Bt + (size_t)nxt.pn * tstep + E.bt_off(nxt) : cB;
        if constexpr (Epi::APERM) { if (has_next) { PG8_APERM_SET(voffAn, hstepAn, E.a_lgr(nxt)); } else { voffAn[0] = voffAc[0]; voffAn[1] = voffAc[1]; hstepAn = hstepAc; } }
        else { voffAn[0] = voffA[0]; voffAn[1] = voffA[1]; hstepAn = hstepT; }
        for (int t = 0; t < nt; t += 2) {
            if constexpr (Epi::MIDFIX) { if (t == E.fix_t) E.midfix(acc, cur, wr, wc, fr, fq); }
            const bool last = (t == nt - 2);
            const char* a1 = cA + (size_t)(t + 1) * kstepA;
            const char* a2 = last ? nA : cA + (size_t)(t + 2) * kstepA; const char* b2 = last ? nB : cB + (size_t)(t + 2) * kstep;
            const char* a3 = a2 + kstepA; const char* b3 = b2 + kstep;
            if (last && has_next) S.a_ready(nxt);
            unsigned vo2[2]; vo2[0] = last ? voffAn[0] : voffAc[0]; vo2[1] = last ? voffAn[1] : voffAc[1]; const size_t hs2 = last ? hstepAn : hstepAc;
            if constexpr (SP2) {
            PG8_LDB(B0, 0, 0); PG8_LDB(B1, 0, 1); PG8_SCHED; PG8_LDA(At, 0, 0); PG8_STAGE(PG8_SA(1, 1), a1 + hstepAc, voffAc);
            PG8_WAIT_V(8); PG8_WAIT_L(0); PG8_BAR; PG8_MMA(0, 0, At, B0); PG8_MMA(0, 1, At, B1); PG8_BAR; PG8_SCHED;
            PG8_LDA(At, 0, 1); PG8_STAGE(PG8_SB(0, 0), b2, voffB); PG8_STAGE(PG8_SB(0, 1), b2 + hstep, voffB); PG8_STAGE(PG8_SA(0, 0), a2, vo2);
            PG8_WAIT_V(8); PG8_WAIT_L(0); PG8_BAR; PG8_MMA(1, 0, At, B0); PG8_MMA(1, 1, At, B1); PG8_BAR; PG8_SCHED;
            PG8_LDB(B0, 1, 0); PG8_LDB(B1, 1, 1); PG8_SCHED; PG8_LDA(At, 1, 0); PG8_STAGE(PG8_SA(0, 1), a2 + hs2, vo2);
            PG8_WAIT_V(8); PG8_WAIT_L(0); PG8_BAR; PG8_MMA(0, 0, At, B0); PG8_MMA(0, 1, At, B1); PG8_BAR; PG8_SCHED;
            PG8_LDA(At, 1, 1); PG8_STAGE(PG8_SB(1, 0), b3, voffB); PG8_STAGE(PG8_SB(1, 1), b3 + hstep, voffB); PG8_STAGE(PG8_SA(1, 0), a3, vo2);
            PG8_WAIT_V(8); PG8_WAIT_L(0); PG8_BAR; PG8_MMA(1, 0, At, B0); PG8_MMA(1, 1, At, B1); PG8_BAR; PG8_SCHED;
            } else {
            PG8_LDB(B0, 0, 0); PG8_SCHED; PG8_LDA(At, 0, 0); PG8_STAGE(PG8_SA(1, 1), a1 + hstep, voffA);
            PG8_WAIT_L(8); PG8_BAR; PG8_WAIT_L(0); PG8_MMA(0, 0, At, B0); PG8_BAR; PG8_SCHED;
            PG8_LDB(B1, 0, 1); PG8_STAGE(PG8_SB(0, 0), b2, voffB);
            PG8_BAR; PG8_WAIT_L(0); PG8_MMA(0, 1, At, B1); PG8_BAR;
            PG8_LDA(At, 0, 1); PG8_STAGE(PG8_SA(0, 0), a2, voffA);
            PG8_BAR; PG8_WAIT_L(0); PG8_MMA(1, 0, At, B0); PG8_BAR; PG8_SCHED;
            PG8_STAGE(PG8_SB(0, 1), b2 + hstep, voffB);
            PG8_WAIT_V(6); PG8_BAR; PG8_MMA(1, 1, At, B1); PG8_BAR;
            PG8_LDB(B0, 1, 0); PG8_SCHED; PG8_LDA(At, 1, 0); PG8_STAGE(PG8_SA(0, 1), a2 + hstep, voffA);
            PG8_WAIT_L(8); PG8_BAR; PG8_WAIT_L(0); PG8_MMA(0, 0, At, B0); PG8_BAR; PG8_SCHED;
            PG8_LDB(B1, 1, 1); PG8_STAGE(PG8_SB(1, 0), b3, voffB);
            PG8_BAR; PG8_WAIT_L(0); PG8_MMA(0, 1, At, B1); PG8_BAR;
            PG8_LDA(At, 1, 1); PG8_STAGE(PG8_SA(1, 0), a3, voffA);
            PG8_BAR; PG8_WAIT_L(0); PG8_MMA(1, 0, At, B0); PG8_BAR; PG8_SCHED;
            PG8_STAGE(PG8_SB(1, 1), b3 + hstep, voffB);
            PG8_WAIT_V(6); PG8_BAR; PG8_MMA(1, 1, At, B1); PG8_BAR;
            }
        }
        if constexpr (ALIGN_EPI) { if (wr == 0) PG8_BAR; }
        if constexpr (!Epi::AFTER_DRAIN) { E(acc, cur, wr, wc, fr, fq); S.done(cur); }
        if (!has_next) break;
        if constexpr (Epi::INIT) E.init(acc, nxt, wr, wc, fr, fq);
        else {
#pragma unroll
        for (int a = 0; a < 2; ++a)
#pragma unroll
            for (int b = 0; b < 2; ++b)
#pragma unroll
                for (int m = 0; m < 4; ++m)
#pragma unroll
                    for (int n = 0; n < 2; ++n) acc[a][b][m][n] = (f32x4){0.f, 0.f, 0.f, 0.f};
        }
        cur = nxt; cA = nA; cB = nB; ++ui; voffAc[0] = voffAn[0]; voffAc[1] = voffAn[1]; hstepAc = hstepAn;
        if constexpr (ALIGN_EPI) { if (wr == 1) PG8_BAR; }
    }
    PG8_WAIT_V(0);
    if constexpr (!ALIGN_EPI) { if (wr == 0) PG8_BAR; }
    PG8_BAR;
    if constexpr (Epi::AFTER_DRAIN) { E.fused(acc, cur, wr, wc, fr, fq, lds, wid, lane); S.done(cur); }
#undef PG8_SA
#undef PG8_SB
#undef PG8_STAGE
#undef PG8_LDA
#undef PG8_LDB
#undef PG8_MMA
#undef PG8_WAIT_V
#undef PG8_WAIT_L
#undef PG8_BAR
#undef PG8_SCHED
}
#define PG8_EPI_DEFAULTS static constexpr bool INIT = false, MIDFIX = false, APERM = false; __device__ __forceinline__ size_t bt_off(const Unit&) const { return 0; } __device__ __forceinline__ ptrdiff_t a_off(const Unit&) const { return 0; }
#ifndef LDH
#define LDH 4096
#endif
#ifdef NT_STORES
#define EPI_ST(T, p, v) __builtin_nontemporal_store((T)(v), (T*)(p))
#elif defined(NO_EPI_ST)
#define EPI_ST(T, p, v) do { T v_ = (v); asm volatile("" :: "v"(v_), "v"(p)); } while (0)
#else
#define EPI_ST(T, p, v) (*(T*)(p) = (v))
#endif
constexpr int CH = 16384;
constexpr float C2Q = 0.125f * 1.4426950408889634f;
__device__ __forceinline__ u32x4 pack8(const f32x4& a, const f32x4& b) { u32x4 w; w.x = cvt_pk_bf16(a[0], a[1]); w.y = cvt_pk_bf16(a[2], a[3]); w.z = cvt_pk_bf16(b[0], b[1]); w.w = cvt_pk_bf16(b[2], b[3]); return w; }
__device__ __forceinline__ f32x4 bf4lo(const u32x4& w) { return (f32x4){__uint_as_float(w.x << 16), __uint_as_float(w.x & 0xffff0000u), __uint_as_float(w.y << 16), __uint_as_float(w.y & 0xffff0000u)}; }
__device__ __forceinline__ f32x4 bf4hi(const u32x4& w) { return (f32x4){__uint_as_float(w.z << 16), __uint_as_float(w.z & 0xffff0000u), __uint_as_float(w.w << 16), __uint_as_float(w.w & 0xffff0000u)}; }
__device__ __forceinline__ int batch_of(int m) { return m < 16384 ? (m >> 12) : 4 + ((m - 16384) >> 13); }

#ifdef P1_NOCLASS
#define P1DR(x) lr
#else
#define P1DR(x) (x)
#endif
struct P1Order {
    int chunk, G, c;
    __device__ __forceinline__ bool next(int i, Unit& u) const {
        const int nwg = chunk == 0 ? 2432 : 2304, nN = chunk == 0 ? 38 : 36; const long L = (long)i * G + c; if (L >= nwg + (chunk == 0 ? 128 : 0)) return false;
        if (L >= nwg) { const int t = (int)L - nwg, x = t & 7, s = t >> 3; u.pm = 64 + 8 * x + (s & 7); u.pn = 30 + (s >> 3); return true; }
        int wgid = (int)L; { const int q = nwg / NXCD, xcd = wgid % NXCD, off = wgid / NXCD; const int rot = ((xcd >> 1) * (q >> 2)) & ~7;
            const int o2 = (off + rot) % q; wgid = xcd * q + ((xcd & 1) ? q - 1 - o2 : o2); }
        const int nig = WGM * nN, fm = (wgid / nig) * WGM; int pn = (wgid % nig) / WGM; if (chunk == 1 && pn >= 30) pn += 2;
        u.pm = fm + ((wgid % nig) % WGM); u.pn = pn; return true;
    }
    __device__ __forceinline__ void a_ready(const Unit&) const {}
    __device__ __forceinline__ void done(const Unit&) const {}
};
constexpr size_t GTX_OFF = ((size_t)(420 - 282) << 20) / 2;
struct EpiProj {
    static constexpr bool PERM = true, AFTER_DRAIN = false, INIT = false, MIDFIX = false, APERM = true;
    __device__ __forceinline__ size_t bt_off(const Unit&) const { return 0; } __device__ __forceinline__ ptrdiff_t a_off(const Unit&) const { return 0; }
    __device__ __forceinline__ int a_lgr(const Unit& u) const { return (u.pn >= 12 && u.pn < 30) ? 2 * ((u.pn - 12) / 6) : 0; }
#define P1ROW(ai, m) (u.pm * BM + (lgr ? ((((ai) * HALF + wr * 64 + (m) * 16 + fr) >> (8 - lgr)) + ((((ai) * HALF + wr * 64 + (m) * 16 + fr) & ((1 << (8 - lgr)) - 1)) << lgr)) : ((ai) * HALF + wr * 64 + (m) * 16 + fr)))
    bf16_t *QK, *VA, *DIL, *GT; const PG8_LAS float* gl; int S, lgS;
    __device__ __forceinline__ void operator()(const f32x4 (&acc)[2][2][4][2], const Unit& u, int wr, int wc, int fr_in, int fq) const {
        int fr = fr_in; asm volatile("" : "+v"(fr));
        const int pn = u.pn, lrb = (u.pm & 63) * BM + wr * 64 + fr;
        int kind, lgr = 0; bf16_t* dst; const PG8_LAS float* gain = gl;
        if (pn < 8) { const int which = pn >> 1, head = (pn & 1) * 4 + wc; kind = 0; gain = gl + (which < 2 ? 0 : 64); dst = QK + (size_t)(which * 8 + head) * ((size_t)CH * 64); }
        else if (pn < 12) { const int head = (pn - 8) * 2 + (wc >> 1); kind = 1; dst = VA + (size_t)head * ((size_t)CH * 128) + (2 * (wc & 1)) * 2048 + 8 * fq; }
        else if (pn < 30) { const int idx = pn - 12, g = idx / 6, part = (idx % 6) >> 1, head = (idx & 1) * 4 + wc; lgr = 2 * g;
            dst = DIL + (size_t)((g * 3 + part) * 8 + head) * ((size_t)CH * 64);
            if (part < 2) { kind = 0; gain = gl + (part == 0 ? 128 : 320) + 64 * g; } else { kind = 2; dst += 8 * fq; } }
        else { kind = 3; dst = GT + (u.pm >= 64 ? GTX_OFF : (size_t)0) + (size_t)((pn - 30) * 4 + wc) * 2048 + fq * 8; }
        const int Sm = S - 1, rm = (1 << lgr) - 1, lsh = lgS - lgr;
        if (kind == 0) {
            f32x4 gv[2][2];
#pragma unroll
            for (int bj = 0; bj < 2; ++bj)
#pragma unroll
                for (int n = 0; n < 2; ++n) gv[bj][n] = *(const PG8_LAS f32x4*)(gain + 32 * bj + 8 * fq + 4 * n);
#pragma unroll
            for (int ai = 0; ai < 2; ++ai)
#pragma unroll
                for (int m = 0; m < 4; ++m) {
                    const int lr = P1ROW(ai, m), t = lr & Sm, dr = P1DR((lr & ~Sm) + ((t & rm) << lsh) + (t >> lgr));
                    float ss = 0.f;
#pragma unroll
                    for (int bj = 0; bj < 2; ++bj)
#pragma unroll
                        for (int n = 0; n < 2; ++n) { const f32x4 x = acc[ai][bj][m][n]; ss += (x[0] * x[0] + x[1] * x[1]) + (x[2] * x[2] + x[3] * x[3]); }
                    ss += swz_xor<16>(ss); ss = add_x32(ss);
                    const float rs = __builtin_amdgcn_rsqf(ss * (1.0f / 64.0f) + 1e-6f);
                    bf16_t* rowp = dst + (size_t)(dr >> 6) * 4096 + fq * 512 + (dr & 63) * 8;
#pragma unroll
                    for (int bj = 0; bj < 2; ++bj) EPI_ST(u32x4, (rowp + bj * 2048), pack8(acc[ai][bj][m][0] * rs * gv[bj][0], acc[ai][bj][m][1] * rs * gv[bj][1]));
                }
        } else if (kind == 1) {
#pragma unroll
            for (int ai = 0; ai < 2; ++ai)
#pragma unroll
                for (int m = 0; m < 4; ++m) {
                    const int lr = lrb + ai * HALF + m * 16;
                    bf16_t* rowp = dst + (size_t)(lr >> 6) * 8192 + ((lr & 63) >> 4) * 512 + (lr & 15) * 32;
#pragma unroll
                    for (int bj = 0; bj < 2; ++bj) EPI_ST(u32x4, (rowp + bj * 2048), pack8(acc[ai][bj][m][0], acc[ai][bj][m][1]));
                }
        } else if (kind == 2) {
#pragma unroll
            for (int ai = 0; ai < 2; ++ai)
#pragma unroll
                for (int m = 0; m < 4; ++m) {
                    const int lr = P1ROW(ai, m), t = lr & Sm, dr = P1DR((lr & ~Sm) + ((t & rm) << lsh) + (t >> lgr));
                    const int hi8 = (fr >> 3) & 1;
                    const u32x4 w0 = pack8(acc[ai][0][m][0], acc[ai][0][m][1]), w1 = pack8(acc[ai][1][m][0], acc[ai][1][m][1]), snd = hi8 ? w0 : w1;
                    u32x4 rcv; rcv.x = (unsigned)__builtin_amdgcn_mov_dpp((int)snd.x, 0x128, 0xF, 0xF, true); rcv.y = (unsigned)__builtin_amdgcn_mov_dpp((int)snd.y, 0x128, 0xF, 0xF, true);
                    rcv.z = (unsigned)__builtin_amdgcn_mov_dpp((int)snd.z, 0x128, 0xF, 0xF, true); rcv.w = (unsigned)__builtin_amdgcn_mov_dpp((int)snd.w, 0x128, 0xF, 0xF, true);
                    bf16_t* rowp = dst + (size_t)(dr - 8 * hi8) * 64 + 32 * hi8;
                    EPI_ST(u32x4, rowp, (hi8 ? rcv : w0));
                    EPI_ST(u32x4, (rowp + 8 * 64), (hi8 ? w1 : rcv));
                }
        } else {
#pragma unroll
            for (int ai = 0; ai < 2; ++ai)
#pragma unroll
                for (int m = 0; m < 4; ++m) {
                    const int lr = lrb + ai * HALF + m * 16;
                    bf16_t* rowp = dst + (size_t)(lr >> 6) * 65536 + (lr & 63) * 32;
                    f32x4 r0, r1, s0, s1;
#pragma unroll
                    for (int i = 0; i < 4; ++i) {
                        const float ea0 = __builtin_amdgcn_exp2f(fminf(-1.4426950408889634f * acc[ai][0][m][0][i], 64.f)), ea1 = __builtin_amdgcn_exp2f(fminf(-1.4426950408889634f * acc[ai][0][m][1][i], 64.f));
                        const float eb0 = __builtin_amdgcn_exp2f(fminf(-1.4426950408889634f * acc[ai][1][m][0][i], 64.f)), eb1 = __builtin_amdgcn_exp2f(fminf(-1.4426950408889634f * acc[ai][1][m][1][i], 64.f));
                        s0[i] = __builtin_amdgcn_rcpf(1.0f + eb0); s1[i] = __builtin_amdgcn_rcpf(1.0f + eb1);
                        r0[i] = (1.0f + eb0) * __builtin_amdgcn_rcpf(1.0f + ea0); r1[i] = (1.0f + eb1) * __builtin_amdgcn_rcpf(1.0f + ea1); }
                    EPI_ST(u32x4, rowp, pack8(r0, r1));
                    EPI_ST(u32x4, (rowp + (size_t)CH * 1024), pack8(s0, s1));
                }
        }
    }
};
struct EpiBrC {
    static constexpr bool PERM = true, AFTER_DRAIN = false, INIT = false, MIDFIX = true, APERM = false;
    bf16_t* MG; const bf16_t* GR0; const bf16_t* GS0; const bf16_t* GR1; const bf16_t* GS1; ptrdiff_t aoff1; int fix_t;
    __device__ __forceinline__ size_t bt_off(const Unit&) const { return 0; }
    __device__ __forceinline__ ptrdiff_t a_off(const Unit& u) const { return u.pm >= 64 ? aoff1 : 0; }
    __device__ __forceinline__ void midfix(f32x4 (&acc)[2][2][4][2], const Unit& u, int wr, int wc, int fr_in, int fq) const {
        int fr = fr_in; asm volatile("" : "+v"(fr));
        const int row0 = (u.pm & 63) * BM + wr * 64 + fr, col0 = u.pn * BM + wc * 32 + 8 * fq; const bf16_t* GR = u.pm >= 64 ? GR1 : GR0;
        u32x4 gr[2][4][2];
#pragma unroll
        for (int ai = 0; ai < 2; ++ai)
#pragma unroll
            for (int m = 0; m < 4; ++m) { const int lr = row0 + ai * HALF + m * 16;
                const bf16_t* gp = GR + (size_t)(lr >> 6) * 65536 + (size_t)(col0 >> 5) * 2048 + (lr & 63) * 32 + ((col0 >> 3) & 3) * 8;
#pragma unroll
                for (int bj = 0; bj < 2; ++bj) gr[ai][m][bj] = *(const u32x4*)(gp + bj * (4 * 2048)); }
#pragma unroll
        for (int ai = 0; ai < 2; ++ai)
#pragma unroll
            for (int m = 0; m < 4; ++m)
#pragma unroll
                for (int bj = 0; bj < 2; ++bj) { acc[ai][bj][m][0] *= bf4lo(gr[ai][m][bj]); acc[ai][bj][m][1] *= bf4hi(gr[ai][m][bj]); }
    }
    __device__ __forceinline__ void operator()(const f32x4 (&acc)[2][2][4][2], const Unit& u, int wr, int wc, int fr, int fq) const {
        const int row0 = u.pm * BM + wr * 64 + fr, lrow0 = (u.pm & 63) * BM + wr * 64 + fr, col0 = u.pn * BM + wc * 32 + 8 * fq; const bf16_t* GS = u.pm >= 64 ? GS1 : GS0;
#pragma unroll
        for (int ai = 0; ai < 2; ++ai) {
            u32x4 gw[4][2];
#pragma unroll
            for (int m = 0; m < 4; ++m) { const int lr = lrow0 + ai * HALF + m * 16;
                const bf16_t* gp = GS + (size_t)(lr >> 6) * 65536 + (size_t)(col0 >> 5) * 2048 + (lr & 63) * 32 + ((col0 >> 3) & 3) * 8;
#pragma unroll
                for (int bj = 0; bj < 2; ++bj) gw[m][bj] = *(const u32x4*)(gp + bj * (4 * 2048)); }
#pragma unroll
            for (int m = 0; m < 4; ++m) { bf16_t* mp = MG + a_tiled(row0 + ai * HALF + m * 16, col0, 1024);
#pragma unroll
                for (int bj = 0; bj < 2; ++bj) EPI_ST(u32x4, (mp + bj * PG8_ABJ), pack8(acc[ai][bj][m][0] * bf4lo(gw[m][bj]), acc[ai][bj][m][1] * bf4hi(gw[m][bj]))); }
        }
    }
};
struct EpiWo {
    static constexpr bool PERM = true, AFTER_DRAIN = false; PG8_EPI_DEFAULTS
    const float *xp, *xs; float* out; bf16_t* A2; const float *mod, *n2g; float* rowss;
    __device__ __forceinline__ void operator()(const f32x4 (&acc)[2][2][4][2], const Unit& u, int wr, int wc, int fr, int fq) const {
        const int m0 = u.pm * BM, b = batch_of(m0), row0 = m0 + wr * 64 + fr, col0 = u.pn * BM + wc * 32 + 8 * fq;
        const float* xb = m0 < 16384 ? xp : xs - (size_t)16384 * 1024;
        const float* g1p = mod + b * 6144 + 2048 + col0; const float* s2p = mod + b * 6144 + 4096 + col0; const float* ngp = n2g + col0;
        f32x4 g1[2][2], gm[2][2];
#pragma unroll
        for (int bj = 0; bj < 2; ++bj)
#pragma unroll
            for (int n = 0; n < 2; ++n) { g1[bj][n] = *(const f32x4*)(g1p + bj * HALF + 4 * n); gm[bj][n] = *(const f32x4*)(ngp + bj * HALF + 4 * n) * (*(const f32x4*)(s2p + bj * HALF + 4 * n) + 1.0f); }
#pragma unroll
        for (int ai = 0; ai < 2; ++ai)
#pragma unroll
          for (int mh = 0; mh < 4; mh += 2) { f32x4 xv[4][2][2];
#pragma unroll
            for (int m = mh; m < mh + 2; ++m)
#pragma unroll
                for (int bj = 0; bj < 2; ++bj) { const float* p = xb + (size_t)(row0 + ai * HALF + m * 16) * 1024 + col0 + bj * HALF; xv[m][bj][0] = *(const f32x4*)p; xv[m][bj][1] = *(const f32x4*)(p + 4); }
#pragma unroll
            for (int m = mh; m < mh + 2; ++m) { const int r = row0 + ai * HALF + m * 16; const size_t off = (size_t)r * 1024 + col0; float ss = 0.f;
#pragma unroll
                for (int bj = 0; bj < 2; ++bj) {
                    const f32x4 y0 = xv[m][bj][0] + g1[bj][0] * acc[ai][bj][m][0], y1 = xv[m][bj][1] + g1[bj][1] * acc[ai][bj][m][1];
                    *(f32x4*)(out + off + bj * HALF) = y0; *(f32x4*)(out + off + bj * HALF + 4) = y1;
                    ss += (y0[0] * y0[0] + y0[1] * y0[1]) + (y0[2] * y0[2] + y0[3] * y0[3]) + (y1[0] * y1[0] + y1[1] * y1[1]) + (y1[2] * y1[2] + y1[3] * y1[3]);
                    EPI_ST(u32x4, (A2 + a_tiled(r, col0 + bj * HALF, 1024)), pack8(y0 * gm[bj][0], y1 * gm[bj][1])); }
                ss += swz_xor<16>(ss); ss = add_x32(ss);
                if (fq == 0) atomicAdd(rowss + r, ss); } }
    }
};
struct EpiUp {
    static constexpr bool PERM = true, AFTER_DRAIN = false; PG8_EPI_DEFAULTS
    bf16_t* H; const float *rowss, *sbias;
    __device__ __forceinline__ static u32x4 swap1(const u32x4& v) {
        u32x4 r; r.x = (unsigned)__builtin_amdgcn_mov_dpp((int)v.x, 0xB1, 0xF, 0xF, true); r.y = (unsigned)__builtin_amdgcn_mov_dpp((int)v.y, 0xB1, 0xF, 0xF, true);
        r.z = (unsigned)__builtin_amdgcn_mov_dpp((int)v.z, 0xB1, 0xF, 0xF, true); r.w = (unsigned)__builtin_amdgcn_mov_dpp((int)v.w, 0xB1, 0xF, 0xF, true); return r; }
    __device__ __forceinline__ void operator()(const f32x4 (&acc)[2][2][4][2], const Unit& u, int wr, int wc, int fr, int fq) const {
        const int m0 = u.pm * BM, b = batch_of(m0), row0 = m0 + wr * 64 + fr, col0 = u.pn * BM + wc * 64 + 8 * fq, odd = fr & 1;
        f32x4 sb[2][2];
#pragma unroll
        for (int bj = 0; bj < 2; ++bj)
#pragma unroll
            for (int n = 0; n < 2; ++n) sb[bj][n] = *(const f32x4*)(sbias + b * 4096 + col0 + bj * 32 + 4 * n);
        float rsv[2][4];
#pragma unroll
        for (int ai = 0; ai < 2; ++ai)
#pragma unroll
            for (int m = 0; m < 4; ++m) rsv[ai][m] = rowss[row0 + ai * HALF + m * 16];
#pragma unroll
        for (int ai = 0; ai < 2; ++ai)
#pragma unroll
            for (int m = 0; m < 4; ++m) { const int r = row0 + ai * HALF + m * 16; const float rs = __builtin_amdgcn_rsqf(rsv[ai][m] * (1.0f / 1024.0f) + 1e-6f);
                u32x4 w[2];
#pragma unroll
                for (int bj = 0; bj < 2; ++bj) { f32x4 v0 = acc[ai][bj][m][0] * rs + sb[bj][0], v1 = acc[ai][bj][m][1] * rs + sb[bj][1];
#pragma unroll
                    for (int i = 0; i < 4; ++i) { v0[i] = fmaxf(v0[i], 0.f); v1[i] = fmaxf(v1[i], 0.f); }
                    w[bj] = pack8(v0 * v0, v1 * v1); }
                const u32x4 snd = odd ? w[0] : w[1], rcv = swap1(snd);
                bf16_t* rowp = H + (size_t)(r - odd) * LDH + col0 + 32 * odd;
                EPI_ST(u32x4, rowp, (odd ? rcv : w[0]));
                EPI_ST(u32x4, (rowp + LDH), (odd ? w[1] : rcv)); }
    }
};
struct EpiDown {
    static constexpr bool PERM = false, AFTER_DRAIN = false; PG8_EPI_DEFAULTS
    float* out; const float* mod;
    __device__ __forceinline__ void operator()(const f32x4 (&acc)[2][2][4][2], const Unit& u, int wr, int wc, int fr, int fq) const {
        const int m0 = u.pm * BM, b = batch_of(m0), row0 = m0 + wr * 64 + fr, col0 = u.pn * BM + wc * 32 + 4 * fq;
        const float* g2p = mod + b * 6144 + 5120 + col0;
        f32x4 g2[2][2];
#pragma unroll
        for (int bj = 0; bj < 2; ++bj)
#pragma unroll
            for (int n = 0; n < 2; ++n) g2[bj][n] = *(const f32x4*)(g2p + bj * HALF + 16 * n);
#pragma unroll
        for (int ai = 0; ai < 2; ++ai) { f32x4 ov[4][2][2];
#pragma unroll
            for (int m = 0; m < 4; ++m)
#pragma unroll
                for (int bj = 0; bj < 2; ++bj) { const float* p = out + (size_t)(row0 + ai * HALF + m * 16) * 1024 + col0 + bj * HALF; ov[m][bj][0] = *(const f32x4*)p; ov[m][bj][1] = *(const f32x4*)(p + 16); }
#pragma unroll
            for (int m = 0; m < 4; ++m) { float* rowp = out + (size_t)(row0 + ai * HALF + m * 16) * 1024 + col0;
#pragma unroll
                for (int bj = 0; bj < 2; ++bj) { *(f32x4*)(rowp + bj * HALF) = ov[m][bj][0] + g2[bj][0] * acc[ai][bj][m][0]; *(f32x4*)(rowp + bj * HALF + 16) = ov[m][bj][1] + g2[bj][1] * acc[ai][bj][m][1]; } } }
    }
};
}
namespace att {
#define LASC __attribute__((address_space(3)))
typedef unsigned short bf16;
typedef short bf16x8 __attribute__((ext_vector_type(8)));
typedef short s16x4 __attribute__((ext_vector_type(4)));
typedef short v4i16_t __attribute__((ext_vector_type(4)));
typedef float f32x16 __attribute__((ext_vector_type(16)));
typedef float f32x4 __attribute__((ext_vector_type(4)));
typedef unsigned u32x4 __attribute__((ext_vector_type(4)));
typedef float f32x2_t __attribute__((ext_vector_type(2))); typedef __bf16 bf16x2_t __attribute__((ext_vector_type(2)));
constexpr int CH = 16384;
constexpr float LOG2E = 1.4426950408889634f;
__device__ __forceinline__ int crow(int r, int hi) { return (r & 3) + 8 * (r >> 2) + 4 * hi; }
__device__ __forceinline__ unsigned cvtpk(float lo, float hi) { f32x2_t v = {lo, hi}; bf16x2_t b = __builtin_convertvector(v, bf16x2_t); return __builtin_bit_cast(unsigned, b); }
__device__ __forceinline__ s16x4 vtr(const LASC unsigned char* p) { return __builtin_bit_cast(s16x4, __builtin_amdgcn_ds_read_tr16_b64_v4i16((LASC v4i16_t*)p)); }
#ifndef BK_SH
#define BK_SH 0
#endif
__device__ __forceinline__ int rel_bucket(int rel) {
    const int n = rel < 0 ? -rel : rel; const int ret = rel > 0 ? 16 : 0;
    int v;
    if (n < 8) v = n; else if (n < 12) v = 8; else if (n < 16 + BK_SH) v = 9; else if (n < 23) v = 10; else if (n < 32 + BK_SH) v = 11; else if (n < 46) v = 12; else if (n < 64 + BK_SH) v = 13; else if (n < 91) v = 14; else v = 15;
    return ret + v;
}
__device__ __forceinline__ bf16x8 pack_frag(const f32x16& p, int base) {
    u32x4 w; w.x = cvtpk(p[base], p[base + 1]); w.y = cvtpk(p[base + 2], p[base + 3]); w.z = cvtpk(p[base + 4], p[base + 5]); w.w = cvtpk(p[base + 6], p[base + 7]);
    return __builtin_bit_cast(bf16x8, w);
}
constexpr int DA_K = 0, DA_V = 32768;
constexpr int DA_Q = 81920;
constexpr int DA_BT = 147456;
constexpr int DA_WS = 149504;
constexpr int SC_OFF = 155648;
constexpr int DL_VS = 136192;
constexpr int DL_N = 0, DL_D = 131072, DL_T = 131072 + 2048;

__device__ __forceinline__ void da_epilogue(LASC unsigned char* lds, bf16* YA, const float* subln_g, f32x16 (&o1)[4], f32x16 (&o2)[4], float l1, float l2, float lam, int head, int tile0, int qb, int wid);
#define SBAR() __builtin_amdgcn_sched_barrier(0)
__device__ __forceinline__ int lane_now() { int l; asm volatile("v_mbcnt_lo_u32_b32 %0, -1, 0\n\tv_mbcnt_hi_u32_b32 %0, -1, %0" : "=v"(l)); return l; }
__device__ __forceinline__ void da_unit(LASC unsigned char* lds, const bf16* QK, const bf16* VA, bf16* YA, const float* rel_bias, const float* subln_g,
                                        int head, int tile0, int NT, int qb, int tid_in, float* tprobe = nullptr) {
    int tid = tid_in; asm volatile("" : "+v"(tid));
    const int lane = tid & 63, r32 = lane & 31, hi = lane >> 5; const int wid = __builtin_amdgcn_readfirstlane(tid >> 6);
    LASC float* BT = (LASC float*)(lds + DA_BT); const LASC float* SC = (const LASC float*)(lds + SC_OFF);
    const float lam = __builtin_bit_cast(float, __builtin_amdgcn_readfirstlane(__builtin_bit_cast(int, SC[0])));
    if (tid < 448) { const int rel = tid - 224; BT[tid] = rel_bias[rel_bucket(rel) * 32 + head] * LOG2E; }
    const bf16* Q1h = QK + (size_t)(0 * 8 + head) * ((size_t)CH * 64); const bf16* Q2h = QK + (size_t)(1 * 8 + head) * ((size_t)CH * 64);
    const bf16* K1h = QK + (size_t)(2 * 8 + head) * ((size_t)CH * 64) + (size_t)tile0 * 4096; const bf16* K2h = QK + (size_t)(3 * 8 + head) * ((size_t)CH * 64) + (size_t)tile0 * 4096;
    const bf16* Vh = VA + (size_t)head * ((size_t)CH * 128) + (size_t)tile0 * 8192;
#define DA_GLDS(SRC, DST) do { unsigned keep_; const unsigned dst_ = (unsigned)__builtin_amdgcn_readfirstlane((int)(unsigned)(uintptr_t)(DST)); \
        asm volatile("s_mov_b32 %0, m0\n\ts_mov_b32 m0, %2\n\ts_nop 0\n\tglobal_load_lds_dwordx4 %1, off\n\ts_mov_b32 m0, %0" : "=&s"(keep_) : "v"(SRC), "s"(dst_) : "memory"); } while (0)
#define DA_DMA1(t, pc) do { LASC unsigned char* dk_ = lds + DA_K + ((t) & 1) * 16384 + (pc) * 1024; LASC unsigned char* dv_ = lds + DA_V + ((t) % 3) * 16384 + (pc) * 1024; \
        const char* k1_ = (const char*)K1h + (size_t)(t) * 8192 + (pc) * 1024; const char* k2_ = (const char*)K2h + (size_t)(t) * 8192 + (pc) * 1024; const char* v_ = (const char*)Vh + (size_t)(t) * 16384 + (pc) * 1024;     \
        DA_GLDS(k1_ + lo_, dk_); DA_GLDS(k2_ + lo_, dk_ + 8192); DA_GLDS(v_ + lo_, dv_); DA_GLDS(v_ + 8192 + lo_, dv_ + 8192); } while (0)
#ifndef DA_DMA_ALL
#define DA_DMA(t) do { if (wid < 4) { const unsigned lo_ = (unsigned)lane_now() * 16u; DA_DMA1(t, wid); DA_DMA1(t, wid + 4); } } while (0)
#else
#define DA_DMA(t) do { const unsigned lo_ = (unsigned)lane_now() * 16u; DA_DMA1(t, wid); } while (0)
#endif
    DA_DMA(0);
    bf16x8 q1f[4], q2f[4];
    { const int tq = tile0 + 4 * qb + (wid >> 1), rq = (wid & 1) * 32 + r32;
#pragma unroll
      for (int ks = 0; ks < 4; ++ks) { q1f[ks] = *(const bf16x8*)(Q1h + (size_t)tq * 4096 + (2 * ks + hi) * 512 + rq * 8); q2f[ks] = *(const bf16x8*)(Q2h + (size_t)tq * 4096 + (2 * ks + hi) * 512 + rq * 8); } }
#pragma unroll
    for (int ks = 0; ks < 4; ++ks) asm volatile("" : "+v"(q1f[ks]), "+v"(q2f[ks]));
    f32x16 o1[4], o2[4];
#pragma unroll
    for (int d = 0; d < 4; ++d) { o1[d] = f32x16{}; o2[d] = f32x16{}; }
    float l1 = 0.f, l2 = 0.f;
    asm volatile("s_waitcnt vmcnt(0)" ::: "memory");
    __syncthreads();
    const int qw0 = 256 * qb + 32 * wid;
    const int tL = (qw0 >= 191) ? ((qw0 - 191) >> 6) : -1, tR = (qw0 + 159 + 63) >> 6;
    const float fLN = __builtin_bit_cast(float, __builtin_amdgcn_readfirstlane(__builtin_bit_cast(int, __builtin_amdgcn_exp2f(BT[0])))), fNR = __builtin_bit_cast(float, __builtin_amdgcn_readfirstlane(__builtin_bit_cast(int, __builtin_amdgcn_exp2f(-BT[447]))));
    bf16x8 paA1[2], paA2[2], paB1[2], paB2[2];
#pragma unroll
    for (int i = 0; i < 2; ++i) { paB1[i] = bf16x8{}; paB2[i] = bf16x8{}; }
#define DA_NEARC(S_, HALF_) do { const int lnn_ = lane_now(); const LASC float* bt_ = BT + (64 * t + 32 * (HALF_) - (qw0 + (lnn_ & 31)) + 4 * (lnn_ >> 5) + 224); \
        { unsigned bti_ = (unsigned)(uintptr_t)bt_; asm volatile("" : "+v"(bti_)); bt_ = (const LASC float*)(uintptr_t)bti_; }     \
        _Pragma("unroll") for (int r = 0; r < 16; ++r) S_[r] = bt_[(r & 3) + 8 * (r >> 2)]; } while (0)
#define DA_VRD(DST, F_) do { const s16x4 lo_ = vtr(vp + ((F_) >> 1) * 4096 + ((F_) & 1) * 1024), hh_ = vtr(vp + ((F_) >> 1) * 4096 + ((F_) & 1) * 1024 + 512); DST = (bf16x8){lo_[0], lo_[1], lo_[2], lo_[3], hh_[0], hh_[1], hh_[2], hh_[3]}; } while (0)
#ifdef DA_XMFMA
#define DA_XM() do { f32x16 sx_ = __builtin_amdgcn_mfma_f32_32x32x16_bf16(kfB[0], qfB[0], (f32x16){}, 0, 0, 0); _Pragma("unroll") for (int xk = 1; xk < DA_XMFMA; ++xk) sx_ = __builtin_amdgcn_mfma_f32_32x32x16_bf16(kfB[xk & 3], qfB[xk & 3], sx_, 0, 0, 0); asm volatile("" :: "v"(sx_)); } while (0)
#else
#define DA_XM() do {} while (0)
#endif
#ifdef DA_XVALU
#define DA_XV(g) do { float x0_ = __builtin_amdgcn_exp2f(s2[(g)] * 0.5f), x1_ = __builtin_amdgcn_exp2f(s2[(g)] * 0.25f); asm volatile("" :: "v"(x0_), "v"(x1_)); } while (0)
#else
#define DA_XV(g) do {} while (0)
#endif
#define DA_STEP(KS, HALF, VP, PI1, PI2, PO1, PO2) do { \
        f32x16 s1, s2; const LASC unsigned char* vp; const LASC unsigned char* kb; \
        { kb = (KS) + klane_ + (HALF) * 512; vp = (VP) + vlane_; \
          { unsigned vpi_ = (unsigned)(uintptr_t)vp; asm volatile("" : "+v"(vpi_)); vp = (const LASC unsigned char*)(uintptr_t)vpi_; } }     \
        { bf16x8 kf[4]; \
          _Pragma("unroll") for (int ks = 0; ks < 4; ++ks) kf[ks] = *(const LASC bf16x8*)(kb + ks * 2048); \
          if (near) { DA_NEARC(s1, HALF); s1 = __builtin_amdgcn_mfma_f32_32x32x16_bf16(kf[0], q1f[0], s1, 0, 0, 0); } \
          else s1 = __builtin_amdgcn_mfma_f32_32x32x16_bf16(kf[0], q1f[0], (f32x16){}, 0, 0, 0); \
          _Pragma("unroll") for (int ks = 1; ks < 4; ++ks) s1 = __builtin_amdgcn_mfma_f32_32x32x16_bf16(kf[ks], q1f[ks], s1, 0, 0, 0); \
          SBAR(); \
          _Pragma("unroll") for (int ks = 0; ks < 4; ++ks) kf[ks] = *(const LASC bf16x8*)(kb + 8192 + ks * 2048); \
          DA_VRD(vf[0], 0); \
          if (near) { DA_NEARC(s2, HALF); s2 = __builtin_amdgcn_mfma_f32_32x32x16_bf16(kf[0], q2f[0], s2, 0, 0, 0); } \
          else s2 = __builtin_amdgcn_mfma_f32_32x32x16_bf16(kf[0], q2f[0], (f32x16){}, 0, 0, 0); \
          _Pragma("unroll") for (int ks = 1; ks < 4; ++ks) s2 = __builtin_amdgcn_mfma_f32_32x32x16_bf16(kf[ks], q2f[ks], s2, 0, 0, 0); DA_XM(); } \
        SBAR(); \
        { float sa = 0.f, sb = 0.f; u32x4 w1a, w1b, w2a, w2b; float pe0 = 0.f, pe1 = 0.f; \
            \
            \
          _Pragma("unroll") for (int g = 0; g < 16; ++g) { const int f = g >> 1, d0 = f >> 1, ks = f & 1, sm = g & 1; \
              if (sm == 0) { if (f + 1 < 8) DA_VRD(vf[(f + 1) & 1], f + 1); o1[d0] = __builtin_amdgcn_mfma_f32_32x32x16_bf16(PI1[ks], vf[f & 1], o1[d0], 0, 0, 0); } \
              else o2[d0] = __builtin_amdgcn_mfma_f32_32x32x16_bf16(PI2[ks], vf[f & 1], o2[d0], 0, 0, 0); \
              DA_XV(g); \
              const float e0 = __builtin_amdgcn_exp2f(g < 8 ? s1[2 * (g & 7)] : s2[2 * (g & 7)]), e1 = __builtin_amdgcn_exp2f(g < 8 ? s1[2 * (g & 7) + 1] : s2[2 * (g & 7) + 1]); \
              if (g > 0) { const int h = g - 1; unsigned w = cvtpk(pe0, pe1); \
                  if (h < 8) { sa += pe0; sa += pe1; asm volatile("" : "+v"(w), "+v"(sa)); if (h < 4) w1a[h & 3] = w; else w1b[h & 3] = w; } \
                  else { sb += pe0; sb += pe1; asm volatile("" : "+v"(w), "+v"(sb)); if (h < 12) w2a[h & 3] = w; else w2b[h & 3] = w; } } \
              pe0 = e0; pe1 = e1; asm volatile("" : "+v"(pe0), "+v"(pe1)); \
              SBAR(); } \
          { unsigned w = cvtpk(pe0, pe1); sb += pe0; sb += pe1; w2b[3] = w; } \
          l1 += sa; l2 += sb; \
          PO1[0] = __builtin_bit_cast(bf16x8, w1a); PO1[1] = __builtin_bit_cast(bf16x8, w1b); PO2[0] = __builtin_bit_cast(bf16x8, w2a); PO2[1] = __builtin_bit_cast(bf16x8, w2b); } \
    } while (0)
    bf16x8 vf[2];
    unsigned klane_ = (unsigned)(hi * 1024 + r32 * 16), vlane_ = (unsigned)(((lane >> 4) & 1) * 32 + (lane & 3) * 8 + (4 * hi + ((lane & 15) >> 2)) * 64);
    asm volatile("" : "+v"(klane_), "+v"(vlane_));
#ifdef TMODE
    const unsigned long long tm0_ = __builtin_amdgcn_s_memtime(), tr0_ = __builtin_amdgcn_s_memrealtime();
#endif
#ifdef DA_PRIO
    if (wid >= 4) __builtin_amdgcn_s_setprio(DA_PRIO);
#endif
    for (int t = 0; t < NT; ++t) {
        if (t + 1 < NT) DA_DMA(t + 1);
        const bool near = (t > tL) && (t < tR);
        const bool trans = (t == tL + 1 && tL >= 0) || (t == tR);
        const float f = (t == tR) ? fNR : fLN;
        const LASC unsigned char* ks_ = lds + DA_K + (t & 1) * 16384;
        const int tp = t > 0 ? t - 1 : 0;
        const LASC unsigned char* vprev = lds + DA_V + (tp % 3) * 16384 + (t > 0 ? 2048 : 0);
        const LASC unsigned char* vcur = lds + DA_V + (t % 3) * 16384;
        if (trans) { l1 *= f; l2 *= f; }
        DA_STEP(ks_, 0, vprev, paB1, paB2, paA1, paA2);
        if (trans) {
#pragma unroll
            for (int d = 0; d < 4; ++d) { o1[d] *= f; o2[d] *= f; } }
#ifdef DA_XBAR
        __syncthreads();
#endif
        DA_STEP(ks_, 1, vcur, paA1, paA2, paB1, paB2);
        asm volatile("s_waitcnt vmcnt(0)" ::: "memory");
        __syncthreads();
    }
    { const int ln_ = lane_now(); const LASC unsigned char* vp = lds + DA_V + ((NT - 1) % 3) * 16384 + 2048 + ((ln_ >> 4) & 1) * 32 + (ln_ & 3) * 8 + (4 * (ln_ >> 5) + ((ln_ & 15) >> 2)) * 64;
#pragma unroll
      for (int d0 = 0; d0 < 4; ++d0)
#pragma unroll
          for (int ks = 0; ks < 2; ++ks) { const s16x4 lo = vtr(vp + d0 * 4096 + ks * 1024), hh = vtr(vp + d0 * 4096 + ks * 1024 + 512); const bf16x8 vf = (bf16x8){lo[0], lo[1], lo[2], lo[3], hh[0], hh[1], hh[2], hh[3]};
              o1[d0] = __builtin_amdgcn_mfma_f32_32x32x16_bf16(paB1[ks], vf, o1[d0], 0, 0, 0); o2[d0] = __builtin_amdgcn_mfma_f32_32x32x16_bf16(paB2[ks], vf, o2[d0], 0, 0, 0); } }
#ifdef DA_PRIO
    __builtin_amdgcn_s_setprio(0);
#endif
#ifdef TMODE
    { const unsigned long long tm1_ = __builtin_amdgcn_s_memtime(), tr1_ = __builtin_amdgcn_s_memrealtime(); if (tprobe && tid == 0) { tprobe[0] = (float)(tm1_ - tm0_) / (float)NT; tprobe[1] = (float)(tr1_ - tr0_) * 10.0f / (float)NT; } }
#endif
    __syncthreads();
#undef DA_DMA
#undef DA_DMA1
#undef DA_GLDS
#undef DA_STEP
#undef DA_NEARC
#undef DA_VRD
    da_epilogue(lds, YA, subln_g, o1, o2, l1, l2, lam, head, tile0, qb, wid);
}
__device__ __forceinline__ void da_epilogue(LASC unsigned char* lds, bf16* YA, const float* subln_g, f32x16 (&o1)[4], f32x16 (&o2)[4], float l1, float l2, float lam, int head, int tile0, int qb, int wid) {
    const int lane = lane_now(), r32 = lane & 31, hi = lane >> 5;
    LASC float* wsf = (LASC float*)(lds + DA_WS) + wid * 128;
    l1 = add_x32(l1); l2 = add_x32(l2);
    if (hi == 0) { wsf[r32] = l1; wsf[32 + r32] = l2; }
    asm volatile("s_waitcnt lgkmcnt(0)" ::: "memory");
    float sg[4];
#pragma unroll
    for (int d0 = 0; d0 < 4; ++d0) sg[d0] = subln_g[32 * d0 + r32] * 0.8f;
    LASC bf16* stg = (LASC bf16*)(lds + wid * 8192);
#pragma unroll
    for (int r = 0; r < 16; ++r) {
        const int row = crow(r, hi); const float i1 = __builtin_amdgcn_rcpf(wsf[row]), i2 = lam * __builtin_amdgcn_rcpf(wsf[32 + row]);
        float v[4]; float ss = 0.f;
#pragma unroll
        for (int d0 = 0; d0 < 4; ++d0) { v[d0] = o1[d0][r] * i1 - o2[d0][r] * i2; ss += v[d0] * v[d0]; }
        ss += swz_xor<1>(ss); ss += swz_xor<2>(ss); ss += swz_xor<4>(ss); ss += swz_xor<8>(ss); ss += swz_xor<16>(ss);
        const float rs = __builtin_amdgcn_rsqf(ss * (1.0f / 128.0f) + 1e-6f);
#pragma unroll
        for (int d0 = 0; d0 < 4; ++d0) stg[row * 128 + d0 * 32 + r32] = (bf16)(cvtpk(v[d0] * rs * sg[d0], 0.f) & 0xffffu);
    }
    asm volatile("s_waitcnt lgkmcnt(0)" ::: "memory");
    { bf16* Yw = YA + (size_t)((tile0 + 4 * qb) * 64 + wid * 32) * 1536 + head * 128;
#pragma unroll
      for (int i = 0; i < 8; ++i) { const int row = i * 4 + (lane >> 4), ch = lane & 15; const u32x4 v = *(const LASC u32x4*)(stg + row * 128 + ch * 8); *(u32x4*)(Yw + (size_t)row * 1536 + ch * 8) = v; } }
    __syncthreads();
}

template <bool PRE, bool ACC> __device__ __forceinline__ void dil_task(const bf16* Qh, const bf16* Kh, const bf16* Vh, int drq0, int lq0, int L, int r, int tok_base, const LASC float* DBT, LASC float* Nsum, LASC float* Dsum, LASC unsigned char* vst, int lane) {
    const int r32 = lane & 31, hi = lane >> 5;
    bf16x8 qf[4];
#pragma unroll
    for (int ks = 0; ks < 4; ++ks) qf[ks] = *(const bf16x8*)(Qh + (size_t)(drq0 >> 6) * 4096 + (2 * ks + hi) * 512 + ((drq0 & 63) + r32) * 8);
    f32x16 o[2]; o[0] = f32x16{}; o[1] = f32x16{}; float l = 0.f;
    const int vrow = lane >> 3, vch = lane & 7;
    LASC unsigned char* vw = vst + (vch >> 2) * 1024 + vrow * 64 + (vch & 3) * 16;
    const LASC unsigned char* vr = vst + ((lane >> 4) & 1) * 32 + (lane & 3) * 8 + (4 * hi + ((lane & 15) >> 2)) * 64;
    bf16x8 kc[4], kn[4]; u32x4 vc[4], vn[4];
#define DIL_LOAD(KD, VD, S5) do { const int lk_ = lq0 - 64 + 32 * (S5); const int lc_ = min(max(lk_, 0), L - 32); const int dk_ = drq0 + (lc_ - lq0); \
        _Pragma("unroll") for (int ks = 0; ks < 4; ++ks) KD[ks] = *(const bf16x8*)(Kh + (size_t)(dk_ >> 6) * 4096 + (2 * ks + hi) * 512 + ((dk_ & 63) + r32) * 8); \
        const bf16* vg_ = Vh + (size_t)(dk_ + vrow) * 64 + vch * 8; \
        _Pragma("unroll") for (int i = 0; i < 4; ++i) VD[i] = *(const u32x4*)(vg_ + i * 8 * 64); } while (0)
    DIL_LOAD(kc, vc, 0);
#pragma unroll
    for (int s5 = 0; s5 < 5; ++s5) {
        if (s5 + 1 < 5) DIL_LOAD(kn, vn, s5 + 1);
        const int lk0 = lq0 - 64 + 32 * s5;
        if (lk0 >= 0 && lk0 < L) {
            const int jb = lk0 - lq0 - r32 + 4 * hi + 96;
            f32x16 p;
#pragma unroll
            for (int rg = 0; rg < 16; ++rg) p[rg] = DBT[jb + (rg & 3) + 8 * (rg >> 2)];
#pragma unroll
            for (int ks = 0; ks < 4; ++ks) p = __builtin_amdgcn_mfma_f32_32x32x16_bf16(kc[ks], qf[ks], p, 0, 0, 0);
            float s = 0.f;
#pragma unroll
            for (int rg = 0; rg < 16; ++rg) { p[rg] = __builtin_amdgcn_exp2f(p[rg]); s += p[rg]; }
            l += s;
            const bf16x8 pa0 = pack_frag(p, 0), pa1 = pack_frag(p, 8);
#pragma unroll
            for (int ss = 0; ss < 2; ++ss) {
                *(LASC u32x4*)(vw) = vc[2 * ss]; *(LASC u32x4*)(vw + 512) = vc[2 * ss + 1];
#pragma unroll
                for (int db = 0; db < 2; ++db) { const s16x4 lo = vtr(vr + db * 1024), hh = vtr(vr + db * 1024 + 512); const bf16x8 vf = (bf16x8){lo[0], lo[1], lo[2], lo[3], hh[0], hh[1], hh[2], hh[3]};
                    o[db] = __builtin_amdgcn_mfma_f32_32x32x16_bf16(ss == 0 ? pa0 : pa1, vf, o[db], 0, 0, 0); }
            }
        }
        if (s5 + 1 < 5) {
#pragma unroll
            for (int i = 0; i < 4; ++i) { kc[i] = kn[i]; vc[i] = vn[i]; } }
    }
#undef DIL_LOAD
    l = add_x32(l);
    if (hi == 0) { LASC float* dp = Dsum + tok_base + r32 * r; *dp = ACC ? *dp + l : l; }
#pragma unroll
    for (int db = 0; db < 2; ++db)
#pragma unroll
        for (int rg = 0; rg < 16; ++rg) { LASC float* np = Nsum + (tok_base + crow(rg, hi) * r) * 64 + 32 * db + r32; *np = ACC ? *np + o[db][rg] : o[db][rg]; }
}
template <bool PRE> __device__ __forceinline__ void dil_unit(LASC unsigned char* lds, const bf16* DIL, bf16* YB, const float* rel_bias, int head, int span, int S, int lgS, int tid_in) {
    int tid = tid_in; asm volatile("" : "+v"(tid));
    const int lane = tid & 63; const int wid = __builtin_amdgcn_readfirstlane(tid >> 6);
    LASC float* Nsum = (LASC float*)(lds + DL_N); LASC float* Dsum = (LASC float*)(lds + DL_D); LASC float* DBT = (LASC float*)(lds + DL_T); const LASC float* SC = (const LASC float*)(lds + SC_OFF);
    const float M2 = SC[2];
#ifdef DIL_DELAY
    for (int dd_ = 0; dd_ < DIL_DELAY; ++dd_) __builtin_amdgcn_s_sleep(127);
#endif
    for (int i = tid; i < 600; i += 512) { const int g = i / 200, j = i % 200 - 96; const int aj = j < 0 ? -j : j;
        DBT[i] = (aj <= 64) ? rel_bias[rel_bucket(j * (1 << (2 * g))) * 32 + 8 + 8 * g + head] * LOG2E - M2 : -1e30f; }
    __syncthreads();
    const int row0 = span * 512, seqbase = row0 & ~(S - 1), t0 = row0 & (S - 1);
#pragma unroll
    for (int g = 0; g < 3; ++g) {
        const int lgr = 2 * g, r = 1 << lgr, L = S >> lgr, nblk = 16 >> lgr;
        const bf16* Qh = DIL + (size_t)((g * 3 + 0) * 8 + head) * ((size_t)CH * 64); const bf16* Kh = DIL + (size_t)((g * 3 + 1) * 8 + head) * ((size_t)CH * 64); const bf16* Vh = DIL + (size_t)((g * 3 + 2) * 8 + head) * ((size_t)CH * 64);
        for (int j = wid; j < 16; j += 8) { const int cl = j / nblk, blk = j % nblk, lq0 = (t0 >> lgr) + 32 * blk;
            if (g == 0) dil_task<PRE, false>(Qh, Kh, Vh, seqbase + cl * L + lq0, lq0, L, r, lq0 * r + cl - t0, DBT + 200 * g, Nsum, Dsum, lds + DL_VS + wid * 2048, lane);
            else dil_task<PRE, true>(Qh, Kh, Vh, seqbase + cl * L + lq0, lq0, L, r, lq0 * r + cl - t0, DBT + 200 * g, Nsum, Dsum, lds + DL_VS + wid * 2048, lane); }
        if (g < 2) __syncthreads();
    }
    __syncthreads();
#pragma unroll
    for (int i = 0; i < 8; ++i) { const int row = (tid >> 3) + 64 * i, dc = tid & 7; const float inv = 1.0f / Dsum[row];
        const f32x4 a = *(const LASC f32x4*)(Nsum + row * 64 + dc * 8), b = *(const LASC f32x4*)(Nsum + row * 64 + dc * 8 + 4);
        u32x4 w; w.x = cvtpk(a[0] * inv, a[1] * inv); w.y = cvtpk(a[2] * inv, a[3] * inv); w.z = cvtpk(b[0] * inv, b[1] * inv); w.w = cvtpk(b[2] * inv, b[3] * inv);
        *(u32x4*)(YB + (size_t)(row0 + row) * 1536 + 1024 + head * 64 + dc * 8) = w; }
    __syncthreads();
}
}
#define LAS __attribute__((address_space(3)))
typedef unsigned short bf16;
typedef unsigned v4u __attribute__((ext_vector_type(4)));
typedef float f32x4 __attribute__((ext_vector_type(4)));
constexpr int NWAVES = 8, LDS_BYTES = 163840, BST_OFF = 163840 - 64;
constexpr int TOK = 32768, DM = 1024, CH = 16384, FF = 4096, NIN = 9728;
constexpr size_t MiB = 1u << 20;
constexpr size_t WS_MOD = 1 * MiB, WS_SBIAS = WS_MOD + 160 * 1024, WS_ROWSS = WS_MOD + 320 * 1024;
constexpr size_t WS_WIN = 2 * MiB, WS_WBA = 21 * MiB, WS_WBB = 23 * MiB, WS_WO = 24 * MiB, WS_WUP = 26 * MiB, WS_WDN = 410 * MiB;
constexpr size_t WS_QK = 42 * MiB, WS_VA = 106 * MiB, WS_DIL = 138 * MiB, WS_GT = 282 * MiB, WS_MG = 346 * MiB, WS_GT1 = 420 * MiB, WS_END = 484 * MiB;
constexpr size_t WS_A2 = 42 * MiB, WS_H = 106 * MiB;
constexpr size_t DO_XN = 0, DO_YA = 64 * MiB, DO_YB = 64 * MiB;
#define LDS_WAIT() asm volatile("s_waitcnt lgkmcnt(0)" ::: "memory")
#define XB_TMO      128
#define XB_XCNT(j)  (256  + 64 * (j))
#define XB_XSUB(j)  (1280 + 64 * (j))
#define XB_XGEN(j)  (2304 + 64 * (j))
#define XB_TOP      3328
#define XB_TOPGEN   3392
#define XCD_BAR_WORDS 3456
#define XB_SPIN_CAP (1u << 18)

__device__ __forceinline__ unsigned xb_ld(unsigned* p)              { return __hip_atomic_load(p, __ATOMIC_RELAXED, __HIP_MEMORY_SCOPE_AGENT); }
__device__ __forceinline__ unsigned xb_add(unsigned* p, unsigned v) { return __hip_atomic_fetch_add(p, v, __ATOMIC_RELAXED, __HIP_MEMORY_SCOPE_AGENT); }
__device__ __forceinline__ unsigned xb_xcc_id() { return (unsigned)__builtin_amdgcn_s_getreg((3 << 11) | 20) & 0xFu; }
#define XB_SPIN(cond, bar) do { unsigned _sp = 0; while (cond) { __builtin_amdgcn_s_sleep(1); \
    if ((++_sp & 255u) == 0u) { if (xb_ld(&(bar)[XB_TMO])) break; if (_sp > XB_SPIN_CAP) { atomicAdd(&(bar)[XB_TMO], 1u); break; } } } } while (0)

struct XcdBarrier {
    unsigned* bar; unsigned x;
    volatile LAS unsigned* st;
};

__device__ __forceinline__ XcdBarrier xcd_barrier_post(unsigned* bar, volatile LAS unsigned* st) {
    XcdBarrier b; b.bar = bar; b.x = xb_xcc_id(); b.st = st;
    if (threadIdx.x == 0) (void)xb_add(&bar[XB_XCNT(b.x)], 1u);
    return b;
}
__device__ __forceinline__ void xcd_barrier_complete(unsigned* bar, unsigned x, unsigned& nloc, unsigned& nx) {
    const unsigned G = gridDim.x * gridDim.y * gridDim.z;
    unsigned sum, cnt, mine, sp = 0u;
    for (;;) {
        sum = 0u; cnt = 0u; mine = 0u;
#pragma unroll
        for (unsigned j = 0; j < 16; ++j) { const unsigned c = xb_ld(&bar[XB_XCNT(j)]); sum += c; cnt += (c > 0u) ? 1u : 0u; mine = (j == x) ? c : mine; }
        if (sum == G) break;
        __builtin_amdgcn_s_sleep(1);
        if ((++sp & 255u) == 0u) { if (xb_ld(&bar[XB_TMO])) break; if (sp > XB_SPIN_CAP) { atomicAdd(&bar[XB_TMO], 1u); break; } }
    }
    nloc = mine > 0u ? mine : 1u; nx = cnt > 0u ? cnt : 1u;
}

__device__ __forceinline__ void xcd_barrier(const XcdBarrier& b) {
    asm volatile("s_waitcnt vmcnt(0)" ::: "memory");
    __syncthreads();
    if (threadIdx.x == 0) {
        unsigned* bar = b.bar;
        __builtin_amdgcn_s_waitcnt(0);
        unsigned nloc = b.st[0], nx = b.st[1];
        if (nloc == 0u) { xcd_barrier_complete(bar, b.x, nloc, nx); b.st[0] = nloc; b.st[1] = nx; }
        const unsigned old = xb_add(&bar[XB_XSUB(b.x)], 1u);
        const unsigned gen = old / nloc;
        if (old + 1u == (gen + 1u) * nloc) {
            __builtin_amdgcn_fence(__ATOMIC_RELEASE, "agent");
            asm volatile("s_waitcnt vmcnt(0)" ::: "memory");
            const unsigned og = xb_add(&bar[XB_TOP], 1u);
            const unsigned tg = og / nx;
            if (og + 1u == (tg + 1u) * nx) xb_add(&bar[XB_TOPGEN], 1u);
            else XB_SPIN(xb_ld(&bar[XB_TOPGEN]) == tg, bar);
            __builtin_amdgcn_fence(__ATOMIC_ACQUIRE, "agent");
            xb_add(&bar[XB_XGEN(b.x)], 1u);
            asm volatile("s_waitcnt vmcnt(0)" ::: "memory");
        } else {
            XB_SPIN(xb_ld(&bar[XB_XGEN(b.x)]) == gen, bar);
            __builtin_amdgcn_fence(__ATOMIC_ACQUIRE, "agent");
            asm volatile("s_waitcnt vmcnt(0)" ::: "memory");
        }
    }
    __syncthreads();
}

__device__ __forceinline__ unsigned f2bf(float f) { unsigned u = __builtin_bit_cast(unsigned, f); return (u + 0x7fffu + ((u >> 16) & 1u)) >> 16; }
__device__ __forceinline__ unsigned pk2(float lo, float hi) { return f2bf(lo) | (f2bf(hi) << 16); }
__device__ __forceinline__ float wave_sum(float v) {
    v += swz_xor<1>(v); v += swz_xor<2>(v); v += swz_xor<4>(v); v += swz_xor<8>(v); v += swz_xor<16>(v);
    return add_x32(v);
}
__device__ __forceinline__ float wave_max(float v) {
    v = fmaxf(v, swz_xor<1>(v)); v = fmaxf(v, swz_xor<2>(v)); v = fmaxf(v, swz_xor<4>(v)); v = fmaxf(v, swz_xor<8>(v)); v = fmaxf(v, swz_xor<16>(v));
    return max_x32(v);
}
template <bool PERMW> __device__ __forceinline__ void transpose_item(const float* W, int K, int N, bf16* WT, LAS float* scr, int item, int lane, int ldk = 0, int koff = 0) {
    if (ldk == 0) ldk = K;
    const int nblk = N / 32, kb = item / nblk, nb = item % nblk, k0 = 64 * kb, n0 = 32 * nb;
#pragma unroll 8
    for (int i = 0; i < 32; ++i) { const int kk = 2 * i + (lane >> 5); scr[kk * 33 + (lane & 31)] = W[(size_t)(k0 + kk) * N + n0 + (lane & 31)]; }
    LDS_WAIT(); asm volatile("" ::: "memory");
    const int c = lane & 7;
    int n0p = n0;
    if (PERMW) { const int lg = nb & 7; n0p = (nb & ~7) * 32 + 32 * (4 * (lg & 1) + (lg >> 1));
        if (nb >= 240) { const int gi = nb - 240, isb = gi >> 5, blk = gi & 31; n0p = (30 + (blk >> 2)) * 256 + 32 * (4 * isb + (blk & 3)); } }
#pragma unroll
    for (int j = 0; j < 4; ++j) { const int n = (lane >> 3) + 8 * j; const LAS float* s = scr + (8 * c) * 33 + n;
        v4u o; o.x = pk2(s[0 * 33], s[1 * 33]); o.y = pk2(s[2 * 33], s[3 * 33]); o.z = pk2(s[4 * 33], s[5 * 33]); o.w = pk2(s[6 * 33], s[7 * 33]);
        *(v4u*)(WT + (size_t)(n0p + n) * ldk + koff + k0 + 8 * c) = o; }
    LDS_WAIT(); asm volatile("" ::: "memory");
}
__device__ __forceinline__ void transpose6_item(const float* W, int K, int N, bf16* WT6, const float* gate  , LAS float* scr, int item, int lane) {
    const int nblk = N / 32, kb = item / nblk, nb = item % nblk, k0 = 64 * kb, n0 = 32 * nb;
#pragma unroll 8
    for (int i = 0; i < 32; ++i) { const int kk = 2 * i + (lane >> 5); scr[kk * 33 + (lane & 31)] = W[(size_t)(k0 + kk) * N + n0 + (lane & 31)]; }
    LDS_WAIT(); asm volatile("" ::: "memory");
    const int c = lane & 7;
#pragma unroll
    for (int j = 0; j < 4; ++j) { const int n = (lane >> 3) + 8 * j; const LAS float* s = scr + (8 * c) * 33 + n;
        float v[8];
#pragma unroll
        for (int q = 0; q < 8; ++q) v[q] = s[q * 33];
#pragma unroll
        for (int b = 0; b < 6; ++b) { const float g = gate[b * 6144 + n0 + n];
            v4u o; o.x = pk2(v[0] * g, v[1] * g); o.y = pk2(v[2] * g, v[3] * g); o.z = pk2(v[4] * g, v[5] * g); o.w = pk2(v[6] * g, v[7] * g);
            *(v4u*)(WT6 + (size_t)b * K * N + (size_t)(n0 + n) * K + k0 + 8 * c) = o; } }
    LDS_WAIT(); asm volatile("" ::: "memory");
}
__device__ __forceinline__ void gemv6_task(const LAS float* vec, LAS f32x4* red, const float* W, int N, int col0, const float* bias, float* out, int tid) {
    const int cgp = tid & 7, ks = tid >> 3;
    f32x4 acc[6];
#pragma unroll
    for (int b = 0; b < 6; ++b) acc[b] = (f32x4){0.f, 0.f, 0.f, 0.f};
#pragma unroll 4
    for (int kk = 0; kk < 16; ++kk) { const int k = ks * 16 + kk; const f32x4 w = *(const f32x4*)(W + (size_t)k * N + col0 + 4 * cgp);
#pragma unroll
        for (int b = 0; b < 6; ++b) acc[b] += w * vec[b * 1024 + k]; }
#pragma unroll
    for (int b = 0; b < 6; ++b) red[(ks * 8 + cgp) * 6 + b] = acc[b];
    __syncthreads();
    if (tid < 192) { const int b = tid >> 5, c = tid & 31; float s = 0.f; const LAS float* rf = (const LAS float*)red;
        for (int k2 = 0; k2 < 64; ++k2) s += rf[((k2 * 8 + (c >> 2)) * 6 + b) * 4 + (c & 3)];
        out[b * N + col0 + c] = s + (bias ? bias[col0 + c] : 0.f); }
    __syncthreads();
}

__device__ __forceinline__ void gemv6_task16(const LAS float* vec, LAS f32x4* red, const float* W, int N, int col0, float* out, int tid) {
    const int cgp = tid & 3, ks = tid >> 2;
    f32x4 acc[6];
#pragma unroll
    for (int b = 0; b < 6; ++b) acc[b] = (f32x4){0.f, 0.f, 0.f, 0.f};
#pragma unroll
    for (int kk = 0; kk < 8; ++kk) { const int k = ks * 8 + kk; const f32x4 w = *(const f32x4*)(W + (size_t)k * N + col0 + 4 * cgp);
#pragma unroll
        for (int b = 0; b < 6; ++b) acc[b] += w * vec[b * 1024 + k]; }
#pragma unroll
    for (int b = 0; b < 6; ++b) red[(ks * 4 + cgp) * 6 + b] = acc[b];
    __syncthreads();
    if (tid < 96) { const int b = tid >> 4, c = tid & 15; float s = 0.f; const LAS float* rf = (const LAS float*)red;
        for (int k2 = 0; k2 < 128; ++k2) s += rf[((k2 * 4 + (c >> 2)) * 6 + b) * 4 + (c & 3)];
        out[b * N + col0 + c] = s; }
    __syncthreads();
}

struct Args { const float* in[24]; float* out; unsigned char* ws; int ph_lo, ph_hi; };
constexpr int NPHASE = 11;

__global__ void __launch_bounds__(NWAVES * 64, 2) mk_fwd(Args a) {
    extern __shared__ __attribute__((aligned(16))) unsigned char lds_raw[];
    cg::grid_group grid = cg::this_grid();
    LAS unsigned char* lds = (LAS unsigned char*)lds_raw;
    const int wave = __builtin_amdgcn_readfirstlane((int)threadIdx.x >> 6);
#define lane (att::lane_now())
#define tid ((wave << 6) | att::lane_now())
    const int G = gridDim.x; const int bx = blockIdx.x; const int vcu = (G % 8 == 0) ? (bx % 8) * (G / 8) + bx / 8 : bx;
    const int gw = vcu * NWAVES + wave, NGW = G * NWAVES;
    unsigned char* ws = a.ws; unsigned char* dob = (unsigned char*)a.out;
    const float *x_p = a.in[0], *x_s = a.in[1], *c_p = a.in[2], *c_s = a.in[3], *rel_bias = a.in[4], *norm1_g = a.in[5], *w_ada = a.in[6], *b_ada = a.in[7], *w_in = a.in[8],
                *qn_a = a.in[9], *kn_a = a.in[10], *lq1 = a.in[11], *lk1 = a.in[12], *lq2 = a.in[13], *lk2 = a.in[14], *subln_g = a.in[15], *qn_b = a.in[16], *kn_b = a.in[17],
                *w_br_a = a.in[18], *w_br_b = a.in[19], *w_o = a.in[20], *norm2_g = a.in[21], *w_up = a.in[22], *w_down = a.in[23];
    float* mod = (float*)(ws + WS_MOD); float* sbias = (float*)(ws + WS_SBIAS); float* rowss = (float*)(ws + WS_ROWSS);
    bf16 *WinT = (bf16*)(ws + WS_WIN), *WbaT = (bf16*)(ws + WS_WBA), *WbbT = (bf16*)(ws + WS_WBB), *WupT = (bf16*)(ws + WS_WUP), *WoT = (bf16*)(ws + WS_WO), *WdnT = (bf16*)(ws + WS_WDN);
    bf16 *QK = (bf16*)(ws + WS_QK), *VA = (bf16*)(ws + WS_VA), *DIL = (bf16*)(ws + WS_DIL), *GT = (bf16*)(ws + WS_GT), *MG = (bf16*)(ws + WS_MG), *A2 = (bf16*)(ws + WS_A2), *HB = (bf16*)(ws + WS_H);
    bf16 *XN = (bf16*)(dob + DO_XN), *YA = (bf16*)(dob + DO_YA), *YB = (bf16*)(dob + DO_YB);
    const int lo = a.ph_lo, hi = a.ph_hi;
    if (lo < 0) grid.sync();
    volatile LAS unsigned* bst = (volatile LAS unsigned*)(lds + BST_OFF);
    if (threadIdx.x < 4) bst[threadIdx.x] = 0u;
    __syncthreads();
    const XcdBarrier xbar = xcd_barrier_post((unsigned*)ws, bst);
#ifdef PMODE
    if (blockIdx.x == 0 && threadIdx.x == 0) *(volatile unsigned long long*)(ws + 65536 + 512) = __builtin_amdgcn_s_memrealtime();
#define PSTAMP(k) do { if (bx == 0 && threadIdx.x == 0) ((float*)(ws + 65536 + 256))[(k)] = (float)(__builtin_amdgcn_s_memrealtime() - *(volatile unsigned long long*)(ws + 65536 + 512)) * 0.01f; } while (0)
#else
#define PSTAMP(k) do {} while (0)
#endif
#ifndef P2_ROT
#define P2_ROT(v) (((v) >> 5) % 3)
#endif
#ifndef PPREV
#define PPREV (PMODE - 1)
#endif
#ifndef PBASE
#define PBASE 0
#define PQ 32.0f
#endif
#ifndef TBASE
#define TBASE 0
#define TSCALE 0.01f
#endif
#ifndef PH_MASK
#define PH_MASK 0x7ff
#endif
#define PH_ON(k) ((PH_MASK >> (k)) & 1)
#ifndef PH_REP
#define PH_REP 0
#endif
#define NREP(k) ((((PH_REP) >> (k)) & 1) ? 2 : 1)
#define IN(k) (lo <= (k) && (k) < hi)
#ifndef XSYNC
#define XSYNC 0
#endif
#define SEAM(k) do { if (IN(k) && IN((k) + 1)) { xcd_barrier(xbar); for (int xs_ = 0; xs_ < XSYNC; ++xs_) xcd_barrier(xbar); PSTAMP(k); } } while (0)

    if (PH_ON(0) && IN(0)) for (int rep_ = 0; rep_ < NREP(0); ++rep_) {
        LAS float* scr = (LAS float*)(lds + wave * 16384);
        constexpr int I_IN = (DM / 64) * (NIN / 32), I_BA = (DM / 64) * (DM / 32), I_BB = (512 / 64) * (DM / 32), I_O = I_BA, I_UP = (DM / 64) * (FF / 32), I_DN = (FF / 64) * (DM / 32);
        constexpr int NITEMS = I_IN + I_BA + I_BB + I_O + I_UP + I_DN;
        for (int it = gw; it < NITEMS; it += NGW) {
            int r = it;
            if (r < I_IN) { transpose_item<true>(w_in, DM, NIN, WinT, scr, r, lane); continue; } r -= I_IN;
            if (r < I_BA) { transpose_item<false>(w_br_a, DM, DM, WbaT, scr, r, lane, 1536, 0); continue; } r -= I_BA;
            if (r < I_BB) { transpose_item<false>(w_br_b, 512, DM, WbaT, scr, r, lane, 1536, 1024); continue; } r -= I_BB;
            if (r < I_O) { transpose_item<false>(w_o, DM, DM, WoT, scr, r, lane); continue; } r -= I_O;
            if (r < I_UP) { transpose_item<true>(w_up, DM, FF, WupT, scr, r, lane); continue; } r -= I_UP;
            transpose_item<false>(w_down, FF, DM, WdnT, scr, r, lane, LDH, 0);
        }
        for (int i = gw * 64 + lane; i < TOK; i += NGW * 64) rowss[i] = 0.f;
        __syncthreads();
        LAS float* vec = (LAS float*)lds; LAS f32x4* red = (LAS f32x4*)(lds + 32768);
        for (int i = tid; i < 6 * 1024; i += 512) { const int b = i >> 10, k = i & 1023; const float c = b < 4 ? c_p[b * 1024 + k] : c_s[(b - 4) * 1024 + k]; vec[i] = c / (1.0f + __expf(-c)); }
        __syncthreads();
        for (int task = vcu; task < 6144 / 32; task += G) gemv6_task(vec, red, w_ada, 6144, task * 32, b_ada, mod, tid);
        __syncthreads();
    }
    SEAM(0);
    if (PH_ON(1) && IN(1)) for (int rep_ = 0; rep_ < NREP(1); ++rep_) {
        for (int m0 = 4 * gw; m0 < TOK; m0 += 4 * NGW) {
            const int ln = lane; const int b = pg8::batch_of(m0);
            const float* xr = m0 < 16384 ? x_p + (size_t)m0 * 1024 : x_s + (size_t)(m0 - 16384) * 1024;
            const float* sh1 = mod + b * 6144; const float* sc1 = mod + b * 6144 + 1024;
            f32x4 v[4][4];
#pragma unroll
            for (int r = 0; r < 4; ++r)
#pragma unroll
                for (int j = 0; j < 4; ++j) v[r][j] = ((const f32x4*)(xr + (size_t)r * 1024))[ln + 64 * j];
            f32x4 gm[4], sh[4];
#pragma unroll
            for (int j = 0; j < 4; ++j) { const int c = 4 * ln + 256 * j; gm[j] = *(const f32x4*)(norm1_g + c) * (*(const f32x4*)(sc1 + c) + 1.0f); sh[j] = *(const f32x4*)(sh1 + c); }
#pragma unroll
            for (int r = 0; r < 4; ++r) {
                float s = 0.f;
#pragma unroll
                for (int j = 0; j < 4; ++j) s += (v[r][j].x * v[r][j].x + v[r][j].y * v[r][j].y) + (v[r][j].z * v[r][j].z + v[r][j].w * v[r][j].w);
                const float rstd = 1.0f / sqrtf(wave_sum(s) * (1.0f / 1024.0f) + 1e-6f);
                unsigned long long* o8 = (unsigned long long*)(XN + (size_t)(m0 + r) * 1024) + ln;
#pragma unroll
                for (int j = 0; j < 4; ++j) { const f32x4 h = v[r][j] * rstd * gm[j] + sh[j]; o8[64 * j] = (unsigned long long)pk2(h.x, h.y) | ((unsigned long long)pk2(h.z, h.w) << 32); }
            }
        }
        __syncthreads();
        LAS float* vec = (LAS float*)lds; LAS f32x4* red = (LAS f32x4*)(lds + 32768);
        for (int i = tid; i < 6 * 1024; i += 512) { const int b = i >> 10, k = i & 1023; vec[i] = mod[b * 6144 + 3072 + k]; }
        __syncthreads();
        for (int task = vcu; task < FF / 16; task += G) gemv6_task16(vec, red, w_up, FF, task * 16, sbias, tid);
        __syncthreads();
    }
    SEAM(1);
#pragma unroll 1
    for (int c = 0; c < 2; ++c) {
        const int S = c == 0 ? 4096 : 8192, lgS = c == 0 ? 12 : 13;
        bf16* Yc = c == 0 ? YA : XN;
        bf16* GTc = c == 0 ? GT : (bf16*)(ws + WS_GT1);
        if (PH_ON(2) && IN(2 + 3 * c)) for (int rep_ = 0; rep_ < NREP(2); ++rep_) {
#ifdef STAG1
            for (int sd_ = 0; sd_ < STAG1 * (vcu & 3); ++sd_) __builtin_amdgcn_s_sleep(127);
#endif
            pg8::Gemm g{XN + (size_t)c * CH * DM, WinT, CH, NIN, DM}; pg8::P1Order SO{c, (int)G, (int)bx};
            { LAS float* gl_ = (LAS float*)(lds + 131072);
              if (tid < 512) gl_[tid] = tid < 64 ? qn_a[tid] * pg8::C2Q : tid < 128 ? kn_a[tid - 64] : tid < 320 ? qn_b[tid - 128] * pg8::C2Q : kn_b[tid - 320];
              __syncthreads(); }
            pg8::EpiProj E{QK, VA, DIL, GTc, (const LAS float*)(lds + 131072), S, lgS};
            static_assert(WS_GT1 - WS_GT == pg8::GTX_OFF * 2, "gate buffer distance");
            pg8::gemm_phase<pg8::EpiProj, pg8::P1Order, true, true>(lds, g, SO, E);
        }
        SEAM(2 + 3 * c);
        if (PH_ON(3) && IN(3 + 3 * c)) for (int rep_ = 0; rep_ < NREP(3); ++rep_) {
            if (wave == 0) {
                const int ln = lane;
                const float a1 = wave_sum(lq1[ln] * lk1[ln]), a2 = wave_sum(lq2[ln] * lk2[ln]);
                const float gqa = wave_max(fabsf(qn_a[ln])), gka = wave_max(fabsf(kn_a[ln]));
                float gb = 0.f;
#pragma unroll
                for (int g = 0; g < 3; ++g) gb = fmaxf(gb, wave_max(fabsf(qn_b[64 * g + ln])) * wave_max(fabsf(kn_b[64 * g + ln])));
                float ba = 0.f, bb = 0.f;
                for (int i = ln; i < 1024; i += 64) { const float v = fabsf(rel_bias[i]); if ((i & 31) < 8) ba = fmaxf(ba, v); else bb = fmaxf(bb, v); }
                ba = wave_max(ba); bb = wave_max(bb);
                if (ln == 0) { LAS float* SC = (LAS float*)(lds + att::SC_OFF); SC[0] = __expf(a1) - __expf(a2) + 0.2f; SC[1] = (8.0f * gqa * gka + ba) * att::LOG2E; SC[2] = (8.0f * gb + bb) * att::LOG2E; }
            }
            __syncthreads();
            { const int nqb = S / 256; const int rot = P2_ROT(vcu); int kda = 0; bool dil_done = false;
              for (int s = 0; ; ++s) {
                  const int uda = vcu + kda * G;
                  if (!dil_done && (s == rot || uda >= 512)) {
                      for (int u = vcu; u < 256; u += G) att::dil_unit<false>(lds, DIL, Yc, rel_bias, u & 7, u >> 3, S, lgS, tid);
                      dil_done = true;
                  } else if (uda < 512) { const int sh = uda / nqb, qb = uda % nqb, seq = sh >> 3, head = sh & 7;
#ifdef TMODE
                      att::da_unit(lds, QK, VA, Yc, rel_bias, subln_g, head, seq * (S / 64), S / 64, qb, tid, (bx == 0 && c == 1 && kda == 0) ? (float*)(ws + 65536) : nullptr);
#else
                      att::da_unit(lds, QK, VA, Yc, rel_bias, subln_g, head, seq * (S / 64), S / 64, qb, tid);
#endif
                      ++kda;
                  } else break;
              } }
        }
        SEAM(3 + 3 * c);
        if (c == 1) {
            if (PH_ON(4) && IN(7)) for (int rep_ = 0; rep_ < NREP(4); ++rep_) {
                pg8::Gemm g{YA, WbaT, TOK, DM, 1536}; pg8::StaticOrder SO; SO.init(TOK, DM, G, bx);
                const ptrdiff_t aoff1 = ((const char*)XN - (const char*)YA) - (ptrdiff_t)64 * 256 * 1536 * 2;
                pg8::EpiBrC E{MG, GT, GT + (size_t)CH * 1024, (const bf16*)(ws + WS_GT1), (const bf16*)(ws + WS_GT1) + (size_t)CH * 1024, aoff1, 16};
                pg8::gemm_phase<pg8::EpiBrC, pg8::StaticOrder, true, true>(lds, g, SO, E);
            }
            SEAM(7);
        }
    }
    if (PH_ON(8) && IN(8)) for (int rep_ = 0; rep_ < NREP(8); ++rep_) {
        pg8::Gemm g{MG, WoT, TOK, DM, DM, PG8_ATILE}; pg8::StaticOrder SO; SO.init(TOK, DM, G, bx);
        pg8::EpiWo E{x_p, x_s, a.out, A2, mod, norm2_g, rowss};
        pg8::gemm_phase<pg8::EpiWo, pg8::StaticOrder, true, true>(lds, g, SO, E);
    }
    SEAM(8);
    if (PH_ON(9) && IN(9)) for (int rep_ = 0; rep_ < NREP(9); ++rep_) {
        pg8::Gemm g{A2, WupT, TOK, FF, DM, PG8_ATILE}; pg8::StaticOrder SO; SO.init(TOK, FF, G, bx);
        pg8::EpiUp E{HB, rowss, sbias};
        pg8::gemm_phase<pg8::EpiUp, pg8::StaticOrder, true, true>(lds, g, SO, E);
    }
    SEAM(9);
    if (PH_ON(10) && IN(10)) for (int rep_ = 0; rep_ < NREP(10); ++rep_) {
        pg8::Gemm g{HB, WdnT, TOK, DM, FF, 0, LDH, LDH}; pg8::StaticOrder SO; SO.init(TOK, DM, G, bx);
        pg8::EpiDown E{a.out, mod};
        pg8::gemm_phase<pg8::EpiDown, pg8::StaticOrder, true, true>(lds, g, SO, E);
    }
#ifdef PMODE
    xcd_barrier(xbar); PSTAMP(10);
    if (bx == 0 && threadIdx.x == 0) { const float* tp = (const float*)(ws + 65536 + 256); a.out[0] += floorf(((PMODE == 0 ? tp[0] : (PMODE == 99 ? tp[10] * 0.1f : tp[PMODE] - tp[PPREV])) - (float)PBASE) * (1.0f / PQ)); }
#endif
#ifdef TMODE
    xcd_barrier(xbar);
    if (bx == 0 && threadIdx.x == 0) { const float* tp = (const float*)(ws + 65536); a.out[0] += (TMODE == 0) ? 100.0f : ((tp[TMODE - 1] - (float)TBASE) * TSCALE); }
#endif
#undef IN
#undef SEAM
#undef lane
#undef tid
}

extern "C" void kernel_launch(void* const* d_in, const int* in_sizes, int n_in, void* d_out, int out_size, void* d_ws, size_t ws_size, hipStream_t stream) {
    static int grid = 0;
    if (grid == 0) {
        if (n_in != 24 || out_size != TOK * DM || ws_size < WS_END) { fprintf(stderr, "kernel_launch: unexpected shapes (n_in %d, out %d, ws %zu)\n", n_in, out_size, ws_size); grid = -1; return; }
        int dev = 0, cus = 0, per_cu = 0;
        if (hipGetDevice(&dev) != hipSuccess || hipDeviceGetAttribute(&cus, hipDeviceAttributeMultiprocessorCount, dev) != hipSuccess) { grid = -1; return; }
        if (hipFuncSetAttribute((const void*)mk_fwd, hipFuncAttributeMaxDynamicSharedMemorySize, LDS_BYTES) != hipSuccess) { fprintf(stderr, "kernel_launch: hipFuncSetAttribute failed\n"); grid = -1; return; }
        if (hipOccupancyMaxActiveBlocksPerMultiprocessor(&per_cu, (const void*)mk_fwd, NWAVES * 64, LDS_BYTES) != hipSuccess || per_cu < 1) { fprintf(stderr, "kernel_launch: occupancy query says %d\n", per_cu); per_cu = 1; }
        (void)hipGetLastError();
        grid = cus;
    }
    if (grid < 0) return;
#ifdef XMEMSET
    for (int xm_ = 0; xm_ < XMEMSET; ++xm_) (void)hipMemsetAsync((char*)d_ws + (480u << 20) + xm_ * 65536, 0, 65536, stream);
#endif
    if (hipMemsetAsync(d_ws, 0, 65536, stream) != hipSuccess) { fprintf(stderr, "kernel_launch: hipMemsetAsync failed\n"); return; }
    Args a{};
    for (int i = 0; i < 24; ++i) a.in[i] = (const float*)d_in[i];
    a.out = (float*)d_out; a.ws = (unsigned char*)d_ws;
#ifndef MK_PER_PHASE
    a.ph_lo = 0; a.ph_hi = NPHASE;
    void* args[] = {&a};
#ifdef PLAIN_LAUNCH
    hipLaunchKernelGGL(mk_fwd, dim3(grid), dim3(NWAVES * 64), LDS_BYTES, stream, a); hipError_t e = hipGetLastError(); (void)args;
#else
    hipError_t e = hipLaunchCooperativeKernel((const void*)mk_fwd, dim3(grid), dim3(NWAVES * 64), args, LDS_BYTES, stream);
#endif
    if (e != hipSuccess) fprintf(stderr, "kernel_launch: cooperative launch failed: %s (grid %d)\n", hipGetErrorString(e), grid);
#else
    for (int p = 0; p < NPHASE; ++p) { a.ph_lo = p; a.ph_hi = p + 1; hipLaunchKernelGGL(mk_fwd, dim3(grid), dim3(NWAVES * 64), LDS_BYTES, stream, a); }
#endif
}
```

```cpp
#include <hip/hip_runtime.h>
#include <hip/hip_cooperative_groups.h>
#include <cstdio>
#include <cstdint>
namespace cg = cooperative_groups;
template <int M> __device__ __forceinline__ float swz_xor(float v) { return __builtin_bit_cast(float, __builtin_amdgcn_ds_swizzle(__builtin_bit_cast(int, v), (M << 10) | 0x1f)); }
__device__ __forceinline__ float add_x32(float v) { const unsigned b = __builtin_bit_cast(unsigned, v); auto rr = __builtin_amdgcn_permlane32_swap(b, b, false, false); return __builtin_bit_cast(float, (unsigned)rr[0]) + __builtin_bit_cast(float, (unsigned)rr[1]); }
__device__ __forceinline__ float max_x32(float v) { const unsigned b = __builtin_bit_cast(unsigned, v); auto rr = __builtin_amdgcn_permlane32_swap(b, b, false, false); return fmaxf(__builtin_bit_cast(float, (unsigned)rr[0]), __builtin_bit_cast(float, (unsigned)rr[1])); }
namespace pg8 {
#define PG8_LAS __attribute__((address_space(3)))
typedef unsigned short bf16_t;
typedef short bf16x8 __attribute__((ext_vector_type(8)));
typedef float f32x4 __attribute__((ext_vector_type(4)));
typedef unsigned u32x4 __attribute__((ext_vector_type(4)));
constexpr int BM = 256, BK = 64, HALF = 128, HTB = HALF * BK * 2  , STAGE_BYTES = 8 * HTB, NXCD = 8, WGM = 8;

__host__ __device__ __forceinline__ int lds_byte(int r, int c) { const int st = (r >> 4) * 2 + (c >> 5), rr = r & 15, cc = c & 31, ob = rr * 64 + cc * 2; return st * 1024 + (ob ^ (((ob >> 9) & 1) << 5)); }
__host__ __device__ __forceinline__ void stage_rc(int b, int& R, int& C) { const int st = b / 1024, sb = b % 1024, swz = sb ^ (((sb >> 9) & 1) << 5); R = (st >> 1) * 16 + swz / 64; C = (st & 1) * 32 + (swz % 64) / 2; }
__host__ __device__ __forceinline__ int perm32(int rho) { const int n = rho >> 4, i = rho & 15; return 8 * (i >> 2) + 4 * n + (i & 3); }

struct Unit { int pm, pn; };
struct Gemm { const bf16_t* A; const bf16_t* Bt; int M, N, K; int atile = 0; int lda = 0, ldb = 0; };
__host__ __device__ __forceinline__ size_t a_tiled(int row, int col, int nblk) { return ((size_t)(row >> 4) * nblk + (col >> 5)) * 512 + (row & 15) * 32 + (col & 31); }
#define PG8_ATILE 0
#define PG8_ABJ 128

struct StaticOrder {
    int nM, nN, nwg, G, c;
    __host__ __device__ void init(int M, int N, int G_, int c_) { nM = M / BM; nN = N / BM; nwg = nM * nN; G = G_; c = c_; }
    __host__ __device__ bool next(int i, Unit& u) const {
        const long L = (long)i * G + c; if (L >= nwg) return false;
        int wgid = (int)L; { const int q = nwg / NXCD, r = nwg % NXCD, xcd = wgid % NXCD; int off = wgid / NXCD;
#ifndef SO_NOMIX
            if (r == 0) { const int rot = ((xcd >> 1) * (q >> 2)) & ~7; off = (off + rot) % q; if (xcd & 1) off = q - 1 - off; }
#endif
            wgid = (xcd < r ? xcd * (q + 1) : r * (q + 1) + (xcd - r) * q) + off; }
        const int nig = WGM * nN, gid = wgid / nig, fm = gid * WGM, gsz = (nM - fm) < WGM ? (nM - fm) : WGM;
        u.pm = fm + ((wgid % nig) % gsz); u.pn = (wgid % nig) / gsz; return true;
    }
    __device__ __forceinline__ void a_ready(const Unit&) const {}
    __device__ __forceinline__ void done(const Unit&) const {}
};
typedef __bf16 pk_bf16x2_t __attribute__((ext_vector_type(2)));
typedef float pk_f32x2_t __attribute__((ext_vector_type(2)));
__device__ __forceinline__ unsigned cvt_pk_bf16(float lo, float hi) { pk_f32x2_t v = {lo, hi}; return __builtin_bit_cast(unsigned, __builtin_convertvector(v, pk_bf16x2_t)); }
template <class Epi, class Sched, bool ALIGN_EPI = false, bool SP2 = false>
__device__ __forceinline__ void gemm_phase(PG8_LAS unsigned char* lds, const Gemm g, const Sched& S, const Epi& E) {
    int tid_ = threadIdx.x; asm volatile("" : "+v"(tid_));
    const int tid = tid_, wid = __builtin_amdgcn_readfirstlane(tid >> 6), lane = tid & 63, wr = wid >> 2, wc = wid & 3, fr = lane & 15, fq = lane >> 4;
    const int K = g.K, nt = K / BK, lda = g.lda ? g.lda : K, ldb = g.ldb ? g.ldb : K;
    unsigned voffA[2], voffB[2];
#pragma unroll
    for (int i = 0; i < 2; ++i) { int R, C; stage_rc(tid * 16 + i * 8192, R, C); const int Rb = Epi::PERM ? ((R & ~31) + perm32(R & 31)) : R;
        voffA[i] = g.atile ? (unsigned)(((R >> 4) * g.atile + (C >> 5)) * 1024 + (R & 15) * 64 + (C & 31) * 2) : (unsigned)(R * lda + C) * 2u;     voffB[i] = (unsigned)(Rb * ldb + C) * 2u; }
    unsigned voffAc[2], voffAn[2]; size_t hstepAc, hstepAn;
#define PG8_APERM_SET(VO, HS, LGR) do { const int lg_ = (LGR); _Pragma("unroll") for (int i = 0; i < 2; ++i) { int R, C; stage_rc(tid * 16 + i * 8192, R, C); \
        const int Rp = lg_ ? ((R >> (8 - lg_)) + ((R & ((1 << (8 - lg_)) - 1)) << lg_)) : R; VO[i] = (unsigned)(Rp * K + C) * 2u; } \
        HS = (size_t)(lg_ ? (1 << (lg_ - 1)) : HALF) * K * 2; } while (0)
    const size_t kstep = (size_t)(BK * 2);
    const size_t hstep = (size_t)HALF * ldb * 2;
    const size_t tstep = 2 * hstep;
    const size_t kstepA = g.atile ? (size_t)2048 : kstep, hstepT = g.atile ? (size_t)g.atile * 8192 : (size_t)HALF * lda * 2, tstepA = 2 * hstepT;
    const unsigned ldsw = (unsigned)wid * 1024u;
    const int aoff = lds_byte(wr * 64 + fr, fq * 8), boff = lds_byte(wc * 32 + fr, fq * 8);
#define PG8_SA(b, h) (((b) * 2 + (h)) * HTB)
#define PG8_SB(b, h) ((4 + (b) * 2 + (h)) * HTB)
#define PG8_STAGE(bufoff, gbase, voff) do { _Pragma("unroll") for (int _i = 0; _i < 2; ++_i) \
        __builtin_amdgcn_global_load_lds((const unsigned*)((const char*)(gbase) + (voff)[_i]), (PG8_LAS unsigned*)(lds + (bufoff) + ldsw + _i * 8192), 16, 0, 0); } while (0)
#define PG8_LDA(dst, b, h) do { _Pragma("unroll") for (int m = 0; m < 4; ++m) _Pragma("unroll") for (int k = 0; k < 2; ++k) dst[m][k] = *(const PG8_LAS bf16x8*)(lds + PG8_SA(b, h) + aoff + m * 2048 + k * 1024); } while (0)
#define PG8_LDB(dst, b, h) do { _Pragma("unroll") for (int n = 0; n < 2; ++n) _Pragma("unroll") for (int k = 0; k < 2; ++k) dst[n][k] = *(const PG8_LAS bf16x8*)(lds + PG8_SB(b, h) + boff + n * 2048 + k * 1024); } while (0)
#define PG8_MMA(ai, bj, At, Bt) do { __builtin_amdgcn_s_setprio(1); _Pragma("unroll") for (int m = 0; m < 4; ++m) _Pragma("unroll") for (int n = 0; n < 2; ++n) _Pragma("unroll") for (int k = 0; k < 2; ++k) \
        acc[ai][bj][m][n] = __builtin_amdgcn_mfma_f32_16x16x32_bf16(Bt[n][k], At[m][k], acc[ai][bj][m][n], 0, 0, 0); __builtin_amdgcn_s_setprio(0); } while (0)
#define PG8_WAIT_V(n) asm volatile("s_waitcnt vmcnt(" #n ")" ::: "memory")
#define PG8_WAIT_L(n) asm volatile("s_waitcnt lgkmcnt(" #n ")" ::: "memory")
#define PG8_BAR __builtin_amdgcn_s_barrier()
#define PG8_SCHED __builtin_amdgcn_sched_barrier(0)
    Unit cur, nxt; int ui = 0;
    if (!S.next(0, cur)) return;
    f32x4 acc[2][2][4][2];
    if constexpr (Epi::INIT) E.init(acc, cur, wr, wc, fr, fq);
    else {
#pragma unroll
    for (int a = 0; a < 2; ++a)
#pragma unroll
        for (int b = 0; b < 2; ++b)
#pragma unroll
            for (int m = 0; m < 4; ++m)
#pragma unroll
                for (int n = 0; n < 2; ++n) acc[a][b][m][n] = (f32x4){0.f, 0.f, 0.f, 0.f};
    }
    bf16x8 At[4][2], B0[2][2], B1[2][2];
    const char* cA = (const char*)g.A + (size_t)cur.pm * tstepA + E.a_off(cur); const char* cB = (const char*)g.Bt + (size_t)cur.pn * tstep + E.bt_off(cur);
    if constexpr (Epi::APERM) { PG8_APERM_SET(voffAc, hstepAc, E.a_lgr(cur)); } else { voffAc[0] = voffA[0]; voffAc[1] = voffA[1]; hstepAc = hstepT; }
    S.a_ready(cur);
    if constexpr (SP2) {
        PG8_STAGE(PG8_SB(0, 0), cB, voffB); PG8_STAGE(PG8_SB(0, 1), cB + hstep, voffB); PG8_STAGE(PG8_SA(0, 0), cA, voffAc); PG8_STAGE(PG8_SA(0, 1), cA + hstepAc, voffAc);
        if (wr == 1) PG8_BAR;
        PG8_WAIT_V(2); PG8_BAR;
        PG8_STAGE(PG8_SB(1, 0), cB + kstep, voffB); PG8_STAGE(PG8_SA(1, 0), cA + kstepA, voffAc); PG8_STAGE(PG8_SB(1, 1), cB + hstep + kstep, voffB);
        PG8_WAIT_V(6); PG8_BAR;
    } else {
        PG8_STAGE(PG8_SB(0, 0), cB, voffB); PG8_STAGE(PG8_SA(0, 0), cA, voffA); PG8_STAGE(PG8_SB(0, 1), cB + hstep, voffB); PG8_STAGE(PG8_SA(0, 1), cA + hstep, voffA);
        if (wr == 1) PG8_BAR;
        PG8_WAIT_V(4); PG8_BAR;
        PG8_STAGE(PG8_SB(1, 0), cB + kstep, voffB); PG8_STAGE(PG8_SA(1, 0), cA + kstep, voffA); PG8_STAGE(PG8_SB(1, 1), cB + hstep + kstep, voffB);
        PG8_WAIT_V(6); PG8_BAR;
    }
    for (;;) {
        const bool has_next = S.next(ui + 1, nxt);
        const char* nA = has_next ? (const char*)g.A + (size_t)nxt.pm * tstepA + E.a_off(nxt) : cA; const char* nB = has_next ? (const char*)g.Bt + (size_t)nxt.pn * tstep + E.bt_off(nxt) : cB;
        if constexpr (Epi::APERM) { if (has_next) { PG8_APERM_SET(voffAn, hstepAn, E.a_lgr(nxt)); } else { voffAn[0] = voffAc[0]; voffAn[1] = voffAc[1]; hstepAn = hstepAc; } }
        else { voffAn[0] = voffA[0]; voffAn[1] = voffA[1]; hstepAn = hstepT; }
        for (int t = 0; t < nt; t += 2) {
            if constexpr (Epi::MIDFIX) { if (t == E.fix_t) E.midfix(acc, cur, wr, wc, fr, fq); }
            const bool last = (t == nt - 2);
            const char* a1 = cA + (size_t)(t + 1) * kstepA;
            const char* a2 = last ? nA : cA + (size_t)(t + 2) * kstepA; const char* b2 = last ? nB : cB + (size_t)(t + 2) * kstep;
            const char* a3 = a2 + kstepA; const char* b3 = b2 + kstep;
            if (last && has_next) S.a_ready(nxt);
            unsigned vo2[2]; vo2[0] = last ? voffAn[0] : voffAc[0]; vo2[1] = last ? voffAn[1] : voffAc[1]; const size_t hs2 = last ? hstepAn : hstepAc;
            if constexpr (SP2) {
            PG8_LDB(B0, 0, 0); PG8_LDB(B1, 0, 1); PG8_SCHED; PG8_LDA(At, 0, 0); PG8_STAGE(PG8_SA(1, 1), a1 + hstepAc, voffAc);
            PG8_WAIT_V(8); PG8_WAIT_L(0); PG8_BAR; PG8_MMA(0, 0, At, B0); PG8_MMA(0, 1, At, B1); PG8_BAR; PG8_SCHED;
            PG8_LDA(At, 0, 1); PG8_STAGE(PG8_SB(0, 0), b2, voffB); PG8_STAGE(PG8_SB(0, 1), b2 + hstep, voffB); PG8_STAGE(PG8_SA(0, 0), a2, vo2);
            PG8_WAIT_V(8); PG8_WAIT_L(0); PG8_BAR; PG8_MMA(1, 0, At, B0); PG8_MMA(1, 1, At, B1); PG8_BAR; PG8_SCHED;
            PG8_LDB(B0, 1, 0); PG8_LDB(B1, 1, 1); PG8_SCHED; PG8_LDA(At, 1, 0); PG8_STAGE(PG8_SA(0, 1), a2 + hs2, vo2);
            PG8_WAIT_V(8); PG8_WAIT_L(0); PG8_BAR; PG8_MMA(0, 0, At, B0); PG8_MMA(0, 1, At, B1); PG8_BAR; PG8_SCHED;
            PG8_LDA(At, 1, 1); PG8_STAGE(PG8_SB(1, 0), b3, voffB); PG8_STAGE(PG8_SB(1, 1), b3 + hstep, voffB); PG8_STAGE(PG8_SA(1, 0), a3, vo2);
            PG8_WAIT_V(8); PG8_WAIT_L(0); PG8_BAR; PG8_MMA(1, 0, At, B0); PG8_MMA(1, 1, At, B1); PG8_BAR; PG8_SCHED;
            } else {
            PG8_LDB(B0, 0, 0); PG8_SCHED; PG8_LDA(At, 0, 0); PG8_STAGE(PG8_SA(1, 1), a1 + hstep, voffA);
            PG8_WAIT_L(8); PG8_BAR; PG8_WAIT_L(0); PG8_MMA(0, 0, At, B0); PG8_BAR; PG8_SCHED;
            PG8_LDB(B1, 0, 1); PG8_STAGE(PG8_SB(0, 0), b2, voffB);
            PG8_BAR; PG8_WAIT_L(0); PG8_MMA(0, 1, At, B1); PG8_BAR;
            PG8_LDA(At, 0, 1); PG8_STAGE(PG8_SA(0, 0), a2, voffA);
            PG8_BAR; PG8_WAIT_L(0); PG8_MMA(1, 0, At, B0); PG8_BAR; PG8_SCHED;
            PG8_STAGE(PG8_SB(0, 1), b2 + hstep, voffB);
            PG8_WAIT_V(6); PG8_BAR; PG8_MMA(1, 1, At, B1); PG8_BAR;
            PG8_LDB(B0, 1, 0); PG8_SCHED; PG8_LDA(At, 1, 0); PG8_STAGE(PG8_SA(0, 1), a2 + hstep, voffA);
            PG8_WAIT_L(8); PG8_BAR; PG8_WAIT_L(0); PG8_MMA(0, 0, At, B0); PG8_BAR; PG8_SCHED;
            PG8_LDB(B1, 1, 1); PG8_STAGE(PG8_SB(1, 0), b3, voffB);
            PG8_BAR; PG8_WAIT_L(0); PG8_MMA(0, 1, At, B1); PG8_BAR;
            PG8_LDA(At, 1, 1); PG8_STAGE(PG8_SA(1, 0), a3, voffA);
            PG8_BAR; PG8_WAIT_L(0); PG8_MMA(1, 0, At, B0); PG8_BAR; PG8_SCHED;
            PG8_STAGE(PG8_SB(1, 1), b3 + hstep, voffB);
            PG8_WAIT_V(6); PG8_BAR; PG8_MMA(1, 1, At, B1); PG8_BAR;
            }
        }
        if constexpr (ALIGN_EPI) { if (wr == 0) PG8_BAR; }
        if constexpr (!Epi::AFTER_DRAIN) { E(acc, cur, wr, wc, fr, fq); S.done(cur); }
        if (!has_next) break;
        if constexpr (Epi::INIT) E.init(acc, nxt, wr, wc, fr, fq);
        else {
#pragma unroll
        for (int a = 0; a < 2; ++a)
#pragma unroll
            for (int b = 0; b < 2; ++b)
#pragma unroll
                for (int m = 0; m < 4; ++m)
#pragma unroll
                    for (int n = 0; n < 2; ++n) acc[a][b][m][n] = (f32x4){0.f, 0.f, 0.f, 0.f};
        }
        cur = nxt; cA = nA; cB = nB; ++ui; voffAc[0] = voffAn[0]; voffAc[1] = voffAn[1]; hstepAc = hstepAn;
        if constexpr (ALIGN_EPI) { if (wr == 1) PG8_BAR; }
    }
    PG8_WAIT_V(0);
    if constexpr (!ALIGN_EPI) { if (wr == 0) PG8_BAR; }
    PG8_BAR;
    if constexpr (Epi::AFTER_DRAIN) { E.fused(acc, cur, wr, wc, fr, fq, lds, wid, lane); S.done(cur); }
#undef PG8_SA
#undef PG8_SB
#undef PG8_STAGE
#undef PG8_LDA
#undef PG8_LDB
#undef PG8_MMA
#undef PG8_WAIT_V
#undef PG8_WAIT_L
#undef PG8_BAR
#undef PG8_SCHED
}
#define PG8_EPI_DEFAULTS static constexpr bool INIT = false, MIDFIX = false, APERM = false; __device__ __forceinline__ size_t bt_off(const Unit&) const { return 0; } __device__ __forceinline__ ptrdiff_t a_off(const Unit&) const { return 0; }
#ifndef LDH
#define LDH 4096
#endif
#ifdef NT_STORES
#define EPI_ST(T, p, v) __builtin_nontemporal_store((T)(v), (T*)(p))
#elif defined(NO_EPI_ST)
#define EPI_ST(T, p, v) do { T v_ = (v); asm volatile("" :: "v"(v_), "v"(p)); } while (0)
#else
#define EPI_ST(T, p, v) (*(T*)(p) = (v))
#endif
#ifndef H_ROWMAJOR
#define H_TILED
#define HNBLK 129
#else
#define HNBLK 0
#endif
constexpr int CH = 16384;
constexpr float C2Q = 0.125f * 1.4426950408889634f;
__device__ __forceinline__ u32x4 pack8(const f32x4& a, const f32x4& b) { u32x4 w; w.x = cvt_pk_bf16(a[0], a[1]); w.y = cvt_pk_bf16(a[2], a[3]); w.z = cvt_pk_bf16(b[0], b[1]); w.w = cvt_pk_bf16(b[2], b[3]); return w; }
__device__ __forceinline__ f32x4 bf4lo(const u32x4& w) { return (f32x4){__uint_as_float(w.x << 16), __uint_as_float(w.x & 0xffff0000u), __uint_as_float(w.y << 16), __uint_as_float(w.y & 0xffff0000u)}; }
__device__ __forceinline__ f32x4 bf4hi(const u32x4& w) { return (f32x4){__uint_as_float(w.z << 16), __uint_as_float(w.z & 0xffff0000u), __uint_as_float(w.w << 16), __uint_as_float(w.w & 0xffff0000u)}; }
__device__ __forceinline__ int batch_of(int m) { return m < 16384 ? (m >> 12) : 4 + ((m - 16384) >> 13); }

#ifdef P1_NOCLASS
#define P1DR(x) lr
#else
#define P1DR(x) (x)
#endif
struct P1Order {
    int chunk, G, c;
    __device__ __forceinline__ bool next(int i, Unit& u) const {
        const int nwg = chunk == 0 ? 2432 : 2304, nN = chunk == 0 ? 38 : 36; const long L = (long)i * G + c; if (L >= nwg + (chunk == 0 ? 128 : 0)) return false;
        if (L >= nwg) { const int t = (int)L - nwg, x = t & 7, s = t >> 3; u.pm = 64 + 8 * x + (s & 7); u.pn = 30 + (s >> 3); return true; }
        int wgid = (int)L; { const int q = nwg / NXCD, xcd = wgid % NXCD, off = wgid / NXCD; const int rot = ((xcd >> 1) * (q >> 2)) & ~7;
            const int o2 = (off + rot) % q; wgid = xcd * q + ((xcd & 1) ? q - 1 - o2 : o2); }
        const int nig = WGM * nN, fm = (wgid / nig) * WGM; int pn = (wgid % nig) / WGM; if (chunk == 1 && pn >= 30) pn += 2;
        u.pm = fm + ((wgid % nig) % WGM); u.pn = pn; return true;
    }
    __device__ __forceinline__ void a_ready(const Unit&) const {}
    __device__ __forceinline__ void done(const Unit&) const {}
};
constexpr size_t GTX_OFF = ((size_t)(420 - 282) << 20) / 2;
struct EpiProj {
    static constexpr bool PERM = true, AFTER_DRAIN = false, INIT = false, MIDFIX = false, APERM = true;
    __device__ __forceinline__ size_t bt_off(const Unit&) const { return 0; } __device__ __forceinline__ ptrdiff_t a_off(const Unit&) const { return 0; }
    __device__ __forceinline__ int a_lgr(const Unit& u) const { return (u.pn >= 12 && u.pn < 30) ? 2 * ((u.pn - 12) / 6) : 0; }
#define P1ROW(ai, m) (u.pm * BM + (lgr ? ((((ai) * HALF + wr * 64 + (m) * 16 + fr) >> (8 - lgr)) + ((((ai) * HALF + wr * 64 + (m) * 16 + fr) & ((1 << (8 - lgr)) - 1)) << lgr)) : ((ai) * HALF + wr * 64 + (m) * 16 + fr)))
    bf16_t *QK, *VA, *DIL, *GT; const PG8_LAS float* gl; int S, lgS;
    __device__ __forceinline__ void operator()(const f32x4 (&acc)[2][2][4][2], const Unit& u, int wr, int wc, int fr_in, int fq) const {
        int fr = fr_in; asm volatile("" : "+v"(fr));
        const int pn = u.pn, lrb = (u.pm & 63) * BM + wr * 64 + fr;
        int kind, lgr = 0; bf16_t* dst; const PG8_LAS float* gain = gl;
        if (pn < 8) { const int which = pn >> 1, head = (pn & 1) * 4 + wc; kind = 0; gain = gl + (which < 2 ? 0 : 64); dst = QK + (size_t)(which * 8 + head) * ((size_t)CH * 64); }
        else if (pn < 12) { const int head = (pn - 8) * 2 + (wc >> 1); kind = 1; dst = VA + (size_t)head * ((size_t)CH * 128) + (2 * (wc & 1)) * 2048 + 8 * fq; }
        else if (pn < 30) { const int idx = pn - 12, g = idx / 6, part = (idx % 6) >> 1, head = (idx & 1) * 4 + wc; lgr = 2 * g;
            dst = DIL + (size_t)((g * 3 + part) * 8 + head) * ((size_t)CH * 64);
            if (part < 2) { kind = 0; gain = gl + (part == 0 ? 128 : 320) + 64 * g; } else { kind = 2; dst += 8 * fq; } }
        else { kind = 3; dst = GT + (u.pm >= 64 ? GTX_OFF : (size_t)0) + (size_t)((pn - 30) * 16 + 4 * wc + fq) * 512; }
        const int Sm = S - 1, rm = (1 << lgr) - 1, lsh = lgS - lgr;
        if (kind == 0) {
            f32x4 gv[2][2];
#pragma unroll
            for (int bj = 0; bj < 2; ++bj)
#pragma unroll
                for (int n = 0; n < 2; ++n) gv[bj][n] = *(const PG8_LAS f32x4*)(gain + 32 * bj + 8 * fq + 4 * n);
#pragma unroll
            for (int ai = 0; ai < 2; ++ai)
#pragma unroll
                for (int m = 0; m < 4; ++m) {
                    const int lr = P1ROW(ai, m), t = lr & Sm, dr = P1DR((lr & ~Sm) + ((t & rm) << lsh) + (t >> lgr));
                    float ss = 0.f;
#pragma unroll
                    for (int bj = 0; bj < 2; ++bj)
#pragma unroll
                        for (int n = 0; n < 2; ++n) { const f32x4 x = acc[ai][bj][m][n]; ss += (x[0] * x[0] + x[1] * x[1]) + (x[2] * x[2] + x[3] * x[3]); }
                    ss += swz_xor<16>(ss); ss = add_x32(ss);
                    const float rs = __builtin_amdgcn_rsqf(ss * (1.0f / 64.0f) + 1e-6f);
                    bf16_t* rowp = dst + (size_t)(dr >> 6) * 4096 + fq * 512 + (dr & 63) * 8;
#pragma unroll
                    for (int bj = 0; bj < 2; ++bj) EPI_ST(u32x4, (rowp + bj * 2048), pack8(acc[ai][bj][m][0] * rs * gv[bj][0], acc[ai][bj][m][1] * rs * gv[bj][1]));
                }
        } else if (kind == 1) {
#pragma unroll
            for (int ai = 0; ai < 2; ++ai)
#pragma unroll
                for (int m = 0; m < 4; ++m) {
                    const int lr = lrb + ai * HALF + m * 16;
                    bf16_t* rowp = dst + (size_t)(lr >> 6) * 8192 + ((lr & 63) >> 4) * 512 + (lr & 15) * 32;
#pragma unroll
                    for (int bj = 0; bj < 2; ++bj) EPI_ST(u32x4, (rowp + bj * 2048), pack8(acc[ai][bj][m][0], acc[ai][bj][m][1]));
                }
        } else if (kind == 2) {
#pragma unroll
            for (int ai = 0; ai < 2; ++ai)
#pragma unroll
                for (int m = 0; m < 4; ++m) {
                    const int lr = P1ROW(ai, m), t = lr & Sm, dr = P1DR((lr & ~Sm) + ((t & rm) << lsh) + (t >> lgr));
                    const int hi8 = (fr >> 3) & 1;
                    const u32x4 w0 = pack8(acc[ai][0][m][0], acc[ai][0][m][1]), w1 = pack8(acc[ai][1][m][0], acc[ai][1][m][1]), snd = hi8 ? w0 : w1;
                    u32x4 rcv; rcv.x = (unsigned)__builtin_amdgcn_mov_dpp((int)snd.x, 0x128, 0xF, 0xF, true); rcv.y = (unsigned)__builtin_amdgcn_mov_dpp((int)snd.y, 0x128, 0xF, 0xF, true);
                    rcv.z = (unsigned)__builtin_amdgcn_mov_dpp((int)snd.z, 0x128, 0xF, 0xF, true); rcv.w = (unsigned)__builtin_amdgcn_mov_dpp((int)snd.w, 0x128, 0xF, 0xF, true);
                    bf16_t* rowp = dst + (size_t)(dr - 8 * hi8) * 64 + 32 * hi8;
                    EPI_ST(u32x4, rowp, (hi8 ? rcv : w0));
                    EPI_ST(u32x4, (rowp + 8 * 64), (hi8 ? w1 : rcv));
                }
        } else {
#pragma unroll
            for (int ai = 0; ai < 2; ++ai)
#pragma unroll
                for (int m = 0; m < 4; ++m) {
                    const int lr = lrb + ai * HALF + m * 16;
                    bf16_t* rowp = dst + (size_t)(lr >> 6) * (128 * 512) + (lr & 63) * 8;
                    f32x4 r0, r1, s0, s1;
#pragma unroll
                    for (int i = 0; i < 4; ++i) {
                        const float ea0 = __builtin_amdgcn_exp2f(fminf(-1.4426950408889634f * acc[ai][0][m][0][i], 64.f)), ea1 = __builtin_amdgcn_exp2f(fminf(-1.4426950408889634f * acc[ai][0][m][1][i], 64.f));
                        const float eb0 = __builtin_amdgcn_exp2f(fminf(-1.4426950408889634f * acc[ai][1][m][0][i], 64.f)), eb1 = __builtin_amdgcn_exp2f(fminf(-1.4426950408889634f * acc[ai][1][m][1][i], 64.f));
                        s0[i] = __builtin_amdgcn_rcpf(1.0f + eb0); s1[i] = __builtin_amdgcn_rcpf(1.0f + eb1);
                        r0[i] = (1.0f + eb0) * __builtin_amdgcn_rcpf(1.0f + ea0); r1[i] = (1.0f + eb1) * __builtin_amdgcn_rcpf(1.0f + ea1); }
                    EPI_ST(u32x4, rowp, pack8(r0, r1));
                    EPI_ST(u32x4, (rowp + (size_t)CH * 1024), pack8(s0, s1));
                }
        }
    }
};
struct EpiBrC {
    static constexpr bool PERM = true, AFTER_DRAIN = false, INIT = false, MIDFIX = true, APERM = false;
    bf16_t* MG; const bf16_t* GR0; const bf16_t* GS0; const bf16_t* GR1; const bf16_t* GS1; ptrdiff_t aoff1; int fix_t;
    __device__ __forceinline__ size_t bt_off(const Unit&) const { return 0; }
    __device__ __forceinline__ ptrdiff_t a_off(const Unit& u) const { return u.pm >= 64 ? aoff1 : 0; }
    __device__ __forceinline__ void midfix(f32x4 (&acc)[2][2][4][2], const Unit& u, int wr, int wc, int fr_in, int fq) const {
        int fr = fr_in; asm volatile("" : "+v"(fr));
        const int row0 = (u.pm & 63) * BM + wr * 64 + fr, col0 = u.pn * BM + wc * 32 + 8 * fq; const bf16_t* GR = u.pm >= 64 ? GR1 : GR0;
        u32x4 gr[2][4][2];
#pragma unroll
        for (int ai = 0; ai < 2; ++ai)
#pragma unroll
            for (int m = 0; m < 4; ++m) { const int lr = row0 + ai * HALF + m * 16;
                const bf16_t* gp = GR + (size_t)(lr >> 6) * (128 * 512) + (size_t)(col0 >> 3) * 512 + (lr & 63) * 8;
#pragma unroll
                for (int bj = 0; bj < 2; ++bj) gr[ai][m][bj] = *(const u32x4*)(gp + bj * (16 * 512)); }
#pragma unroll
        for (int ai = 0; ai < 2; ++ai)
#pragma unroll
            for (int m = 0; m < 4; ++m)
#pragma unroll
                for (int bj = 0; bj < 2; ++bj) { acc[ai][bj][m][0] *= bf4lo(gr[ai][m][bj]); acc[ai][bj][m][1] *= bf4hi(gr[ai][m][bj]); }
    }
    __device__ __forceinline__ void operator()(const f32x4 (&acc)[2][2][4][2], const Unit& u, int wr, int wc, int fr, int fq) const {
        const int row0 = u.pm * BM + wr * 64 + fr, lrow0 = (u.pm & 63) * BM + wr * 64 + fr, col0 = u.pn * BM + wc * 32 + 8 * fq; const bf16_t* GS = u.pm >= 64 ? GS1 : GS0;
#pragma unroll
        for (int ai = 0; ai < 2; ++ai) {
            u32x4 gw[4][2];
#pragma unroll
            for (int m = 0; m < 4; ++m) { const int lr = lrow0 + ai * HALF + m * 16;
                const bf16_t* gp = GS + (size_t)(lr >> 6) * (128 * 512) + (size_t)(col0 >> 3) * 512 + (lr & 63) * 8;
#pragma unroll
                for (int bj = 0; bj < 2; ++bj) gw[m][bj] = *(const u32x4*)(gp + bj * (16 * 512)); }
#pragma unroll
            for (int m = 0; m < 4; ++m) { bf16_t* mp = MG + (size_t)(row0 + ai * HALF + m * 16) * 1024 + col0;
#pragma unroll
                for (int bj = 0; bj < 2; ++bj) EPI_ST(u32x4, (mp + bj * PG8_ABJ), pack8(acc[ai][bj][m][0] * bf4lo(gw[m][bj]), acc[ai][bj][m][1] * bf4hi(gw[m][bj]))); }
        }
    }
};
struct EpiWo {
    static constexpr bool PERM = true, AFTER_DRAIN = false; PG8_EPI_DEFAULTS
    const float *xp, *xs; float* out; bf16_t* A2; const float *mod, *n2g; float* rowss;
    __device__ __forceinline__ void operator()(const f32x4 (&acc)[2][2][4][2], const Unit& u, int wr, int wc, int fr, int fq) const {
        const int m0 = u.pm * BM, b = batch_of(m0), row0 = m0 + wr * 64 + fr, col0 = u.pn * BM + wc * 32 + 8 * fq;
        const float* xb = m0 < 16384 ? xp : xs - (size_t)16384 * 1024;
        const float* g1p = mod + b * 6144 + 2048 + col0; const float* s2p = mod + b * 6144 + 4096 + col0; const float* ngp = n2g + col0;
        f32x4 g1[2][2], gm[2][2];
#pragma unroll
        for (int bj = 0; bj < 2; ++bj)
#pragma unroll
            for (int n = 0; n < 2; ++n) { g1[bj][n] = *(const f32x4*)(g1p + bj * HALF + 4 * n); gm[bj][n] = *(const f32x4*)(ngp + bj * HALF + 4 * n) * (*(const f32x4*)(s2p + bj * HALF + 4 * n) + 1.0f); }
#pragma unroll
        for (int ai = 0; ai < 2; ++ai)
#pragma unroll
          for (int mh = 0; mh < 4; mh += 2) { f32x4 xv[4][2][2];
#pragma unroll
            for (int m = mh; m < mh + 2; ++m)
#pragma unroll
                for (int bj = 0; bj < 2; ++bj) { const float* p = xb + (size_t)(row0 + ai * HALF + m * 16) * 1024 + col0 + bj * HALF; xv[m][bj][0] = *(const f32x4*)p; xv[m][bj][1] = *(const f32x4*)(p + 4); }
#pragma unroll
            for (int m = mh; m < mh + 2; ++m) { const int r = row0 + ai * HALF + m * 16; const size_t off = (size_t)r * 1024 + col0; float ss = 0.f;
#pragma unroll
                for (int bj = 0; bj < 2; ++bj) {
                    const f32x4 y0 = xv[m][bj][0] + g1[bj][0] * acc[ai][bj][m][0], y1 = xv[m][bj][1] + g1[bj][1] * acc[ai][bj][m][1];
                    *(f32x4*)(out + off + bj * HALF) = y0; *(f32x4*)(out + off + bj * HALF + 4) = y1;
                    ss += (y0[0] * y0[0] + y0[1] * y0[1]) + (y0[2] * y0[2] + y0[3] * y0[3]) + (y1[0] * y1[0] + y1[1] * y1[1]) + (y1[2] * y1[2] + y1[3] * y1[3]);
                    EPI_ST(u32x4, (A2 + off + bj * HALF), pack8(y0 * gm[bj][0], y1 * gm[bj][1])); }
                ss += swz_xor<16>(ss); ss = add_x32(ss);
                if (fq == 0) atomicAdd(rowss + r, ss); } }
    }
};
struct EpiUp {
    static constexpr bool PERM = true, AFTER_DRAIN = false; PG8_EPI_DEFAULTS
    bf16_t* H; const float *rowss, *sbias;
    __device__ __forceinline__ static u32x4 swap1(const u32x4& v) {
        u32x4 r; r.x = (unsigned)__builtin_amdgcn_mov_dpp((int)v.x, 0xB1, 0xF, 0xF, true); r.y = (unsigned)__builtin_amdgcn_mov_dpp((int)v.y, 0xB1, 0xF, 0xF, true);
        r.z = (unsigned)__builtin_amdgcn_mov_dpp((int)v.z, 0xB1, 0xF, 0xF, true); r.w = (unsigned)__builtin_amdgcn_mov_dpp((int)v.w, 0xB1, 0xF, 0xF, true); return r; }
    __device__ __forceinline__ void operator()(const f32x4 (&acc)[2][2][4][2], const Unit& u, int wr, int wc, int fr, int fq) const {
        const int m0 = u.pm * BM, b = batch_of(m0), row0 = m0 + wr * 64 + fr, col0 = u.pn * BM + wc * 64 + 8 * fq, odd = fr & 1;
        f32x4 sb[2][2];
#pragma unroll
        for (int bj = 0; bj < 2; ++bj)
#pragma unroll
            for (int n = 0; n < 2; ++n) sb[bj][n] = *(const f32x4*)(sbias + b * 4096 + col0 + bj * 32 + 4 * n);
        float rsv[2][4];
#pragma unroll
        for (int ai = 0; ai < 2; ++ai)
#pragma unroll
            for (int m = 0; m < 4; ++m) rsv[ai][m] = rowss[row0 + ai * HALF + m * 16];
#pragma unroll
        for (int ai = 0; ai < 2; ++ai)
#pragma unroll
            for (int m = 0; m < 4; ++m) { const int r = row0 + ai * HALF + m * 16; const float rs = __builtin_amdgcn_rsqf(rsv[ai][m] * (1.0f / 1024.0f) + 1e-6f);
                u32x4 w[2];
#pragma unroll
                for (int bj = 0; bj < 2; ++bj) { f32x4 v0 = acc[ai][bj][m][0] * rs + sb[bj][0], v1 = acc[ai][bj][m][1] * rs + sb[bj][1];
#pragma unroll
                    for (int i = 0; i < 4; ++i) { v0[i] = fmaxf(v0[i], 0.f); v1[i] = fmaxf(v1[i], 0.f); }
                    w[bj] = pack8(v0 * v0, v1 * v1); }
#ifdef H_TILED
                bf16_t* rowp = H + a_tiled(r, col0, HNBLK);
                EPI_ST(u32x4, rowp, w[0]); EPI_ST(u32x4, (rowp + 512), w[1]); (void)odd; }
#else
                const u32x4 snd = odd ? w[0] : w[1], rcv = swap1(snd);
                bf16_t* rowp = H + (size_t)(r - odd) * LDH + col0 + 32 * odd;
                EPI_ST(u32x4, rowp, (odd ? rcv : w[0]));
                EPI_ST(u32x4, (rowp + LDH), (odd ? w[1] : rcv)); }
#endif
    }
};
struct EpiDown {
    static constexpr bool PERM = false, AFTER_DRAIN = false; PG8_EPI_DEFAULTS
    float* out; const float* mod;
    __device__ __forceinline__ void operator()(const f32x4 (&acc)[2][2][4][2], const Unit& u, int wr, int wc, int fr, int fq) const {
        const int m0 = u.pm * BM, b = batch_of(m0), row0 = m0 + wr * 64 + fr, col0 = u.pn * BM + wc * 32 + 4 * fq;
        const float* g2p = mod + b * 6144 + 5120 + col0;
        f32x4 g2[2][2];
#pragma unroll
        for (int bj = 0; bj < 2; ++bj)
#pragma unroll
            for (int n = 0; n < 2; ++n) g2[bj][n] = *(const f32x4*)(g2p + bj * HALF + 16 * n);
#pragma unroll
        for (int ai = 0; ai < 2; ++ai) { f32x4 ov[4][2][2];
#pragma unroll
            for (int m = 0; m < 4; ++m)
#pragma unroll
                for (int bj = 0; bj < 2; ++bj) { const float* p = out + (size_t)(row0 + ai * HALF + m * 16) * 1024 + col0 + bj * HALF; ov[m][bj][0] = *(const f32x4*)p; ov[m][bj][1] = *(const f32x4*)(p + 16); }
#pragma unroll
            for (int m = 0; m < 4; ++m) { float* rowp = out + (size_t)(row0 + ai * HALF + m * 16) * 1024 + col0;
#pragma unroll
                for (int bj = 0; bj < 2; ++bj) { *(f32x4*)(rowp + bj * HALF) = ov[m][bj][0] + g2[bj][0] * acc[ai][bj][m][0]; *(f32x4*)(rowp + bj * HALF + 16) = ov[m][bj][1] + g2[bj][1] * acc[ai][bj][m][1]; } } }
    }
};
}
namespace att {
#define LASC __attribute__((address_space(3)))
typedef unsigned short bf16;
typedef short bf16x8 __attribute__((ext_vector_type(8)));
typedef short s16x4 __attribute__((ext_vector_type(4)));
typedef short v4i16_t __attribute__((ext_vector_type(4)));
typedef float f32x16 __attribute__((ext_vector_type(16)));
typedef float f32x4 __attribute__((ext_vector_type(4)));
typedef unsigned u32x4 __attribute__((ext_vector_type(4)));
typedef float f32x2_t __attribute__((ext_vector_type(2))); typedef __bf16 bf16x2_t __attribute__((ext_vector_type(2)));
constexpr int CH = 16384;
constexpr float LOG2E = 1.4426950408889634f;
__device__ __forceinline__ int crow(int r, int hi) { return (r & 3) + 8 * (r >> 2) + 4 * hi; }
__device__ __forceinline__ unsigned cvtpk(float lo, float hi) { f32x2_t v = {lo, hi}; bf16x2_t b = __builtin_convertvector(v, bf16x2_t); return __builtin_bit_cast(unsigned, b); }
__device__ __forceinline__ s16x4 vtr(const LASC unsigned char* p) { return __builtin_bit_cast(s16x4, __builtin_amdgcn_ds_read_tr16_b64_v4i16((LASC v4i16_t*)p)); }
#ifndef BK_SH
#define BK_SH 0
#endif
__device__ __forceinline__ int rel_bucket(int rel) {
    const int n = rel < 0 ? -rel : rel; const int ret = rel > 0 ? 16 : 0;
    int v;
    if (n < 8) v = n; else if (n < 12) v = 8; else if (n < 16 + BK_SH) v = 9; else if (n < 23) v = 10; else if (n < 32 + BK_SH) v = 11; else if (n < 46) v = 12; else if (n < 64 + BK_SH) v = 13; else if (n < 91) v = 14; else v = 15;
    return ret + v;
}
__device__ __forceinline__ bf16x8 pack_frag(const f32x16& p, int base) {
    u32x4 w; w.x = cvtpk(p[base], p[base + 1]); w.y = cvtpk(p[base + 2], p[base + 3]); w.z = cvtpk(p[base + 4], p[base + 5]); w.w = cvtpk(p[base + 6], p[base + 7]);
    return __builtin_bit_cast(bf16x8, w);
}
constexpr int DA_K = 0, DA_V = 32768;
constexpr int DA_Q = 81920;
constexpr int DA_BT = 147456;
constexpr int DA_WS = 149504;
constexpr int SC_OFF = 155648;
constexpr int DL_VS = 136192;
constexpr int DL_N = 0, DL_D = 131072, DL_T = 131072 + 2048;

__device__ __forceinline__ void da_epilogue(LASC unsigned char* lds, bf16* YA, const float* subln_g, f32x16 (&o1)[4], f32x16 (&o2)[4], float l1, float l2, float lam, int head, int tile0, int qb, int wid);
#define SBAR() __builtin_amdgcn_sched_barrier(0)
__device__ __forceinline__ int lane_now() { int l; asm volatile("v_mbcnt_lo_u32_b32 %0, -1, 0\n\tv_mbcnt_hi_u32_b32 %0, -1, %0" : "=v"(l)); return l; }
__device__ __forceinline__ void da_unit(LASC unsigned char* lds, const bf16* QK, const bf16* VA, bf16* YA, const float* rel_bias, const float* subln_g,
                                        int head, int tile0, int NT, int qb, int tid_in, float* tprobe = nullptr) {
    int tid = tid_in; asm volatile("" : "+v"(tid));
    const int lane = tid & 63, r32 = lane & 31, hi = lane >> 5; const int wid = __builtin_amdgcn_readfirstlane(tid >> 6);
    LASC float* BT = (LASC float*)(lds + DA_BT); const LASC float* SC = (const LASC float*)(lds + SC_OFF);
    const float lam = __builtin_bit_cast(float, __builtin_amdgcn_readfirstlane(__builtin_bit_cast(int, SC[0])));
    if (tid < 448) { const int rel = tid - 224; BT[tid] = rel_bias[rel_bucket(rel) * 32 + head] * LOG2E; }
    const bf16* Q1h = QK + (size_t)(0 * 8 + head) * ((size_t)CH * 64); const bf16* Q2h = QK + (size_t)(1 * 8 + head) * ((size_t)CH * 64);
    const bf16* K1h = QK + (size_t)(2 * 8 + head) * ((size_t)CH * 64) + (size_t)tile0 * 4096; const bf16* K2h = QK + (size_t)(3 * 8 + head) * ((size_t)CH * 64) + (size_t)tile0 * 4096;
    const bf16* Vh = VA + (size_t)head * ((size_t)CH * 128) + (size_t)tile0 * 8192;
#define DA_GLDS(SRC, DST) do { unsigned keep_; const unsigned dst_ = (unsigned)__builtin_amdgcn_readfirstlane((int)(unsigned)(uintptr_t)(DST)); \
        asm volatile("s_mov_b32 %0, m0\n\ts_mov_b32 m0, %2\n\ts_nop 0\n\tglobal_load_lds_dwordx4 %1, off\n\ts_mov_b32 m0, %0" : "=&s"(keep_) : "v"(SRC), "s"(dst_) : "memory"); } while (0)
#define DA_DMA1(t, pc) do { LASC unsigned char* dk_ = lds + DA_K + ((t) & 1) * 16384 + (pc) * 1024; LASC unsigned char* dv_ = lds + DA_V + ((t) % 3) * 16384 + (pc) * 1024; \
        const char* k1_ = (const char*)K1h + (size_t)(t) * 8192 + (pc) * 1024; const char* k2_ = (const char*)K2h + (size_t)(t) * 8192 + (pc) * 1024; const char* v_ = (const char*)Vh + (size_t)(t) * 16384 + (pc) * 1024;     \
        DA_GLDS(k1_ + lo_, dk_); DA_GLDS(k2_ + lo_, dk_ + 8192); DA_GLDS(v_ + lo_, dv_); DA_GLDS(v_ + 8192 + lo_, dv_ + 8192); } while (0)
#ifndef DA_DMA_ALL
#define DA_DMA(t) do { if (wid < 4) { const unsigned lo_ = (unsigned)lane_now() * 16u; DA_DMA1(t, wid); DA_DMA1(t, wid + 4); } } while (0)
#else
#define DA_DMA(t) do { const unsigned lo_ = (unsigned)lane_now() * 16u; DA_DMA1(t, wid); } while (0)
#endif
    DA_DMA(0);
    bf16x8 q1f[4], q2f[4];
    { const int tq = tile0 + 4 * qb + (wid >> 1), rq = (wid & 1) * 32 + r32;
#pragma unroll
      for (int ks = 0; ks < 4; ++ks) { q1f[ks] = *(const bf16x8*)(Q1h + (size_t)tq * 4096 + (2 * ks + hi) * 512 + rq * 8); q2f[ks] = *(const bf16x8*)(Q2h + (size_t)tq * 4096 + (2 * ks + hi) * 512 + rq * 8); } }
#pragma unroll
    for (int ks = 0; ks < 4; ++ks) asm volatile("" : "+v"(q1f[ks]), "+v"(q2f[ks]));
    f32x16 o1[4], o2[4];
#pragma unroll
    for (int d = 0; d < 4; ++d) { o1[d] = f32x16{}; o2[d] = f32x16{}; }
    float l1 = 0.f, l2 = 0.f;
    asm volatile("s_waitcnt vmcnt(0)" ::: "memory");
    __syncthreads();
    const int qw0 = 256 * qb + 32 * wid;
    const int tL = (qw0 >= 191) ? ((qw0 - 191) >> 6) : -1, tR = (qw0 + 159 + 63) >> 6;
    const float fLN = __builtin_bit_cast(float, __builtin_amdgcn_readfirstlane(__builtin_bit_cast(int, __builtin_amdgcn_exp2f(BT[0])))), fNR = __builtin_bit_cast(float, __builtin_amdgcn_readfirstlane(__builtin_bit_cast(int, __builtin_amdgcn_exp2f(-BT[447]))));
    bf16x8 paA1[2], paA2[2], paB1[2], paB2[2];
#pragma unroll
    for (int i = 0; i < 2; ++i) { paB1[i] = bf16x8{}; paB2[i] = bf16x8{}; }
#define DA_NEARC(S_, HALF_) do { const int lnn_ = lane_now(); const LASC float* bt_ = BT + (64 * t + 32 * (HALF_) - (qw0 + (lnn_ & 31)) + 4 * (lnn_ >> 5) + 224); \
        { unsigned bti_ = (unsigned)(uintptr_t)bt_; asm volatile("" : "+v"(bti_)); bt_ = (const LASC float*)(uintptr_t)bti_; }     \
        _Pragma("unroll") for (int r = 0; r < 16; ++r) S_[r] = bt_[(r & 3) + 8 * (r >> 2)]; } while (0)
#define DA_VRD(DST, F_) do { const s16x4 lo_ = vtr(vp + ((F_) >> 1) * 4096 + ((F_) & 1) * 1024), hh_ = vtr(vp + ((F_) >> 1) * 4096 + ((F_) & 1) * 1024 + 512); DST = (bf16x8){lo_[0], lo_[1], lo_[2], lo_[3], hh_[0], hh_[1], hh_[2], hh_[3]}; } while (0)
#ifdef DA_XMFMA
#define DA_XM() do { f32x16 sx_ = __builtin_amdgcn_mfma_f32_32x32x16_bf16(kfB[0], qfB[0], (f32x16){}, 0, 0, 0); _Pragma("unroll") for (int xk = 1; xk < DA_XMFMA; ++xk) sx_ = __builtin_amdgcn_mfma_f32_32x32x16_bf16(kfB[xk & 3], qfB[xk & 3], sx_, 0, 0, 0); asm volatile("" :: "v"(sx_)); } while (0)
#else
#define DA_XM() do {} while (0)
#endif
#ifdef DA_XVALU
#define DA_XV(g) do { float x0_ = __builtin_amdgcn_exp2f(s2[(g)] * 0.5f), x1_ = __builtin_amdgcn_exp2f(s2[(g)] * 0.25f); asm volatile("" :: "v"(x0_), "v"(x1_)); } while (0)
#else
#define DA_XV(g) do {} while (0)
#endif
#define DA_STEP(KS, HALF, VP, PI1, PI2, PO1, PO2) do { \
        f32x16 s1, s2; const LASC unsigned char* vp; const LASC unsigned char* kb; \
        { kb = (KS) + klane_ + (HALF) * 512; vp = (VP) + vlane_; \
          { unsigned vpi_ = (unsigned)(uintptr_t)vp; asm volatile("" : "+v"(vpi_)); vp = (const LASC unsigned char*)(uintptr_t)vpi_; } }     \
        { bf16x8 kf[4]; \
          _Pragma("unroll") for (int ks = 0; ks < 4; ++ks) kf[ks] = *(const LASC bf16x8*)(kb + ks * 2048); \
          if (near) { DA_NEARC(s1, HALF); s1 = __builtin_amdgcn_mfma_f32_32x32x16_bf16(kf[0], q1f[0], s1, 0, 0, 0); } \
          else s1 = __builtin_amdgcn_mfma_f32_32x32x16_bf16(kf[0], q1f[0], (f32x16){}, 0, 0, 0); \
          _Pragma("unroll") for (int ks = 1; ks < 4; ++ks) s1 = __builtin_amdgcn_mfma_f32_32x32x16_bf16(kf[ks], q1f[ks], s1, 0, 0, 0); \
          SBAR(); \
          _Pragma("unroll") for (int ks = 0; ks < 4; ++ks) kf[ks] = *(const LASC bf16x8*)(kb + 8192 + ks * 2048); \
          DA_VRD(vf[0], 0); \
          if (near) { DA_NEARC(s2, HALF); s2 = __builtin_amdgcn_mfma_f32_32x32x16_bf16(kf[0], q2f[0], s2, 0, 0, 0); } \
          else s2 = __builtin_amdgcn_mfma_f32_32x32x16_bf16(kf[0], q2f[0], (f32x16){}, 0, 0, 0); \
          _Pragma("unroll") for (int ks = 1; ks < 4; ++ks) s2 = __builtin_amdgcn_mfma_f32_32x32x16_bf16(kf[ks], q2f[ks], s2, 0, 0, 0); DA_XM(); } \
        SBAR(); \
        { float sa = 0.f, sb = 0.f; u32x4 w1a, w1b, w2a, w2b; float pe0 = 0.f, pe1 = 0.f; \
            \
            \
          _Pragma("unroll") for (int g = 0; g < 16; ++g) { const int f = g >> 1, d0 = f >> 1, ks = f & 1, sm = g & 1; \
              if (sm == 0) { if (f + 1 < 8) DA_VRD(vf[(f + 1) & 1], f + 1); o1[d0] = __builtin_amdgcn_mfma_f32_32x32x16_bf16(PI1[ks], vf[f & 1], o1[d0], 0, 0, 0); } \
              else o2[d0] = __builtin_amdgcn_mfma_f32_32x32x16_bf16(PI2[ks], vf[f & 1], o2[d0], 0, 0, 0); \
              DA_XV(g); \
              const float e0 = __builtin_amdgcn_exp2f(g < 8 ? s1[2 * (g & 7)] : s2[2 * (g & 7)]), e1 = __builtin_amdgcn_exp2f(g < 8 ? s1[2 * (g & 7) + 1] : s2[2 * (g & 7) + 1]); \
              if (g > 0) { const int h = g - 1; unsigned w = cvtpk(pe0, pe1); \
                  if (h < 8) { sa += pe0; sa += pe1; asm volatile("" : "+v"(w), "+v"(sa)); if (h < 4) w1a[h & 3] = w; else w1b[h & 3] = w; } \
                  else { sb += pe0; sb += pe1; asm volatile("" : "+v"(w), "+v"(sb)); if (h < 12) w2a[h & 3] = w; else w2b[h & 3] = w; } } \
              pe0 = e0; pe1 = e1; asm volatile("" : "+v"(pe0), "+v"(pe1)); \
              SBAR(); } \
          { unsigned w = cvtpk(pe0, pe1); sb += pe0; sb += pe1; w2b[3] = w; } \
          l1 += sa; l2 += sb; \
          PO1[0] = __builtin_bit_cast(bf16x8, w1a); PO1[1] = __builtin_bit_cast(bf16x8, w1b); PO2[0] = __builtin_bit_cast(bf16x8, w2a); PO2[1] = __builtin_bit_cast(bf16x8, w2b); } \
    } while (0)
    bf16x8 vf[2];
    unsigned klane_ = (unsigned)(hi * 1024 + r32 * 16), vlane_ = (unsigned)(((lane >> 4) & 1) * 32 + (lane & 3) * 8 + (4 * hi + ((lane & 15) >> 2)) * 64);
    asm volatile("" : "+v"(klane_), "+v"(vlane_));
#ifdef TMODE
    const unsigned long long tm0_ = __builtin_amdgcn_s_memtime(), tr0_ = __builtin_amdgcn_s_memrealtime();
#endif
#ifdef DA_PRIO
    if (wid >= 4) __builtin_amdgcn_s_setprio(DA_PRIO);
#endif
    for (int t = 0; t < NT; ++t) {
        if (t + 1 < NT) DA_DMA(t + 1);
        const bool near = (t > tL) && (t < tR);
        const bool trans = (t == tL + 1 && tL >= 0) || (t == tR);
        const float f = (t == tR) ? fNR : fLN;
        const LASC unsigned char* ks_ = lds + DA_K + (t & 1) * 16384;
        const int tp = t > 0 ? t - 1 : 0;
        const LASC unsigned char* vprev = lds + DA_V + (tp % 3) * 16384 + (t > 0 ? 2048 : 0);
        const LASC unsigned char* vcur = lds + DA_V + (t % 3) * 16384;
        if (trans) { l1 *= f; l2 *= f; }
        DA_STEP(ks_, 0, vprev, paB1, paB2, paA1, paA2);
        if (trans) {
#pragma unroll
            for (int d = 0; d < 4; ++d) { o1[d] *= f; o2[d] *= f; } }
#ifdef DA_XBAR
        __syncthreads();
#endif
        DA_STEP(ks_, 1, vcur, paA1, paA2, paB1, paB2);
        asm volatile("s_waitcnt vmcnt(0)" ::: "memory");
        __syncthreads();
    }
    { const int ln_ = lane_now(); const LASC unsigned char* vp = lds + DA_V + ((NT - 1) % 3) * 16384 + 2048 + ((ln_ >> 4) & 1) * 32 + (ln_ & 3) * 8 + (4 * (ln_ >> 5) + ((ln_ & 15) >> 2)) * 64;
#pragma unroll
      for (int d0 = 0; d0 < 4; ++d0)
#pragma unroll
          for (int ks = 0; ks < 2; ++ks) { const s16x4 lo = vtr(vp + d0 * 4096 + ks * 1024), hh = vtr(vp + d0 * 4096 + ks * 1024 + 512); const bf16x8 vf = (bf16x8){lo[0], lo[1], lo[2], lo[3], hh[0], hh[1], hh[2], hh[3]};
              o1[d0] = __builtin_amdgcn_mfma_f32_32x32x16_bf16(paB1[ks], vf, o1[d0], 0, 0, 0); o2[d0] = __builtin_amdgcn_mfma_f32_32x32x16_bf16(paB2[ks], vf, o2[d0], 0, 0, 0); } }
#ifdef DA_PRIO
    __builtin_amdgcn_s_setprio(0);
#endif
#ifdef TMODE
    { const unsigned long long tm1_ = __builtin_amdgcn_s_memtime(), tr1_ = __builtin_amdgcn_s_memrealtime(); if (tprobe && tid == 0) { tprobe[0] = (float)(tm1_ - tm0_) / (float)NT; tprobe[1] = (float)(tr1_ - tr0_) * 10.0f / (float)NT; } }
#endif
    __syncthreads();
#undef DA_DMA
#undef DA_DMA1
#undef DA_GLDS
#undef DA_STEP
#undef DA_NEARC
#undef DA_VRD
    da_epilogue(lds, YA, subln_g, o1, o2, l1, l2, lam, head, tile0, qb, wid);
}
__device__ __forceinline__ void da_epilogue(LASC unsigned char* lds, bf16* YA, const float* subln_g, f32x16 (&o1)[4], f32x16 (&o2)[4], float l1, float l2, float lam, int head, int tile0, int qb, int wid) {
    const int lane = lane_now(), r32 = lane & 31, hi = lane >> 5;
    LASC float* wsf = (LASC float*)(lds + DA_WS) + wid * 128;
    l1 = add_x32(l1); l2 = add_x32(l2);
    if (hi == 0) { wsf[r32] = l1; wsf[32 + r32] = l2; }
    asm volatile("s_waitcnt lgkmcnt(0)" ::: "memory");
    float sg[4];
#pragma unroll
    for (int d0 = 0; d0 < 4; ++d0) sg[d0] = subln_g[32 * d0 + r32] * 0.8f;
    LASC bf16* stg = (LASC bf16*)(lds + wid * 8192);
#pragma unroll
    for (int r = 0; r < 16; ++r) {
        const int row = crow(r, hi); const float i1 = __builtin_amdgcn_rcpf(wsf[row]), i2 = lam * __builtin_amdgcn_rcpf(wsf[32 + row]);
        float v[4]; float ss = 0.f;
#pragma unroll
        for (int d0 = 0; d0 < 4; ++d0) { v[d0] = o1[d0][r] * i1 - o2[d0][r] * i2; ss += v[d0] * v[d0]; }
        ss += swz_xor<1>(ss); ss += swz_xor<2>(ss); ss += swz_xor<4>(ss); ss += swz_xor<8>(ss); ss += swz_xor<16>(ss);
        const float rs = __builtin_amdgcn_rsqf(ss * (1.0f / 128.0f) + 1e-6f);
#pragma unroll
        for (int d0 = 0; d0 < 4; ++d0) stg[row * 128 + d0 * 32 + r32] = (bf16)(cvtpk(v[d0] * rs * sg[d0], 0.f) & 0xffffu);
    }
    asm volatile("s_waitcnt lgkmcnt(0)" ::: "memory");
    { bf16* Yw = YA + (size_t)((tile0 + 4 * qb) * 64 + wid * 32) * 1536 + head * 128;
#pragma unroll
      for (int i = 0; i < 8; ++i) { const int row = i * 4 + (lane >> 4), ch = lane & 15; const u32x4 v = *(const LASC u32x4*)(stg + row * 128 + ch * 8); *(u32x4*)(Yw + (size_t)row * 1536 + ch * 8) = v; } }
    __syncthreads();
}

template <bool PRE, bool ACC> __device__ __forceinline__ void dil_task(const bf16* Qh, const bf16* Kh, const bf16* Vh, int drq0, int lq0, int L, int r, int tok_base, const LASC float* DBT, LASC float* Nsum, LASC float* Dsum, LASC unsigned char* vst, int lane) {
    const int r32 = lane & 31, hi = lane >> 5;
    bf16x8 qf[4];
#pragma unroll
    for (int ks = 0; ks < 4; ++ks) qf[ks] = *(const bf16x8*)(Qh + (size_t)(drq0 >> 6) * 4096 + (2 * ks + hi) * 512 + ((drq0 & 63) + r32) * 8);
    f32x16 o[2]; o[0] = f32x16{}; o[1] = f32x16{}; float l = 0.f;
    const int vrow = lane >> 3, vch = lane & 7;
    LASC unsigned char* vw = vst + (vch >> 2) * 1024 + vrow * 64 + (vch & 3) * 16;
    const LASC unsigned char* vr = vst + ((lane >> 4) & 1) * 32 + (lane & 3) * 8 + (4 * hi + ((lane & 15) >> 2)) * 64;
    bf16x8 kc[4], kn[4]; u32x4 vc[4], vn[4];
#define DIL_LOAD(KD, VD, S5) do { const int lk_ = lq0 - 64 + 32 * (S5); const int lc_ = min(max(lk_, 0), L - 32); const int dk_ = drq0 + (lc_ - lq0); \
        _Pragma("unroll") for (int ks = 0; ks < 4; ++ks) KD[ks] = *(const bf16x8*)(Kh + (size_t)(dk_ >> 6) * 4096 + (2 * ks + hi) * 512 + ((dk_ & 63) + r32) * 8); \
        const bf16* vg_ = Vh + (size_t)(dk_ + vrow) * 64 + vch * 8; \
        _Pragma("unroll") for (int i = 0; i < 4; ++i) VD[i] = *(const u32x4*)(vg_ + i * 8 * 64); } while (0)
    DIL_LOAD(kc, vc, 0);
#pragma unroll
    for (int s5 = 0; s5 < 5; ++s5) {
        if (s5 + 1 < 5) DIL_LOAD(kn, vn, s5 + 1);
        const int lk0 = lq0 - 64 + 32 * s5;
        if (lk0 >= 0 && lk0 < L) {
            const int jb = lk0 - lq0 - r32 + 4 * hi + 96;
            f32x16 p;
#pragma unroll
            for (int rg = 0; rg < 16; ++rg) p[rg] = DBT[jb + (rg & 3) + 8 * (rg >> 2)];
#pragma unroll
            for (int ks = 0; ks < 4; ++ks) p = __builtin_amdgcn_mfma_f32_32x32x16_bf16(kc[ks], qf[ks], p, 0, 0, 0);
            float s = 0.f;
#pragma unroll
            for (int rg = 0; rg < 16; ++rg) { p[rg] = __builtin_amdgcn_exp2f(p[rg]); s += p[rg]; }
            l += s;
            const bf16x8 pa0 = pack_frag(p, 0), pa1 = pack_frag(p, 8);
#pragma unroll
            for (int ss = 0; ss < 2; ++ss) {
                *(LASC u32x4*)(vw) = vc[2 * ss]; *(LASC u32x4*)(vw + 512) = vc[2 * ss + 1];
#pragma unroll
                for (int db = 0; db < 2; ++db) { const s16x4 lo = vtr(vr + db * 1024), hh = vtr(vr + db * 1024 + 512); const bf16x8 vf = (bf16x8){lo[0], lo[1], lo[2], lo[3], hh[0], hh[1], hh[2], hh[3]};
                    o[db] = __builtin_amdgcn_mfma_f32_32x32x16_bf16(ss == 0 ? pa0 : pa1, vf, o[db], 0, 0, 0); }
            }
        }
        if (s5 + 1 < 5) {
#pragma unroll
            for (int i = 0; i < 4; ++i) { kc[i] = kn[i]; vc[i] = vn[i]; } }
    }
#undef DIL_LOAD
    l = add_x32(l);
    if (hi == 0) { LASC float* dp = Dsum + tok_base + r32 * r; *dp = ACC ? *dp + l : l; }
#pragma unroll
    for (int db = 0; db < 2; ++db)
#pragma unroll
        for (int rg = 0; rg < 16; ++rg) { LASC float* np = Nsum + (tok_base + crow(rg, hi) * r) * 64 + 32 * db + r32; *np = ACC ? *np + o[db][rg] : o[db][rg]; }
}
template <bool PRE> __device__ __forceinline__ void dil_unit(LASC unsigned char* lds, const bf16* DIL, bf16* YB, const float* rel_bias, int head, int span, int S, int lgS, int tid_in) {
    int tid = tid_in; asm volatile("" : "+v"(tid));
    const int lane = tid & 63; const int wid = __builtin_amdgcn_readfirstlane(tid >> 6);
    LASC float* Nsum = (LASC float*)(lds + DL_N); LASC float* Dsum = (LASC float*)(lds + DL_D); LASC float* DBT = (LASC float*)(lds + DL_T); const LASC float* SC = (const LASC float*)(lds + SC_OFF);
    const float M2 = SC[2];
#ifdef DIL_DELAY
    for (int dd_ = 0; dd_ < DIL_DELAY; ++dd_) __builtin_amdgcn_s_sleep(127);
#endif
    for (int i = tid; i < 600; i += 512) { const int g = i / 200, j = i % 200 - 96; const int aj = j < 0 ? -j : j;
        DBT[i] = (aj <= 64) ? rel_bias[rel_bucket(j * (1 << (2 * g))) * 32 + 8 + 8 * g + head] * LOG2E - M2 : -1e30f; }
    __syncthreads();
    const int row0 = span * 512, seqbase = row0 & ~(S - 1), t0 = row0 & (S - 1);
#pragma unroll
    for (int g = 0; g < 3; ++g) {
        const int lgr = 2 * g, r = 1 << lgr, L = S >> lgr, nblk = 16 >> lgr;
        const bf16* Qh = DIL + (size_t)((g * 3 + 0) * 8 + head) * ((size_t)CH * 64); const bf16* Kh = DIL + (size_t)((g * 3 + 1) * 8 + head) * ((size_t)CH * 64); const bf16* Vh = DIL + (size_t)((g * 3 + 2) * 8 + head) * ((size_t)CH * 64);
        for (int j = wid; j < 16; j += 8) { const int cl = j / nblk, blk = j % nblk, lq0 = (t0 >> lgr) + 32 * blk;
            if (g == 0) dil_task<PRE, false>(Qh, Kh, Vh, seqbase + cl * L + lq0, lq0, L, r, lq0 * r + cl - t0, DBT + 200 * g, Nsum, Dsum, lds + DL_VS + wid * 2048, lane);
            else dil_task<PRE, true>(Qh, Kh, Vh, seqbase + cl * L + lq0, lq0, L, r, lq0 * r + cl - t0, DBT + 200 * g, Nsum, Dsum, lds + DL_VS + wid * 2048, lane); }
        if (g < 2) __syncthreads();
    }
    __syncthreads();
#pragma unroll
    for (int i = 0; i < 8; ++i) { const int row = (tid >> 3) + 64 * i, dc = tid & 7; const float inv = 1.0f / Dsum[row];
        const f32x4 a = *(const LASC f32x4*)(Nsum + row * 64 + dc * 8), b = *(const LASC f32x4*)(Nsum + row * 64 + dc * 8 + 4);
        u32x4 w; w.x = cvtpk(a[0] * inv, a[1] * inv); w.y = cvtpk(a[2] * inv, a[3] * inv); w.z = cvtpk(b[0] * inv, b[1] * inv); w.w = cvtpk(b[2] * inv, b[3] * inv);
        *(u32x4*)(YB + (size_t)(row0 + row) * 1536 + 1024 + head * 64 + dc * 8) = w; }
    __syncthreads();
}
}
#define LAS __attribute__((address_space(3)))
typedef unsigned short bf16;
typedef unsigned v4u __attribute__((ext_vector_type(4)));
typedef float f32x4 __attribute__((ext_vector_type(4)));
constexpr int NWAVES = 8, LDS_BYTES = 163840, BST_OFF = 163840 - 64;
constexpr int TOK = 32768, DM = 1024, CH = 16384, FF = 4096, NIN = 9728;
constexpr size_t MiB = 1u << 20;
constexpr size_t WS_MOD = 1 * MiB, WS_SBIAS = WS_MOD + 160 * 1024, WS_ROWSS = WS_MOD + 320 * 1024;
constexpr size_t WS_WIN = 2 * MiB, WS_WBA = 21 * MiB, WS_WBB = 23 * MiB, WS_WO = 24 * MiB, WS_WUP = 26 * MiB, WS_WDN = 410 * MiB;
constexpr size_t WS_QK = 42 * MiB, WS_VA = 106 * MiB, WS_DIL = 138 * MiB, WS_GT = 282 * MiB, WS_MG = 346 * MiB, WS_GT1 = 420 * MiB, WS_END = 484 * MiB;
constexpr size_t WS_A2 = 42 * MiB, WS_H = 106 * MiB;
constexpr size_t DO_XN = 0, DO_YA = 64 * MiB, DO_YB = 64 * MiB;
#define LDS_WAIT() asm volatile("s_waitcnt lgkmcnt(0)" ::: "memory")
#define XB_TMO      128
#define XB_XCNT(j)  (256  + 64 * (j))
#define XB_XSUB(j)  (1280 + 64 * (j))
#define XB_XGEN(j)  (2304 + 64 * (j))
#define XB_TOP      3328
#define XB_TOPGEN   3392
#define XCD_BAR_WORDS 3456
#define XB_SPIN_CAP (1u << 18)

__device__ __forceinline__ unsigned xb_ld(unsigned* p)              { return __hip_atomic_load(p, __ATOMIC_RELAXED, __HIP_MEMORY_SCOPE_AGENT); }
__device__ __forceinline__ unsigned xb_add(unsigned* p, unsigned v) { return __hip_atomic_fetch_add(p, v, __ATOMIC_RELAXED, __HIP_MEMORY_SCOPE_AGENT); }
__device__ __forceinline__ unsigned xb_xcc_id() { return (unsigned)__builtin_amdgcn_s_getreg((3 << 11) | 20) & 0xFu; }
#define XB_SPIN(cond, bar) do { unsigned _sp = 0; while (cond) { __builtin_amdgcn_s_sleep(1); \
    if ((++_sp & 255u) == 0u) { if (xb_ld(&(bar)[XB_TMO])) break; if (_sp > XB_SPIN_CAP) { atomicAdd(&(bar)[XB_TMO], 1u); break; } } } } while (0)

struct XcdBarrier {
    unsigned* bar; unsigned x;
    volatile LAS unsigned* st;
};

__device__ __forceinline__ XcdBarrier xcd_barrier_post(unsigned* bar, volatile LAS unsigned* st) {
    XcdBarrier b; b.bar = bar; b.x = xb_xcc_id(); b.st = st;
    if (threadIdx.x == 0) (void)xb_add(&bar[XB_XCNT(b.x)], 1u);
    return b;
}
__device__ __forceinline__ void xcd_barrier_complete(unsigned* bar, unsigned x, unsigned& nloc, unsigned& nx) {
    const unsigned G = gridDim.x * gridDim.y * gridDim.z;
    unsigned sum, cnt, mine, sp = 0u;
    for (;;) {
        sum = 0u; cnt = 0u; mine = 0u;
#pragma unroll
        for (unsigned j = 0; j < 16; ++j) { const unsigned c = xb_ld(&bar[XB_XCNT(j)]); sum += c; cnt += (c > 0u) ? 1u : 0u; mine = (j == x) ? c : mine; }
        if (sum == G) break;
        __builtin_amdgcn_s_sleep(1);
        if ((++sp & 255u) == 0u) { if (xb_ld(&bar[XB_TMO])) break; if (sp > XB_SPIN_CAP) { atomicAdd(&bar[XB_TMO], 1u); break; } }
    }
    nloc = mine > 0u ? mine : 1u; nx = cnt > 0u ? cnt : 1u;
}

__device__ __forceinline__ void xcd_barrier(const XcdBarrier& b) {
    asm volatile("s_waitcnt vmcnt(0)" ::: "memory");
    __syncthreads();
    if (threadIdx.x == 0) {
        unsigned* bar = b.bar;
        __builtin_amdgcn_s_waitcnt(0);
        unsigned nloc = b.st[0], nx = b.st[1];
        if (nloc == 0u) { xcd_barrier_complete(bar, b.x, nloc, nx); b.st[0] = nloc; b.st[1] = nx; }
        const unsigned old = xb_add(&bar[XB_XSUB(b.x)], 1u);
        const unsigned gen = old / nloc;
        if (old + 1u == (gen + 1u) * nloc) {
            __builtin_amdgcn_fence(__ATOMIC_RELEASE, "agent");
            asm volatile("s_waitcnt vmcnt(0)" ::: "memory");
            const unsigned og = xb_add(&bar[XB_TOP], 1u);
            const unsigned tg = og / nx;
            if (og + 1u == (tg + 1u) * nx) xb_add(&bar[XB_TOPGEN], 1u);
            else XB_SPIN(xb_ld(&bar[XB_TOPGEN]) == tg, bar);
            __builtin_amdgcn_fence(__ATOMIC_ACQUIRE, "agent");
            xb_add(&bar[XB_XGEN(b.x)], 1u);
            asm volatile("s_waitcnt vmcnt(0)" ::: "memory");
        } else {
            XB_SPIN(xb_ld(&bar[XB_XGEN(b.x)]) == gen, bar);
            __builtin_amdgcn_fence(__ATOMIC_ACQUIRE, "agent");
            asm volatile("s_waitcnt vmcnt(0)" ::: "memory");
        }
    }
    __syncthreads();
}

__device__ __forceinline__ unsigned f2bf(float f) { unsigned u = __builtin_bit_cast(unsigned, f); return (u + 0x7fffu + ((u >> 16) & 1u)) >> 16; }
__device__ __forceinline__ unsigned pk2(float lo, float hi) { return f2bf(lo) | (f2bf(hi) << 16); }
__device__ __forceinline__ float wave_sum(float v) {
    v += swz_xor<1>(v); v += swz_xor<2>(v); v += swz_xor<4>(v); v += swz_xor<8>(v); v += swz_xor<16>(v);
    return add_x32(v);
}
__device__ __forceinline__ float wave_max(float v) {
    v = fmaxf(v, swz_xor<1>(v)); v = fmaxf(v, swz_xor<2>(v)); v = fmaxf(v, swz_xor<4>(v)); v = fmaxf(v, swz_xor<8>(v)); v = fmaxf(v, swz_xor<16>(v));
    return max_x32(v);
}
template <bool PERMW> __device__ __forceinline__ void transpose_item(const float* W, int K, int N, bf16* WT, LAS float* scr, int item, int lane, int ldk = 0, int koff = 0) {
    if (ldk == 0) ldk = K;
    const int nblk = N / 32, kb = item / nblk, nb = item % nblk, k0 = 64 * kb, n0 = 32 * nb;
#pragma unroll 8
    for (int i = 0; i < 32; ++i) { const int kk = 2 * i + (lane >> 5); scr[kk * 33 + (lane & 31)] = W[(size_t)(k0 + kk) * N + n0 + (lane & 31)]; }
    LDS_WAIT(); asm volatile("" ::: "memory");
    const int c = lane & 7;
    int n0p = n0;
    if (PERMW) { const int lg = nb & 7; n0p = (nb & ~7) * 32 + 32 * (4 * (lg & 1) + (lg >> 1));
        if (nb >= 240) { const int gi = nb - 240, isb = gi >> 5, blk = gi & 31; n0p = (30 + (blk >> 2)) * 256 + 32 * (4 * isb + (blk & 3)); } }
#pragma unroll
    for (int j = 0; j < 4; ++j) { const int n = (lane >> 3) + 8 * j; const LAS float* s = scr + (8 * c) * 33 + n;
        v4u o; o.x = pk2(s[0 * 33], s[1 * 33]); o.y = pk2(s[2 * 33], s[3 * 33]); o.z = pk2(s[4 * 33], s[5 * 33]); o.w = pk2(s[6 * 33], s[7 * 33]);
        *(v4u*)(WT + (size_t)(n0p + n) * ldk + koff + k0 + 8 * c) = o; }
    LDS_WAIT(); asm volatile("" ::: "memory");
}
__device__ __forceinline__ void transpose6_item(const float* W, int K, int N, bf16* WT6, const float* gate  , LAS float* scr, int item, int lane) {
    const int nblk = N / 32, kb = item / nblk, nb = item % nblk, k0 = 64 * kb, n0 = 32 * nb;
#pragma unroll 8
    for (int i = 0; i < 32; ++i) { const int kk = 2 * i + (lane >> 5); scr[kk * 33 + (lane & 31)] = W[(size_t)(k0 + kk) * N + n0 + (lane & 31)]; }
    LDS_WAIT(); asm volatile("" ::: "memory");
    const int c = lane & 7;
#pragma unroll
    for (int j = 0; j < 4; ++j) { const int n = (lane >> 3) + 8 * j; const LAS float* s = scr + (8 * c) * 33 + n;
        float v[8];
#pragma unroll
        for (int q = 0; q < 8; ++q) v[q] = s[q * 33];
#pragma unroll
        for (int b = 0; b < 6; ++b) { const float g = gate[b * 6144 + n0 + n];
            v4u o; o.x = pk2(v[0] * g, v[1] * g); o.y = pk2(v[2] * g, v[3] * g); o.z = pk2(v[4] * g, v[5] * g); o.w = pk2(v[6] * g, v[7] * g);
            *(v4u*)(WT6 + (size_t)b * K * N + (size_t)(n0 + n) * K + k0 + 8 * c) = o; } }
    LDS_WAIT(); asm volatile("" ::: "memory");
}
__device__ __forceinline__ void gemv6_task(const LAS float* vec, LAS f32x4* red, const float* W, int N, int col0, const float* bias, float* out, int tid) {
    const int cgp = tid & 7, ks = tid >> 3;
    f32x4 acc[6];
#pragma unroll
    for (int b = 0; b < 6; ++b) acc[b] = (f32x4){0.f, 0.f, 0.f, 0.f};
#pragma unroll 4
    for (int kk = 0; kk < 16; ++kk) { const int k = ks * 16 + kk; const f32x4 w = *(const f32x4*)(W + (size_t)k * N + col0 + 4 * cgp);
#pragma unroll
        for (int b = 0; b < 6; ++b) acc[b] += w * vec[b * 1024 + k]; }
#pragma unroll
    for (int b = 0; b < 6; ++b) red[(ks * 8 + cgp) * 6 + b] = acc[b];
    __syncthreads();
    if (tid < 192) { const int b = tid >> 5, c = tid & 31; float s = 0.f; const LAS float* rf = (const LAS float*)red;
        for (int k2 = 0; k2 < 64; ++k2) s += rf[((k2 * 8 + (c >> 2)) * 6 + b) * 4 + (c & 3)];
        out[b * N + col0 + c] = s + (bias ? bias[col0 + c] : 0.f); }
    __syncthreads();
}

__device__ __forceinline__ void gemv6_task16(const LAS float* vec, LAS f32x4* red, const float* W, int N, int col0, float* out, int tid) {
    const int cgp = tid & 3, ks = tid >> 2;
    f32x4 acc[6];
#pragma unroll
    for (int b = 0; b < 6; ++b) acc[b] = (f32x4){0.f, 0.f, 0.f, 0.f};
#pragma unroll
    for (int kk = 0; kk < 8; ++kk) { const int k = ks * 8 + kk; const f32x4 w = *(const f32x4*)(W + (size_t)k * N + col0 + 4 * cgp);
#pragma unroll
        for (int b = 0; b < 6; ++b) acc[b] += w * vec[b * 1024 + k]; }
#pragma unroll
    for (int b = 0; b < 6; ++b) red[(ks * 4 + cgp) * 6 + b] = acc[b];
    __syncthreads();
    if (tid < 96) { const int b = tid >> 4, c = tid & 15; float s = 0.f; const LAS float* rf = (const LAS float*)red;
        for (int k2 = 0; k2 < 128; ++k2) s += rf[((k2 * 4 + (c >> 2)) * 6 + b) * 4 + (c & 3)];
        out[b * N + col0 + c] = s; }
    __syncthreads();
}

struct Args { const float* in[24]; float* out; unsigned char* ws; int ph_lo, ph_hi; };
constexpr int NPHASE = 11;

__global__ void __launch_bounds__(NWAVES * 64, 2) mk_fwd(Args a) {
    extern __shared__ __attribute__((aligned(16))) unsigned char lds_raw[];
    cg::grid_group grid = cg::this_grid();
    LAS unsigned char* lds = (LAS unsigned char*)lds_raw;
    const int wave = __builtin_amdgcn_readfirstlane((int)threadIdx.x >> 6);
#define lane (att::lane_now())
#define tid ((wave << 6) | att::lane_now())
    const int G = gridDim.x; const int bx = blockIdx.x; const int vcu = (G % 8 == 0) ? (bx % 8) * (G / 8) + bx / 8 : bx;
    const int gw = vcu * NWAVES + wave, NGW = G * NWAVES;
    unsigned char* ws = a.ws; unsigned char* dob = (unsigned char*)a.out;
    const float *x_p = a.in[0], *x_s = a.in[1], *c_p = a.in[2], *c_s = a.in[3], *rel_bias = a.in[4], *norm1_g = a.in[5], *w_ada = a.in[6], *b_ada = a.in[7], *w_in = a.in[8],
                *qn_a = a.in[9], *kn_a = a.in[10], *lq1 = a.in[11], *lk1 = a.in[12], *lq2 = a.in[13], *lk2 = a.in[14], *subln_g = a.in[15], *qn_b = a.in[16], *kn_b = a.in[17],
                *w_br_a = a.in[18], *w_br_b = a.in[19], *w_o = a.in[20], *norm2_g = a.in[21], *w_up = a.in[22], *w_down = a.in[23];
    float* mod = (float*)(ws + WS_MOD); float* sbias = (float*)(ws + WS_SBIAS); float* rowss = (float*)(ws + WS_ROWSS);
    bf16 *WinT = (bf16*)(ws + WS_WIN), *WbaT = (bf16*)(ws + WS_WBA), *WbbT = (bf16*)(ws + WS_WBB), *WupT = (bf16*)(ws + WS_WUP), *WoT = (bf16*)(ws + WS_WO), *WdnT = (bf16*)(ws + WS_WDN);
    bf16 *QK = (bf16*)(ws + WS_QK), *VA = (bf16*)(ws + WS_VA), *DIL = (bf16*)(ws + WS_DIL), *GT = (bf16*)(ws + WS_GT), *MG = (bf16*)(ws + WS_MG), *A2 = (bf16*)(ws + WS_A2), *HB = (bf16*)(ws + WS_H);
    bf16 *XN = (bf16*)(dob + DO_XN), *YA = (bf16*)(dob + DO_YA), *YB = (bf16*)(dob + DO_YB);
    const int lo = a.ph_lo, hi = a.ph_hi;
    if (lo < 0) grid.sync();
    volatile LAS unsigned* bst = (volatile LAS unsigned*)(lds + BST_OFF);
    if (threadIdx.x < 4) bst[threadIdx.x] = 0u;
    __syncthreads();
    const XcdBarrier xbar = xcd_barrier_post((unsigned*)ws, bst);
#ifdef PMODE
    if (blockIdx.x == 0 && threadIdx.x == 0) *(volatile unsigned long long*)(ws + 65536 + 512) = __builtin_amdgcn_s_memrealtime();
#define PSTAMP(k) do { if (bx == 0 && threadIdx.x == 0) ((float*)(ws + 65536 + 256))[(k)] = (float)(__builtin_amdgcn_s_memrealtime() - *(volatile unsigned long long*)(ws + 65536 + 512)) * 0.01f; } while (0)
#else
#define PSTAMP(k) do {} while (0)
#endif
#ifndef P2_ROT
#define P2_ROT(v) (((v) >> 5) % 3)
#endif
#ifndef PPREV
#define PPREV (PMODE - 1)
#endif
#ifndef PBASE
#define PBASE 0
#define PQ 32.0f
#endif
#ifndef TBASE
#define TBASE 0
#define TSCALE 0.01f
#endif
#ifndef PH_MASK
#define PH_MASK 0x7ff
#endif
#define PH_ON(k) ((PH_MASK >> (k)) & 1)
#ifndef PH_REP
#define PH_REP 0
#endif
#define NREP(k) ((((PH_REP) >> (k)) & 1) ? 2 : 1)
#define IN(k) (lo <= (k) && (k) < hi)
#ifndef XSYNC
#define XSYNC 0
#endif
#define SEAM(k) do { if (IN(k) && IN((k) + 1)) { xcd_barrier(xbar); for (int xs_ = 0; xs_ < XSYNC; ++xs_) xcd_barrier(xbar); PSTAMP(k); } } while (0)

    if (PH_ON(0) && IN(0)) for (int rep_ = 0; rep_ < NREP(0); ++rep_) {
        LAS float* scr = (LAS float*)(lds + wave * 16384);
        constexpr int I_IN = (DM / 64) * (NIN / 32), I_BA = (DM / 64) * (DM / 32), I_BB = (512 / 64) * (DM / 32), I_O = I_BA, I_UP = (DM / 64) * (FF / 32), I_DN = (FF / 64) * (DM / 32);
        constexpr int NITEMS = I_IN + I_BA + I_BB + I_O + I_UP + I_DN;
        for (int it = gw; it < NITEMS; it += NGW) {
            int r = it;
            if (r < I_IN) { transpose_item<true>(w_in, DM, NIN, WinT, scr, r, lane); continue; } r -= I_IN;
            if (r < I_BA) { transpose_item<false>(w_br_a, DM, DM, WbaT, scr, r, lane, 1536, 0); continue; } r -= I_BA;
            if (r < I_BB) { transpose_item<false>(w_br_b, 512, DM, WbaT, scr, r, lane, 1536, 1024); continue; } r -= I_BB;
            if (r < I_O) { transpose_item<false>(w_o, DM, DM, WoT, scr, r, lane); continue; } r -= I_O;
            if (r < I_UP) { transpose_item<true>(w_up, DM, FF, WupT, scr, r, lane); continue; } r -= I_UP;
            transpose_item<false>(w_down, FF, DM, WdnT, scr, r, lane, LDH, 0);
        }
        for (int i = gw * 64 + lane; i < TOK; i += NGW * 64) rowss[i] = 0.f;
        __syncthreads();
        LAS float* vec = (LAS float*)lds; LAS f32x4* red = (LAS f32x4*)(lds + 32768);
        for (int i = tid; i < 6 * 1024; i += 512) { const int b = i >> 10, k = i & 1023; const float c = b < 4 ? c_p[b * 1024 + k] : c_s[(b - 4) * 1024 + k]; vec[i] = c / (1.0f + __expf(-c)); }
        __syncthreads();
        for (int task = vcu; task < 6144 / 32; task += G) gemv6_task(vec, red, w_ada, 6144, task * 32, b_ada, mod, tid);
        __syncthreads();
    }
    SEAM(0);
    if (PH_ON(1) && IN(1)) for (int rep_ = 0; rep_ < NREP(1); ++rep_) {
        for (int m0 = 4 * gw; m0 < TOK; m0 += 4 * NGW) {
            const int ln = lane; const int b = pg8::batch_of(m0);
            const float* xr = m0 < 16384 ? x_p + (size_t)m0 * 1024 : x_s + (size_t)(m0 - 16384) * 1024;
            const float* sh1 = mod + b * 6144; const float* sc1 = mod + b * 6144 + 1024;
            f32x4 v[4][4];
#pragma unroll
            for (int r = 0; r < 4; ++r)
#pragma unroll
                for (int j = 0; j < 4; ++j) v[r][j] = ((const f32x4*)(xr + (size_t)r * 1024))[ln + 64 * j];
            f32x4 gm[4], sh[4];
#pragma unroll
            for (int j = 0; j < 4; ++j) { const int c = 4 * ln + 256 * j; gm[j] = *(const f32x4*)(norm1_g + c) * (*(const f32x4*)(sc1 + c) + 1.0f); sh[j] = *(const f32x4*)(sh1 + c); }
#pragma unroll
            for (int r = 0; r < 4; ++r) {
                float s = 0.f;
#pragma unroll
                for (int j = 0; j < 4; ++j) s += (v[r][j].x * v[r][j].x + v[r][j].y * v[r][j].y) + (v[r][j].z * v[r][j].z + v[r][j].w * v[r][j].w);
                const float rstd = 1.0f / sqrtf(wave_sum(s) * (1.0f / 1024.0f) + 1e-6f);
                unsigned long long* o8 = (unsigned long long*)(XN + (size_t)(m0 + r) * 1024) + ln;
#pragma unroll
                for (int j = 0; j < 4; ++j) { const f32x4 h = v[r][j] * rstd * gm[j] + sh[j]; o8[64 * j] = (unsigned long long)pk2(h.x, h.y) | ((unsigned long long)pk2(h.z, h.w) << 32); }
            }
        }
        __syncthreads();
        LAS float* vec = (LAS float*)lds; LAS f32x4* red = (LAS f32x4*)(lds + 32768);
        for (int i = tid; i < 6 * 1024; i += 512) { const int b = i >> 10, k = i & 1023; vec[i] = mod[b * 6144 + 3072 + k]; }
        __syncthreads();
        for (int task = vcu; task < FF / 16; task += G) gemv6_task16(vec, red, w_up, FF, task * 16, sbias, tid);
        __syncthreads();
    }
    SEAM(1);
#pragma unroll 1
    for (int c = 0; c < 2; ++c) {
        const int S = c == 0 ? 4096 : 8192, lgS = c == 0 ? 12 : 13;
        bf16* Yc = c == 0 ? YA : XN;
        bf16* GTc = c == 0 ? GT : (bf16*)(ws + WS_GT1);
        if (PH_ON(2) && IN(2 + 3 * c)) for (int rep_ = 0; rep_ < NREP(2); ++rep_) {
#ifdef STAG1
            for (int sd_ = 0; sd_ < STAG1 * (vcu & 3); ++sd_) __builtin_amdgcn_s_sleep(127);
#endif
            pg8::Gemm g{XN + (size_t)c * CH * DM, WinT, CH, NIN, DM}; pg8::P1Order SO{c, (int)G, (int)bx};
            { LAS float* gl_ = (LAS float*)(lds + 131072);
              if (tid < 512) gl_[tid] = tid < 64 ? qn_a[tid] * pg8::C2Q : tid < 128 ? kn_a[tid - 64] : tid < 320 ? qn_b[tid - 128] * pg8::C2Q : kn_b[tid - 320];
              __syncthreads(); }
            pg8::EpiProj E{QK, VA, DIL, GTc, (const LAS float*)(lds + 131072), S, lgS};
            static_assert(WS_GT1 - WS_GT == pg8::GTX_OFF * 2, "gate buffer distance");
            pg8::gemm_phase<pg8::EpiProj, pg8::P1Order, true, true>(lds, g, SO, E);
        }
        SEAM(2 + 3 * c);
        if (PH_ON(3) && IN(3 + 3 * c)) for (int rep_ = 0; rep_ < NREP(3); ++rep_) {
            if (wave == 0) {
                const int ln = lane;
                const float a1 = wave_sum(lq1[ln] * lk1[ln]), a2 = wave_sum(lq2[ln] * lk2[ln]);
                const float gqa = wave_max(fabsf(qn_a[ln])), gka = wave_max(fabsf(kn_a[ln]));
                float gb = 0.f;
#pragma unroll
                for (int g = 0; g < 3; ++g) gb = fmaxf(gb, wave_max(fabsf(qn_b[64 * g + ln])) * wave_max(fabsf(kn_b[64 * g + ln])));
                float ba = 0.f, bb = 0.f;
                for (int i = ln; i < 1024; i += 64) { const float v = fabsf(rel_bias[i]); if ((i & 31) < 8) ba = fmaxf(ba, v); else bb = fmaxf(bb, v); }
                ba = wave_max(ba); bb = wave_max(bb);
                if (ln == 0) { LAS float* SC = (LAS float*)(lds + att::SC_OFF); SC[0] = __expf(a1) - __expf(a2) + 0.2f; SC[1] = (8.0f * gqa * gka + ba) * att::LOG2E; SC[2] = (8.0f * gb + bb) * att::LOG2E; }
            }
            __syncthreads();
            { const int nqb = S / 256; const int rot = P2_ROT(vcu); int kda = 0; bool dil_done = false;
              for (int s = 0; ; ++s) {
                  const int uda = vcu + kda * G;
                  if (!dil_done && (s == rot || uda >= 512)) {
                      for (int u = vcu; u < 256; u += G) att::dil_unit<false>(lds, DIL, Yc, rel_bias, u & 7, u >> 3, S, lgS, tid);
                      dil_done = true;
                  } else if (uda < 512) { const int sh = uda / nqb, qb = uda % nqb, seq = sh >> 3, head = sh & 7;
#ifdef TMODE
                      att::da_unit(lds, QK, VA, Yc, rel_bias, subln_g, head, seq * (S / 64), S / 64, qb, tid, (bx == 0 && c == 1 && kda == 0) ? (float*)(ws + 65536) : nullptr);
#else
                      att::da_unit(lds, QK, VA, Yc, rel_bias, subln_g, head, seq * (S / 64), S / 64, qb, tid);
#endif
                      ++kda;
                  } else break;
              } }
        }
        SEAM(3 + 3 * c);
        if (c == 1) {
            if (PH_ON(4) && IN(7)) for (int rep_ = 0; rep_ < NREP(4); ++rep_) {
                pg8::Gemm g{YA, WbaT, TOK, DM, 1536}; pg8::StaticOrder SO; SO.init(TOK, DM, G, bx);
                const ptrdiff_t aoff1 = ((const char*)XN - (const char*)YA) - (ptrdiff_t)64 * 256 * 1536 * 2;
                pg8::EpiBrC E{MG, GT, GT + (size_t)CH * 1024, (const bf16*)(ws + WS_GT1), (const bf16*)(ws + WS_GT1) + (size_t)CH * 1024, aoff1, 16};
                pg8::gemm_phase<pg8::EpiBrC, pg8::StaticOrder, true, true>(lds, g, SO, E);
            }
            SEAM(7);
        }
    }
    if (PH_ON(8) && IN(8)) for (int rep_ = 0; rep_ < NREP(8); ++rep_) {
        pg8::Gemm g{MG, WoT, TOK, DM, DM, PG8_ATILE}; pg8::StaticOrder SO; SO.init(TOK, DM, G, bx);
        pg8::EpiWo E{x_p, x_s, a.out, A2, mod, norm2_g, rowss};
        pg8::gemm_phase<pg8::EpiWo, pg8::StaticOrder, true, true>(lds, g, SO, E);
    }
    SEAM(8);
    if (PH_ON(9) && IN(9)) for (int rep_ = 0; rep_ < NREP(9); ++rep_) {
        pg8::Gemm g{A2, WupT, TOK, FF, DM, PG8_ATILE}; pg8::StaticOrder SO; SO.init(TOK, FF, G, bx);
        pg8::EpiUp E{HB, rowss, sbias};
        pg8::gemm_phase<pg8::EpiUp, pg8::StaticOrder, true, true>(lds, g, SO, E);
    }
    SEAM(9);
    if (PH_ON(10) && IN(10)) for (int rep_ = 0; rep_ < NREP(10); ++rep_) {
        pg8::Gemm g{HB, WdnT, TOK, DM, FF, HNBLK, LDH, LDH}; pg8::StaticOrder SO; SO.init(TOK, DM, G, bx);
        pg8::EpiDown E{a.out, mod};
        pg8::gemm_phase<pg8::EpiDown, pg8::StaticOrder, true, true>(lds, g, SO, E);
    }
#ifdef PMODE
    xcd_barrier(xbar); PSTAMP(10);
    if (bx == 0 && threadIdx.x == 0) { const float* tp = (const float*)(ws + 65536 + 256); a.out[0] += floorf(((PMODE == 0 ? tp[0] : (PMODE == 99 ? tp[10] * 0.1f : tp[PMODE] - tp[PPREV])) - (float)PBASE) * (1.0f / PQ)); }
#endif
#ifdef TMODE
    xcd_barrier(xbar);
    if (bx == 0 && threadIdx.x == 0) { const float* tp = (const float*)(ws + 65536); a.out[0] += (TMODE == 0) ? 100.0f : ((tp[TMODE - 1] - (float)TBASE) * TSCALE); }
#endif
#undef IN
#undef SEAM
#undef lane
#undef tid
}

extern "C" void kernel_launch(void* const* d_in, const int* in_sizes, int n_in, void* d_out, int out_size, void* d_ws, size_t ws_size, hipStream_t stream) {
    static int grid = 0;
    if (grid == 0) {
        if (n_in != 24 || out_size != TOK * DM || ws_size < WS_END) { fprintf(stderr, "kernel_launch: unexpected shapes (n_in %d, out %d, ws %zu)\n", n_in, out_size, ws_size); grid = -1; return; }
        int dev = 0, cus = 0, per_cu = 0;
        if (hipGetDevice(&dev) != hipSuccess || hipDeviceGetAttribute(&cus, hipDeviceAttributeMultiprocessorCount, dev) != hipSuccess) { grid = -1; return; }
        if (hipFuncSetAttribute((const void*)mk_fwd, hipFuncAttributeMaxDynamicSharedMemorySize, LDS_BYTES) != hipSuccess) { fprintf(stderr, "kernel_launch: hipFuncSetAttribute failed\n"); grid = -1; return; }
        if (hipOccupancyMaxActiveBlocksPerMultiprocessor(&per_cu, (const void*)mk_fwd, NWAVES * 64, LDS_BYTES) != hipSuccess || per_cu < 1) { fprintf(stderr, "kernel_launch: occupancy query says %d\n", per_cu); per_cu = 1; }
        (void)hipGetLastError();
        grid = cus;
    }
    if (grid < 0) return;
#ifdef XMEMSET
    for (int xm_ = 0; xm_ < XMEMSET; ++xm_) (void)hipMemsetAsync((char*)d_ws + (480u << 20) + xm_ * 65536, 0, 65536, stream);
#endif
    if (hipMemsetAsync(d_ws, 0, 65536, stream) != hipSuccess) { fprintf(stderr, "kernel_launch: hipMemsetAsync failed\n"); return; }
    Args a{};
    for (int i = 0; i < 24; ++i) a.in[i] = (const float*)d_in[i];
    a.out = (float*)d_out; a.ws = (unsigned char*)d_ws;
#ifndef MK_PER_PHASE
    a.ph_lo = 0; a.ph_hi = NPHASE;
    void* args[] = {&a};
#ifdef PLAIN_LAUNCH
    hipLaunchKernelGGL(mk_fwd, dim3(grid), dim3(NWAVES * 64), LDS_BYTES, stream, a); hipError_t e = hipGetLastError(); (void)args;
#else
    hipError_t e = hipLaunchCooperativeKernel((const void*)mk_fwd, dim3(grid), dim3(NWAVES * 64), args, LDS_BYTES, stream);
#endif
    if (e != hipSuccess) fprintf(stderr, "kernel_launch: cooperative launch failed: %s (grid %d)\n", hipGetErrorString(e), grid);
#else
    for (int p = 0; p < NPHASE; ++p) { a.ph_lo = p; a.ph_hi = p + 1; hipLaunchKernelGGL(mk_fwd, dim3(grid), dim3(NWAVES * 64), LDS_BYTES, stream, a); }
#endif
}
```

```cpp
#include <hip/hip_runtime.h>
#include <hip/hip_cooperative_groups.h>
#include <cstdio>
#include <cstdint>
namespace cg = cooperative_groups;
template <int M> __device__ __forceinline__ float swz_xor(float v) { return __builtin_bit_cast(float, __builtin_amdgcn_ds_swizzle(__builtin_bit_cast(int, v), (M << 10) | 0x1f)); }
__device__ __forceinline__ float add_x32(float v) { const unsigned b = __builtin_bit_cast(unsigned, v); auto rr = __builtin_amdgcn_permlane32_swap(b, b, false, false); return __builtin_bit_cast(float, (unsigned)rr[0]) + __builtin_bit_cast(float, (unsigned)rr[1]); }
__device__ __forceinline__ float max_x32(float v) { const unsigned b = __builtin_bit_cast(unsigned, v); auto rr = __builtin_amdgcn_permlane32_swap(b, b, false, false); return fmaxf(__builtin_bit_cast(float, (unsigned)rr[0]), __builtin_bit_cast(float, (unsigned)rr[1])); }
namespace pg8 {
#define PG8_LAS __attribute__((address_space(3)))
typedef unsigned short bf16_t;
typedef short bf16x8 __attribute__((ext_vector_type(8)));
typedef float f32x4 __attribute__((ext_vector_type(4)));
typedef unsigned u32x4 __attribute__((ext_vector_type(4)));
constexpr int BM = 256, BK = 64, HALF = 128, HTB = HALF * BK * 2  , STAGE_BYTES = 8 * HTB, NXCD = 8, WGM = 8;

__host__ __device__ __forceinline__ int lds_byte(int r, int c) { const int st = (r >> 4) * 2 + (c >> 5), rr = r & 15, cc = c & 31, ob = rr * 64 + cc * 2; return st * 1024 + (ob ^ (((ob >> 9) & 1) << 5)); }
__host__ __device__ __forceinline__ void stage_rc(int b, int& R, int& C) { const int st = b / 1024, sb = b % 1024, swz = sb ^ (((sb >> 9) & 1) << 5); R = (st >> 1) * 16 + swz / 64; C = (st & 1) * 32 + (swz % 64) / 2; }
__host__ __device__ __forceinline__ int perm32(int rho) { const int n = rho >> 4, i = rho & 15; return 8 * (i >> 2) + 4 * n + (i & 3); }

struct Unit { int pm, pn; };
struct Gemm { const bf16_t* A; const bf16_t* Bt; int M, N, K; int atile = 0; int lda = 0, ldb = 0; };
__host__ __device__ __forceinline__ size_t a_tiled(int row, int col, int nblk) { return ((size_t)(row >> 4) * nblk + (col >> 5)) * 512 + (row & 15) * 32 + (col & 31); }
#define PG8_ATILE 0
#define PG8_ABJ 128

struct StaticOrder {
    int nM, nN, nwg, G, c;
    __host__ __device__ void init(int M, int N, int G_, int c_) { nM = M / BM; nN = N / BM; nwg = nM * nN; G = G_; c = c_; }
    __host__ __device__ bool next(int i, Unit& u) const {
        const long L = (long)i * G + c; if (L >= nwg) return false;
        int wgid = (int)L; { const int q = nwg / NXCD, r = nwg % NXCD, xcd = wgid % NXCD; int off = wgid / NXCD;
#ifndef SO_NOMIX
            if (r == 0) { const int rot = ((xcd >> 1) * (q >> 2)) & ~7; off = (off + rot) % q; if (xcd & 1) off = q - 1 - off; }
#endif
            wgid = (xcd < r ? xcd * (q + 1) : r * (q + 1) + (xcd - r) * q) + off; }
        const int nig = WGM * nN, gid = wgid / nig, fm = gid * WGM, gsz = (nM - fm) < WGM ? (nM - fm) : WGM;
        u.pm = fm + ((wgid % nig) % gsz); u.pn = (wgid % nig) / gsz; return true;
    }
    __device__ __forceinline__ void a_ready(const Unit&) const {}
    __device__ __forceinline__ void done(const Unit&) const {}
};
typedef __bf16 pk_bf16x2_t __attribute__((ext_vector_type(2)));
typedef float pk_f32x2_t __attribute__((ext_vector_type(2)));
__device__ __forceinline__ unsigned cvt_pk_bf16(float lo, float hi) { pk_f32x2_t v = {lo, hi}; return __builtin_bit_cast(unsigned, __builtin_convertvector(v, pk_bf16x2_t)); }
template <class Epi, class Sched, bool ALIGN_EPI = false, bool SP2 = false>
__device__ __forceinline__ void gemm_phase(PG8_LAS unsigned char* lds, const Gemm g, const Sched& S, const Epi& E) {
    int tid_ = threadIdx.x; asm volatile("" : "+v"(tid_));
    const int tid = tid_, wid = __builtin_amdgcn_readfirstlane(tid >> 6), lane = tid & 63, wr = wid >> 2, wc = wid & 3, fr = lane & 15, fq = lane >> 4;
    const int K = g.K, nt = K / BK, lda = g.lda ? g.lda : K, ldb = g.ldb ? g.ldb : K;
    unsigned voffA[2], voffB[2];
#pragma unroll
    for (int i = 0; i < 2; ++i) { int R, C; stage_rc(tid * 16 + i * 8192, R, C); const int Rb = Epi::PERM ? ((R & ~31) + perm32(R & 31)) : R;
        voffA[i] = g.atile ? (unsigned)(((R >> 4) * g.atile + (C >> 5)) * 1024 + (R & 15) * 64 + (C & 31) * 2) : (unsigned)(R * lda + C) * 2u;     voffB[i] = (unsigned)(Rb * ldb + C) * 2u; }
    unsigned voffAc[2], voffAn[2]; size_t hstepAc, hstepAn;
#define PG8_APERM_SET(VO, HS, LGR) do { const int lg_ = (LGR); _Pragma("unroll") for (int i = 0; i < 2; ++i) { int R, C; stage_rc(tid * 16 + i * 8192, R, C); \
        const int Rp = lg_ ? ((R >> (8 - lg_)) + ((R & ((1 << (8 - lg_)) - 1)) << lg_)) : R; VO[i] = (unsigned)(Rp * K + C) * 2u; } \
        HS = (size_t)(lg_ ? (1 << (lg_ - 1)) : HALF) * K * 2; } while (0)
    const size_t kstep = (size_t)(BK * 2);
    const size_t hstep = (size_t)HALF * ldb * 2;
    const size_t tstep = 2 * hstep;
    const size_t kstepA = g.atile ? (size_t)2048 : kstep, hstepT = g.atile ? (size_t)g.atile * 8192 : (size_t)HALF * lda * 2, tstepA = 2 * hstepT;
    const unsigned ldsw = (unsigned)wid * 1024u;
    const int aoff = lds_byte(wr * 64 + fr, fq * 8), boff = lds_byte(wc * 32 + fr, fq * 8);
#define PG8_SA(b, h) (((b) * 2 + (h)) * HTB)
#define PG8_SB(b, h) ((4 + (b) * 2 + (h)) * HTB)
#define PG8_STAGE(bufoff, gbase, voff) do { _Pragma("unroll") for (int _i = 0; _i < 2; ++_i) \
        __builtin_amdgcn_global_load_lds((const unsigned*)((const char*)(gbase) + (voff)[_i]), (PG8_LAS unsigned*)(lds + (bufoff) + ldsw + _i * 8192), 16, 0, 0); } while (0)
#define PG8_LDA(dst, b, h) do { _Pragma("unroll") for (int m = 0; m < 4; ++m) _Pragma("unroll") for (int k = 0; k < 2; ++k) dst[m][k] = *(const PG8_LAS bf16x8*)(lds + PG8_SA(b, h) + aoff + m * 2048 + k * 1024); } while (0)
#define PG8_LDB(dst, b, h) do { _Pragma("unroll") for (int n = 0; n < 2; ++n) _Pragma("unroll") for (int k = 0; k < 2; ++k) dst[n][k] = *(const PG8_LAS bf16x8*)(lds + PG8_SB(b, h) + boff + n * 2048 + k * 1024); } while (0)
#define PG8_MMA(ai, bj, At, Bt) do { __builtin_amdgcn_s_setprio(1); _Pragma("unroll") for (int m = 0; m < 4; ++m) _Pragma("unroll") for (int n = 0; n < 2; ++n) _Pragma("unroll") for (int k = 0; k < 2; ++k) \
        acc[ai][bj][m][n] = __builtin_amdgcn_mfma_f32_16x16x32_bf16(Bt[n][k], At[m][k], acc[ai][bj][m][n], 0, 0, 0); __builtin_amdgcn_s_setprio(0); } while (0)
#define PG8_WAIT_V(n) asm volatile("s_waitcnt vmcnt(" #n ")" ::: "memory")
#define PG8_WAIT_L(n) asm volatile("s_waitcnt lgkmcnt(" #n ")" ::: "memory")
#define PG8_BAR __builtin_amdgcn_s_barrier()
#define PG8_SCHED __builtin_amdgcn_sched_barrier(0)
    Unit cur, nxt; int ui = 0;
    if (!S.next(0, cur)) return;
    f32x4 acc[2][2][4][2];
    if constexpr (Epi::INIT) E.init(acc, cur, wr, wc, fr, fq);
    else {
#pragma unroll
    for (int a = 0; a < 2; ++a)
#pragma unroll
        for (int b = 0; b < 2; ++b)
#pragma unroll
            for (int m = 0; m < 4; ++m)
#pragma unroll
                for (int n = 0; n < 2; ++n) acc[a][b][m][n] = (f32x4){0.f, 0.f, 0.f, 0.f};
    }
    bf16x8 At[4][2], B0[2][2], B1[2][2];
    const char* cA = (const char*)g.A + (size_t)cur.pm * tstepA + E.a_off(cur); const char* cB = (const char*)g.Bt + (size_t)cur.pn * tstep + E.bt_off(cur);
    if constexpr (Epi::APERM) { PG8_APERM_SET(voffAc, hstepAc, E.a_lgr(cur)); } else { voffAc[0] = voffA[0]; voffAc[1] = voffA[1]; hstepAc = hstepT; }
    S.a_ready(cur);
    if constexpr (SP2) {
        PG8_STAGE(PG8_SB(0, 0), cB, voffB); PG8_STAGE(PG8_SB(0, 1), cB + hstep, voffB); PG8_STAGE(PG8_SA(0, 0), cA, voffAc); PG8_STAGE(PG8_SA(0, 1), cA + hstepAc, voffAc);
        if (wr == 1) PG8_BAR;
        PG8_WAIT_V(2); PG8_BAR;
        PG8_STAGE(PG8_SB(1, 0), cB + kstep, voffB); PG8_STAGE(PG8_SA(1, 0), cA + kstepA, voffAc); PG8_STAGE(PG8_SB(1, 1), cB + hstep + kstep, voffB);
        PG8_WAIT_V(6); PG8_BAR;
    } else {
        PG8_STAGE(PG8_SB(0, 0), cB, voffB); PG8_STAGE(PG8_SA(0, 0), cA, voffA); PG8_STAGE(PG8_SB(0, 1), cB + hstep, voffB); PG8_STAGE(PG8_SA(0, 1), cA + hstep, voffA);
        if (wr == 1) PG8_BAR;
        PG8_WAIT_V(4); PG8_BAR;
        PG8_STAGE(PG8_SB(1, 0), cB + kstep, voffB); PG8_STAGE(PG8_SA(1, 0), cA + kstep, voffA); PG8_STAGE(PG8_SB(1, 1), cB + hstep + kstep, voffB);
        PG8_WAIT_V(6); PG8_BAR;
    }
    for (;;) {
        const bool has_next = S.next(ui + 1, nxt);
        const char* nA = has_next ? (const char*)g.A + (size_t)nxt.pm * tstepA + E.a_off(nxt) : cA; const char* nB = has_next ? (const char*)g.Bt + (size_t)nxt.pn * tstep + E.bt_off(nxt) : cB;
        if constexpr (Epi::APERM) { if (has_next) { PG8_APERM_SET(voffAn, hstepAn, E.a_lgr(nxt)); } else { voffAn[0] = voffAc[0]; voffAn[1] = voffAc[1]; hstepAn = hstepAc; } }
        else { voffAn[0] = voffA[0]; voffAn[1] = voffA[1]; hstepAn = hstepT; }
        for (int t = 0; t < nt; t += 2) {
            if constexpr (Epi::MIDFIX) { if (t == E.fix_t) E.midfix(acc, cur, wr, wc, fr, fq); }
            const bool last = (t == nt - 2);
            const char* a1 = cA + (size_t)(t + 1) * kstepA;
            const char* a2 = last ? nA : cA + (size_t)(t + 2) * kstepA; const char* b2 = last ? nB : cB + (size_t)(t + 2) * kstep;
            const char* a3 = a2 + kstepA; const char* b3 = b2 + kstep;
            if (last && has_next) S.a_ready(nxt);
            unsigned vo2[2]; vo2[0] = last ? voffAn[0] : voffAc[0]; vo2[1] = last ? voffAn[1] : voffAc[1]; const size_t hs2 = last ? hstepAn : hstepAc;
            if constexpr (SP2) {
            PG8_LDB(B0, 0, 0); PG8_LDB(B1, 0, 1); PG8_SCHED; PG8_LDA(At, 0, 0); PG8_STAGE(PG8_SA(1, 1), a1 + hstepAc, voffAc);
            PG8_WAIT_V(8); PG8_WAIT_L(0); PG8_BAR; PG8_MMA(0, 0, At, B0); PG8_MMA(0, 1, At, B1); PG8_BAR; PG8_SCHED;
            PG8_LDA(At, 0, 1); PG8_STAGE(PG8_SB(0, 0), b2, voffB); PG8_STAGE(PG8_SB(0, 1), b2 + hstep, voffB); PG8_STAGE(PG8_SA(0, 0), a2, vo2);
            PG8_WAIT_V(8); PG8_WAIT_L(0); PG8_BAR; PG8_MMA(1, 0, At, B0); PG8_MMA(1, 1, At, B1); PG8_BAR; PG8_SCHED;
            PG8_LDB(B0, 1, 0); PG8_LDB(B1, 1, 1); PG8_SCHED; PG8_LDA(At, 1, 0); PG8_STAGE(PG8_SA(0, 1), a2 + hs2, vo2);
            PG8_WAIT_V(8); PG8_WAIT_L(0); PG8_BAR; PG8_MMA(0, 0, At, B0); PG8_MMA(0, 1, At, B1); PG8_BAR; PG8_SCHED;
            PG8_LDA(At, 1, 1); PG8_STAGE(PG8_SB(1, 0), b3, voffB); PG8_STAGE(PG8_SB(1, 1), b3 + hstep, voffB); PG8_STAGE(PG8_SA(1, 0), a3, vo2);
            PG8_WAIT_V(8); PG8_WAIT_L(0); PG8_BAR; PG8_MMA(1, 0, At, B0); PG8_MMA(1, 1, At, B1); PG8_BAR; PG8_SCHED;
            } else {
            PG8_LDB(B0, 0, 0); PG8_SCHED; PG8_LDA(At, 0, 0); PG8_STAGE(PG8_SA(1, 1), a1 + hstep, voffA);
            PG8_WAIT_L(8); PG8_BAR; PG8_WAIT_L(0); PG8_MMA(0, 0, At, B0); PG8_BAR; PG8_SCHED;
            PG8_LDB(B1, 0, 1); PG8_STAGE(PG8_SB(0, 0), b2, voffB);
            PG8_BAR; PG8_WAIT_L(0); PG8_MMA(0, 1, At, B1); PG8_BAR;
            PG8_LDA(At, 0, 1); PG8_STAGE(PG8_SA(0, 0), a2, voffA);
            PG8_BAR; PG8_WAIT_L(0); PG8_MMA(1, 0, At, B0); PG8_BAR; PG8_SCHED;
            PG8_STAGE(PG8_SB(0, 1), b2 + hstep, voffB);
            PG8_WAIT_V(6); PG8_BAR; PG8_MMA(1, 1, At, B1); PG8_BAR;
            PG8_LDB(B0, 1, 0); PG8_SCHED; PG8_LDA(At, 1, 0); PG8_STAGE(PG8_SA(0, 1), a2 + hstep, voffA);
            PG8_WAIT_L(8); PG8_BAR; PG8_WAIT_L(0); PG8_MMA(0, 0, At, B0); PG8_BAR; PG8_SCHED;
            PG8_LDB(B1, 1, 1); PG8_STAGE(PG8_SB(1, 0), b3, voffB);
            PG8_BAR; PG8_WAIT_L(0); PG8_MMA(0, 1, At, B1); PG8_BAR;
            PG8_LDA(At, 1, 1); PG8_STAGE(PG8_SA(1, 0), a3, voffA);
            PG8_BAR; PG8_WAIT_L(0); PG8_MMA(1, 0, At, B0); PG8_BAR; PG8_SCHED;
            PG8_STAGE(PG8_SB(1, 1), b3 + hstep, voffB);
            PG8_WAIT_V(6); PG8_BAR; PG8_MMA(1, 1, At, B1); PG8_BAR;
            }
        }
        if constexpr (ALIGN_EPI) { if (wr == 0) PG8_BAR; }
        if constexpr (!Epi::AFTER_DRAIN) { E(acc, cur, wr, wc, fr, fq); S.done(cur); }
        if (!has_next) break;
        if constexpr (Epi::INIT) E.init(acc, nxt, wr, wc, fr, fq);
        else {
#pragma unroll
        for (int a = 0; a < 2; ++a)
#pragma unroll
            for (int b = 0; b < 2; ++b)
#pragma unroll
                for (int m = 0; m < 4; ++m)
#pragma unroll
                    for (int n = 0; n < 2; ++n) acc[a][b][m][n] = (f32x4){0.f, 0.f, 0.f, 0.f};
        }
        cur = nxt; cA = nA; cB = nB; ++ui; voffAc[0] = voffAn[0]; voffAc[1] = voffAn[1]; hstepAc = hstepAn;
        if constexpr (ALIGN_EPI) { if (wr == 1) PG8_BAR; }
    }
    PG8_WAIT_V(0);
    if constexpr (!ALIGN_EPI) { if (wr == 0) PG8_BAR; }
    PG8_BAR;
    if constexpr (Epi::AFTER_DRAIN) { E.fused(acc, cur, wr, wc, fr, fq, lds, wid, lane); S.done(cur); }
#undef PG8_SA
#undef PG8_SB
#undef PG8_STAGE
#undef PG8_LDA
#undef PG8_LDB
#undef PG8_MMA
#undef PG8_WAIT_V
#undef PG8_WAIT_L
#undef PG8_BAR
#undef PG8_SCHED
}
#define PG8_EPI_DEFAULTS static constexpr bool INIT = false, MIDFIX = false, APERM = false; __device__ __forceinline__ size_t bt_off(const Unit&) const { return 0; } __device__ __forceinline__ ptrdiff_t a_off(const Unit&) const { return 0; }
#ifndef LDH
#define LDH 4096
#endif
#ifdef NT_STORES
#define EPI_ST(T, p, v) __builtin_nontemporal_store((T)(v), (T*)(p))
#elif defined(NO_EPI_ST)
#define EPI_ST(T, p, v) do { T v_ = (v); asm volatile("" :: "v"(v_), "v"(p)); } while (0)
#else
#define EPI_ST(T, p, v) (*(T*)(p) = (v))
#endif
#ifndef H_ROWMAJOR
#define H_TILED
#define HNBLK 129
#else
#define HNBLK 0
#endif
constexpr int CH = 16384;
constexpr float C2Q = 0.125f * 1.4426950408889634f;
__device__ __forceinline__ u32x4 pack8(const f32x4& a, const f32x4& b) { u32x4 w; w.x = cvt_pk_bf16(a[0], a[1]); w.y = cvt_pk_bf16(a[2], a[3]); w.z = cvt_pk_bf16(b[0], b[1]); w.w = cvt_pk_bf16(b[2], b[3]); return w; }
__device__ __forceinline__ f32x4 bf4lo(const u32x4& w) { return (f32x4){__uint_as_float(w.x << 16), __uint_as_float(w.x & 0xffff0000u), __uint_as_float(w.y << 16), __uint_as_float(w.y & 0xffff0000u)}; }
__device__ __forceinline__ f32x4 bf4hi(const u32x4& w) { return (f32x4){__uint_as_float(w.z << 16), __uint_as_float(w.z & 0xffff0000u), __uint_as_float(w.w << 16), __uint_as_float(w.w & 0xffff0000u)}; }
__device__ __forceinline__ int batch_of(int m) { return m < 16384 ? (m >> 12) : 4 + ((m - 16384) >> 13); }

#ifdef P1_NOCLASS
#define P1DR(x) lr
#else
#define P1DR(x) (x)
#endif
struct P1Order {
    int chunk, G, c;
    __device__ __forceinline__ bool next(int i, Unit& u) const {
        const int nwg = chunk == 0 ? 2432 : 2304, nN = chunk == 0 ? 38 : 36; const long L = (long)i * G + c; if (L >= nwg + (chunk == 0 ? 128 : 0)) return false;
        if (L >= nwg) { const int t = (int)L - nwg, x = t & 7, s = t >> 3; u.pm = 64 + 8 * x + (s & 7); u.pn = 30 + (s >> 3); return true; }
        int wgid = (int)L; { const int q = nwg / NXCD, xcd = wgid % NXCD, off = wgid / NXCD; const int rot = ((xcd >> 1) * (q >> 2)) & ~7;
            const int o2 = (off + rot) % q; wgid = xcd * q + ((xcd & 1) ? q - 1 - o2 : o2); }
        const int nig = WGM * nN, fm = (wgid / nig) * WGM; int pn = (wgid % nig) / WGM; if (chunk == 1 && pn >= 30) pn += 2;
        u.pm = fm + ((wgid % nig) % WGM); u.pn = pn; return true;
    }
    __device__ __forceinline__ void a_ready(const Unit&) const {}
    __device__ __forceinline__ void done(const Unit&) const {}
};
constexpr size_t GTX_OFF = ((size_t)(420 - 282) << 20) / 2;
struct EpiProj {
    static constexpr bool PERM = true, AFTER_DRAIN = false, INIT = false, MIDFIX = false, APERM = true;
    __device__ __forceinline__ size_t bt_off(const Unit&) const { return 0; } __device__ __forceinline__ ptrdiff_t a_off(const Unit&) const { return 0; }
    __device__ __forceinline__ int a_lgr(const Unit& u) const { return (u.pn >= 12 && u.pn < 30) ? 2 * ((u.pn - 12) / 6) : 0; }
#define P1ROW(ai, m) (u.pm * BM + (lgr ? ((((ai) * HALF + wr * 64 + (m) * 16 + fr) >> (8 - lgr)) + ((((ai) * HALF + wr * 64 + (m) * 16 + fr) & ((1 << (8 - lgr)) - 1)) << lgr)) : ((ai) * HALF + wr * 64 + (m) * 16 + fr)))
    bf16_t *QK, *VA, *DIL, *GT; const PG8_LAS float* gl; int S, lgS;
    __device__ __forceinline__ void operator()(const f32x4 (&acc)[2][2][4][2], const Unit& u, int wr, int wc, int fr_in, int fq) const {
        int fr = fr_in; asm volatile("" : "+v"(fr));
        const int pn = u.pn, lrb = (u.pm & 63) * BM + wr * 64 + fr;
        int kind, lgr = 0; bf16_t* dst; const PG8_LAS float* gain = gl;
        if (pn < 8) { const int which = pn >> 1, head = (pn & 1) * 4 + wc; kind = 0; gain = gl + (which < 2 ? 0 : 64); dst = QK + (size_t)(which * 8 + head) * ((size_t)CH * 64); }
        else if (pn < 12) { const int head = (pn - 8) * 2 + (wc >> 1); kind = 1; dst = VA + (size_t)head * ((size_t)CH * 128) + (2 * (wc & 1)) * 2048 + 8 * fq; }
        else if (pn < 30) { const int idx = pn - 12, g = idx / 6, part = (idx % 6) >> 1, head = (idx & 1) * 4 + wc; lgr = 2 * g;
            dst = DIL + (size_t)((g * 3 + part) * 8 + head) * ((size_t)CH * 64);
            if (part < 2) { kind = 0; gain = gl + (part == 0 ? 128 : 320) + 64 * g; } else { kind = 2; dst += 8 * fq; } }
        else { kind = 3; dst = GT + (u.pm >= 64 ? GTX_OFF : (size_t)0) + (size_t)((pn - 30) * 16 + 4 * wc + fq) * 512; }
        const int Sm = S - 1, rm = (1 << lgr) - 1, lsh = lgS - lgr;
        if (kind == 0) {
            f32x4 gv[2][2];
#pragma unroll
            for (int bj = 0; bj < 2; ++bj)
#pragma unroll
                for (int n = 0; n < 2; ++n) gv[bj][n] = *(const PG8_LAS f32x4*)(gain + 32 * bj + 8 * fq + 4 * n);
#pragma unroll
            for (int ai = 0; ai < 2; ++ai)
#pragma unroll
                for (int m = 0; m < 4; ++m) {
                    const int lr = P1ROW(ai, m), t = lr & Sm, dr = P1DR((lr & ~Sm) + ((t & rm) << lsh) + (t >> lgr));
                    float ss = 0.f;
#pragma unroll
                    for (int bj = 0; bj < 2; ++bj)
#pragma unroll
                        for (int n = 0; n < 2; ++n) { const f32x4 x = acc[ai][bj][m][n]; ss += (x[0] * x[0] + x[1] * x[1]) + (x[2] * x[2] + x[3] * x[3]); }
                    ss += swz_xor<16>(ss); ss = add_x32(ss);
                    const float rs = __builtin_amdgcn_rsqf(ss * (1.0f / 64.0f) + 1e-6f);
                    bf16_t* rowp = dst + (size_t)(dr >> 6) * 4096 + fq * 512 + (dr & 63) * 8;
#pragma unroll
                    for (int bj = 0; bj < 2; ++bj) EPI_ST(u32x4, (rowp + bj * 2048), pack8(acc[ai][bj][m][0] * rs * gv[bj][0], acc[ai][bj][m][1] * rs * gv[bj][1]));
                }
        } else if (kind == 1) {
#pragma unroll
            for (int ai = 0; ai < 2; ++ai)
#pragma unroll
                for (int m = 0; m < 4; ++m) {
                    const int lr = lrb + ai * HALF + m * 16;
                    bf16_t* rowp = dst + (size_t)(lr >> 6) * 8192 + ((lr & 63) >> 4) * 512 + (lr & 15) * 32;
#pragma unroll
                    for (int bj = 0; bj < 2; ++bj) EPI_ST(u32x4, (rowp + bj * 2048), pack8(acc[ai][bj][m][0], acc[ai][bj][m][1]));
                }
        } else if (kind == 2) {
#pragma unroll
            for (int ai = 0; ai < 2; ++ai)
#pragma unroll
                for (int m = 0; m < 4; ++m) {
                    const int lr = P1ROW(ai, m), t = lr & Sm, dr = P1DR((lr & ~Sm) + ((t & rm) << lsh) + (t >> lgr));
                    const int hi8 = (fr >> 3) & 1;
                    const u32x4 w0 = pack8(acc[ai][0][m][0], acc[ai][0][m][1]), w1 = pack8(acc[ai][1][m][0], acc[ai][1][m][1]), snd = hi8 ? w0 : w1;
                    u32x4 rcv; rcv.x = (unsigned)__builtin_amdgcn_mov_dpp((int)snd.x, 0x128, 0xF, 0xF, true); rcv.y = (unsigned)__builtin_amdgcn_mov_dpp((int)snd.y, 0x128, 0xF, 0xF, true);
                    rcv.z = (unsigned)__builtin_amdgcn_mov_dpp((int)snd.z, 0x128, 0xF, 0xF, true); rcv.w = (unsigned)__builtin_amdgcn_mov_dpp((int)snd.w, 0x128, 0xF, 0xF, true);
                    bf16_t* rowp = dst + (size_t)(dr - 8 * hi8) * 64 + 32 * hi8;
                    EPI_ST(u32x4, rowp, (hi8 ? rcv : w0));
                    EPI_ST(u32x4, (rowp + 8 * 64), (hi8 ? w1 : rcv));
                }
        } else {
#pragma unroll
            for (int ai = 0; ai < 2; ++ai)
#pragma unroll
                for (int m = 0; m < 4; ++m) {
                    const int lr = lrb + ai * HALF + m * 16;
                    bf16_t* rowp = dst + (size_t)(lr >> 6) * (128 * 512) + (lr & 63) * 8;
                    f32x4 r0, r1, s0, s1;
#pragma unroll
                    for (int i = 0; i < 4; ++i) {
                        const float ea0 = __builtin_amdgcn_exp2f(fminf(-1.4426950408889634f * acc[ai][0][m][0][i], 64.f)), ea1 = __builtin_amdgcn_exp2f(fminf(-1.4426950408889634f * acc[ai][0][m][1][i], 64.f));
                        const float eb0 = __builtin_amdgcn_exp2f(fminf(-1.4426950408889634f * acc[ai][1][m][0][i], 64.f)), eb1 = __builtin_amdgcn_exp2f(fminf(-1.4426950408889634f * acc[ai][1][m][1][i], 64.f));
                        s0[i] = __builtin_amdgcn_rcpf(1.0f + eb0); s1[i] = __builtin_amdgcn_rcpf(1.0f + eb1);
                        r0[i] = (1.0f + eb0) * __builtin_amdgcn_rcpf(1.0f + ea0); r1[i] = (1.0f + eb1) * __builtin_amdgcn_rcpf(1.0f + ea1); }
                    EPI_ST(u32x4, rowp, pack8(r0, r1));
                    EPI_ST(u32x4, (rowp + (size_t)CH * 1024), pack8(s0, s1));
                }
        }
    }
};
struct EpiBrC {
    static constexpr bool PERM = true, AFTER_DRAIN = false, INIT = false, MIDFIX = true, APERM = false;
    bf16_t* MG; const bf16_t* GR0; const bf16_t* GS0; const bf16_t* GR1; const bf16_t* GS1; ptrdiff_t aoff1; int fix_t;
    __device__ __forceinline__ size_t bt_off(const Unit&) const { return 0; }
    __device__ __forceinline__ ptrdiff_t a_off(const Unit& u) const { return u.pm >= 64 ? aoff1 : 0; }
    __device__ __forceinline__ void midfix(f32x4 (&acc)[2][2][4][2], const Unit& u, int wr, int wc, int fr_in, int fq) const {
        int fr = fr_in; asm volatile("" : "+v"(fr));
        const int row0 = (u.pm & 63) * BM + wr * 64 + fr, col0 = u.pn * BM + wc * 32 + 8 * fq; const bf16_t* GR = u.pm >= 64 ? GR1 : GR0;
        u32x4 gr[2][4][2];
#pragma unroll
        for (int ai = 0; ai < 2; ++ai)
#pragma unroll
            for (int m = 0; m < 4; ++m) { const int lr = row0 + ai * HALF + m * 16;
                const bf16_t* gp = GR + (size_t)(lr >> 6) * (128 * 512) + (size_t)(col0 >> 3) * 512 + (lr & 63) * 8;
#pragma unroll
                for (int bj = 0; bj < 2; ++bj) gr[ai][m][bj] = *(const u32x4*)(gp + bj * (16 * 512)); }
#pragma unroll
        for (int ai = 0; ai < 2; ++ai)
#pragma unroll
            for (int m = 0; m < 4; ++m)
#pragma unroll
                for (int bj = 0; bj < 2; ++bj) { acc[ai][bj][m][0] *= bf4lo(gr[ai][m][bj]); acc[ai][bj][m][1] *= bf4hi(gr[ai][m][bj]); }
    }
    __device__ __forceinline__ void operator()(const f32x4 (&acc)[2][2][4][2], const Unit& u, int wr, int wc, int fr, int fq) const {
        const int row0 = u.pm * BM + wr * 64 + fr, lrow0 = (u.pm & 63) * BM + wr * 64 + fr, col0 = u.pn * BM + wc * 32 + 8 * fq; const bf16_t* GS = u.pm >= 64 ? GS1 : GS0;
#pragma unroll
        for (int ai = 0; ai < 2; ++ai) {
            u32x4 gw[4][2];
#pragma unroll
            for (int m = 0; m < 4; ++m) { const int lr = lrow0 + ai * HALF + m * 16;
                const bf16_t* gp = GS + (size_t)(lr >> 6) * (128 * 512) + (size_t)(col0 >> 3) * 512 + (lr & 63) * 8;
#pragma unroll
                for (int bj = 0; bj < 2; ++bj) gw[m][bj] = *(const u32x4*)(gp + bj * (16 * 512)); }
#pragma unroll
            for (int m = 0; m < 4; ++m) { bf16_t* mp = MG + a_tiled(row0 + ai * HALF + m * 16, col0, 32);
#pragma unroll
                for (int bj = 0; bj < 2; ++bj) EPI_ST(u32x4, (mp + bj * (4 * 512)), pack8(acc[ai][bj][m][0] * bf4lo(gw[m][bj]), acc[ai][bj][m][1] * bf4hi(gw[m][bj]))); }
        }
    }
};
struct EpiWo {
    static constexpr bool PERM = true, AFTER_DRAIN = false; PG8_EPI_DEFAULTS
    const float *xp, *xs; float* out; bf16_t* A2; const float *mod, *n2g; float* rowss;
    __device__ __forceinline__ void operator()(const f32x4 (&acc)[2][2][4][2], const Unit& u, int wr, int wc, int fr, int fq) const {
        const int m0 = u.pm * BM, b = batch_of(m0), row0 = m0 + wr * 64 + fr, col0 = u.pn * BM + wc * 32 + 8 * fq;
        const float* xb = m0 < 16384 ? xp : xs - (size_t)16384 * 1024;
        const float* g1p = mod + b * 6144 + 2048 + col0; const float* s2p = mod + b * 6144 + 4096 + col0; const float* ngp = n2g + col0;
        f32x4 g1[2][2], gm[2][2];
#pragma unroll
        for (int bj = 0; bj < 2; ++bj)
#pragma unroll
            for (int n = 0; n < 2; ++n) { g1[bj][n] = *(const f32x4*)(g1p + bj * HALF + 4 * n); gm[bj][n] = *(const f32x4*)(ngp + bj * HALF + 4 * n) * (*(const f32x4*)(s2p + bj * HALF + 4 * n) + 1.0f); }
#pragma unroll
        for (int ai = 0; ai < 2; ++ai)
#pragma unroll
          for (int mh = 0; mh < 4; mh += 2) { f32x4 xv[4][2][2];
#pragma unroll
            for (int m = mh; m < mh + 2; ++m)
#pragma unroll
                for (int bj = 0; bj < 2; ++bj) { const float* p = xb + (size_t)(row0 + ai * HALF + m * 16) * 1024 + col0 + bj * HALF; xv[m][bj][0] = *(const f32x4*)p; xv[m][bj][1] = *(const f32x4*)(p + 4); }
#pragma unroll
            for (int m = mh; m < mh + 2; ++m) { const int r = row0 + ai * HALF + m * 16; const size_t off = (size_t)r * 1024 + col0; float ss = 0.f;
#pragma unroll
                for (int bj = 0; bj < 2; ++bj) {
                    const f32x4 y0 = xv[m][bj][0] + g1[bj][0] * acc[ai][bj][m][0], y1 = xv[m][bj][1] + g1[bj][1] * acc[ai][bj][m][1];
                    *(f32x4*)(out + off + bj * HALF) = y0; *(f32x4*)(out + off + bj * HALF + 4) = y1;
                    ss += (y0[0] * y0[0] + y0[1] * y0[1]) + (y0[2] * y0[2] + y0[3] * y0[3]) + (y1[0] * y1[0] + y1[1] * y1[1]) + (y1[2] * y1[2] + y1[3] * y1[3]);
                    EPI_ST(u32x4, (A2 + a_tiled(r, col0 + bj * HALF, 32)), pack8(y0 * gm[bj][0], y1 * gm[bj][1]));     }
                ss += swz_xor<16>(ss); ss = add_x32(ss);
                if (fq == 0) atomicAdd(rowss + r, ss); } }
    }
};
struct EpiUp {
    static constexpr bool PERM = true, AFTER_DRAIN = false; PG8_EPI_DEFAULTS
    bf16_t* H; const float *rowss, *sbias;
    __device__ __forceinline__ static u32x4 swap1(const u32x4& v) {
        u32x4 r; r.x = (unsigned)__builtin_amdgcn_mov_dpp((int)v.x, 0xB1, 0xF, 0xF, true); r.y = (unsigned)__builtin_amdgcn_mov_dpp((int)v.y, 0xB1, 0xF, 0xF, true);
        r.z = (unsigned)__builtin_amdgcn_mov_dpp((int)v.z, 0xB1, 0xF, 0xF, true); r.w = (unsigned)__builtin_amdgcn_mov_dpp((int)v.w, 0xB1, 0xF, 0xF, true); return r; }
    __device__ __forceinline__ void operator()(const f32x4 (&acc)[2][2][4][2], const Unit& u, int wr, int wc, int fr, int fq) const {
        const int m0 = u.pm * BM, b = batch_of(m0), row0 = m0 + wr * 64 + fr, col0 = u.pn * BM + wc * 64 + 8 * fq, odd = fr & 1;
        f32x4 sb[2][2];
#pragma unroll
        for (int bj = 0; bj < 2; ++bj)
#pragma unroll
            for (int n = 0; n < 2; ++n) sb[bj][n] = *(const f32x4*)(sbias + b * 4096 + col0 + bj * 32 + 4 * n);
        float rsv[2][4];
#pragma unroll
        for (int ai = 0; ai < 2; ++ai)
#pragma unroll
            for (int m = 0; m < 4; ++m) rsv[ai][m] = rowss[row0 + ai * HALF + m * 16];
#pragma unroll
        for (int ai = 0; ai < 2; ++ai)
#pragma unroll
            for (int m = 0; m < 4; ++m) { const int r = row0 + ai * HALF + m * 16; const float rs = __builtin_amdgcn_rsqf(rsv[ai][m] * (1.0f / 1024.0f) + 1e-6f);
                u32x4 w[2];
#pragma unroll
                for (int bj = 0; bj < 2; ++bj) { f32x4 v0 = acc[ai][bj][m][0] * rs + sb[bj][0], v1 = acc[ai][bj][m][1] * rs + sb[bj][1];
#pragma unroll
                    for (int i = 0; i < 4; ++i) { v0[i] = fmaxf(v0[i], 0.f); v1[i] = fmaxf(v1[i], 0.f); }
                    w[bj] = pack8(v0 * v0, v1 * v1); }
#ifdef H_TILED
                bf16_t* rowp = H + a_tiled(r, col0, HNBLK);
                EPI_ST(u32x4, rowp, w[0]); EPI_ST(u32x4, (rowp + 512), w[1]); (void)odd; }
#else
                const u32x4 snd = odd ? w[0] : w[1], rcv = swap1(snd);
                bf16_t* rowp = H + (size_t)(r - odd) * LDH + col0 + 32 * odd;
                EPI_ST(u32x4, rowp, (odd ? rcv : w[0]));
                EPI_ST(u32x4, (rowp + LDH), (odd ? w[1] : rcv)); }
#endif
    }
};
struct EpiDown {
    static constexpr bool PERM = false, AFTER_DRAIN = false; PG8_EPI_DEFAULTS
    float* out; const float* mod;
    __device__ __forceinline__ void operator()(const f32x4 (&acc)[2][2][4][2], const Unit& u, int wr, int wc, int fr, int fq) const {
        const int m0 = u.pm * BM, b = batch_of(m0), row0 = m0 + wr * 64 + fr, col0 = u.pn * BM + wc * 32 + 4 * fq;
        const float* g2p = mod + b * 6144 + 5120 + col0;
        f32x4 g2[2][2];
#pragma unroll
        for (int bj = 0; bj < 2; ++bj)
#pragma unroll
            for (int n = 0; n < 2; ++n) g2[bj][n] = *(const f32x4*)(g2p + bj * HALF + 16 * n);
#pragma unroll
        for (int ai = 0; ai < 2; ++ai) { f32x4 ov[4][2][2];
#pragma unroll
            for (int m = 0; m < 4; ++m)
#pragma unroll
                for (int bj = 0; bj < 2; ++bj) { const float* p = out + (size_t)(row0 + ai * HALF + m * 16) * 1024 + col0 + bj * HALF; ov[m][bj][0] = *(const f32x4*)p; ov[m][bj][1] = *(const f32x4*)(p + 16); }
#pragma unroll
            for (int m = 0; m < 4; ++m) { float* rowp = out + (size_t)(row0 + ai * HALF + m * 16) * 1024 + col0;
#pragma unroll
                for (int bj = 0; bj < 2; ++bj) { *(f32x4*)(rowp + bj * HALF) = ov[m][bj][0] + g2[bj][0] * acc[ai][bj][m][0]; *(f32x4*)(rowp + bj * HALF + 16) = ov[m][bj][1] + g2[bj][1] * acc[ai][bj][m][1]; } } }
    }
};
}
namespace att {
#define LASC __attribute__((address_space(3)))
typedef unsigned short bf16;
typedef short bf16x8 __attribute__((ext_vector_type(8)));
typedef short s16x4 __attribute__((ext_vector_type(4)));
typedef short v4i16_t __attribute__((ext_vector_type(4)));
typedef float f32x16 __attribute__((ext_vector_type(16)));
typedef float f32x4 __attribute__((ext_vector_type(4)));
typedef unsigned u32x4 __attribute__((ext_vector_type(4)));
typedef float f32x2_t __attribute__((ext_vector_type(2))); typedef __bf16 bf16x2_t __attribute__((ext_vector_type(2)));
constexpr int CH = 16384;
constexpr float LOG2E = 1.4426950408889634f;
__device__ __forceinline__ int crow(int r, int hi) { return (r & 3) + 8 * (r >> 2) + 4 * hi; }
__device__ __forceinline__ unsigned cvtpk(float lo, float hi) { f32x2_t v = {lo, hi}; bf16x2_t b = __builtin_convertvector(v, bf16x2_t); return __builtin_bit_cast(unsigned, b); }
__device__ __forceinline__ s16x4 vtr(const LASC unsigned char* p) { return __builtin_bit_cast(s16x4, __builtin_amdgcn_ds_read_tr16_b64_v4i16((LASC v4i16_t*)p)); }
#ifndef BK_SH
#define BK_SH 0
#endif
__device__ __forceinline__ int rel_bucket(int rel) {
    const int n = rel < 0 ? -rel : rel; const int ret = rel > 0 ? 16 : 0;
    int v;
    if (n < 8) v = n; else if (n < 12) v = 8; else if (n < 16 + BK_SH) v = 9; else if (n < 23) v = 10; else if (n < 32 + BK_SH) v = 11; else if (n < 46) v = 12; else if (n < 64 + BK_SH) v = 13; else if (n < 91) v = 14; else v = 15;
    return ret + v;
}
__device__ __forceinline__ bf16x8 pack_frag(const f32x16& p, int base) {
    u32x4 w; w.x = cvtpk(p[base], p[base + 1]); w.y = cvtpk(p[base + 2], p[base + 3]); w.z = cvtpk(p[base + 4], p[base + 5]); w.w = cvtpk(p[base + 6], p[base + 7]);
    return __builtin_bit_cast(bf16x8, w);
}
constexpr int DA_K = 0, DA_V = 32768;
constexpr int DA_Q = 81920;
constexpr int DA_BT = 147456;
constexpr int DA_WS = 149504;
constexpr int SC_OFF = 155648;
constexpr int DL_VS = 136192;
constexpr int DL_N = 0, DL_D = 131072, DL_T = 131072 + 2048;

__device__ __forceinline__ void da_epilogue(LASC unsigned char* lds, bf16* YA, const float* subln_g, f32x16 (&o1)[4], f32x16 (&o2)[4], float l1, float l2, float lam, int head, int tile0, int qb, int wid);
#define SBAR() __builtin_amdgcn_sched_barrier(0)
__device__ __forceinline__ int lane_now() { int l; asm volatile("v_mbcnt_lo_u32_b32 %0, -1, 0\n\tv_mbcnt_hi_u32_b32 %0, -1, %0" : "=v"(l)); return l; }
__device__ __forceinline__ void da_unit(LASC unsigned char* lds, const bf16* QK, const bf16* VA, bf16* YA, const float* rel_bias, const float* subln_g,
                                        int head, int tile0, int NT, int qb, int tid_in, float* tprobe = nullptr) {
    int tid = tid_in; asm volatile("" : "+v"(tid));
    const int lane = tid & 63, r32 = lane & 31, hi = lane >> 5; const int wid = __builtin_amdgcn_readfirstlane(tid >> 6);
    LASC float* BT = (LASC float*)(lds + DA_BT); const LASC float* SC = (const LASC float*)(lds + SC_OFF);
    const float lam = __builtin_bit_cast(float, __builtin_amdgcn_readfirstlane(__builtin_bit_cast(int, SC[0])));
    if (tid < 448) { const int rel = tid - 224; BT[tid] = rel_bias[rel_bucket(rel) * 32 + head] * LOG2E; }
    const bf16* Q1h = QK + (size_t)(0 * 8 + head) * ((size_t)CH * 64); const bf16* Q2h = QK + (size_t)(1 * 8 + head) * ((size_t)CH * 64);
    const bf16* K1h = QK + (size_t)(2 * 8 + head) * ((size_t)CH * 64) + (size_t)tile0 * 4096; const bf16* K2h = QK + (size_t)(3 * 8 + head) * ((size_t)CH * 64) + (size_t)tile0 * 4096;
    const bf16* Vh = VA + (size_t)head * ((size_t)CH * 128) + (size_t)tile0 * 8192;
#define DA_GLDS(SRC, DST) do { unsigned keep_; const unsigned dst_ = (unsigned)__builtin_amdgcn_readfirstlane((int)(unsigned)(uintptr_t)(DST)); \
        asm volatile("s_mov_b32 %0, m0\n\ts_mov_b32 m0, %2\n\ts_nop 0\n\tglobal_load_lds_dwordx4 %1, off\n\ts_mov_b32 m0, %0" : "=&s"(keep_) : "v"(SRC), "s"(dst_) : "memory"); } while (0)
#define DA_DMA1(t, pc) do { LASC unsigned char* dk_ = lds + DA_K + ((t) & 1) * 16384 + (pc) * 1024; LASC unsigned char* dv_ = lds + DA_V + ((t) % 3) * 16384 + (pc) * 1024; \
        const char* k1_ = (const char*)K1h + (size_t)(t) * 8192 + (pc) * 1024; const char* k2_ = (const char*)K2h + (size_t)(t) * 8192 + (pc) * 1024; const char* v_ = (const char*)Vh + (size_t)(t) * 16384 + (pc) * 1024;     \
        DA_GLDS(k1_ + lo_, dk_); DA_GLDS(k2_ + lo_, dk_ + 8192); DA_GLDS(v_ + lo_, dv_); DA_GLDS(v_ + 8192 + lo_, dv_ + 8192); } while (0)
#ifndef DA_DMA_ALL
#define DA_DMA(t) do { if (wid < 4) { const unsigned lo_ = (unsigned)lane_now() * 16u; DA_DMA1(t, wid); DA_DMA1(t, wid + 4); } } while (0)
#else
#define DA_DMA(t) do { const unsigned lo_ = (unsigned)lane_now() * 16u; DA_DMA1(t, wid); } while (0)
#endif
    DA_DMA(0);
    bf16x8 q1f[4], q2f[4];
    { const int tq = tile0 + 4 * qb + (wid >> 1), rq = (wid & 1) * 32 + r32;
#pragma unroll
      for (int ks = 0; ks < 4; ++ks) { q1f[ks] = *(const bf16x8*)(Q1h + (size_t)tq * 4096 + (2 * ks + hi) * 512 + rq * 8); q2f[ks] = *(const bf16x8*)(Q2h + (size_t)tq * 4096 + (2 * ks + hi) * 512 + rq * 8); } }
#pragma unroll
    for (int ks = 0; ks < 4; ++ks) asm volatile("" : "+v"(q1f[ks]), "+v"(q2f[ks]));
    f32x16 o1[4], o2[4];
#pragma unroll
    for (int d = 0; d < 4; ++d) { o1[d] = f32x16{}; o2[d] = f32x16{}; }
    float l1 = 0.f, l2 = 0.f;
    asm volatile("s_waitcnt vmcnt(0)" ::: "memory");
    __syncthreads();
    const int qw0 = 256 * qb + 32 * wid;
    const int tL = (qw0 >= 191) ? ((qw0 - 191) >> 6) : -1, tR = (qw0 + 159 + 63) >> 6;
    const float fLN = __builtin_bit_cast(float, __builtin_amdgcn_readfirstlane(__builtin_bit_cast(int, __builtin_amdgcn_exp2f(BT[0])))), fNR = __builtin_bit_cast(float, __builtin_amdgcn_readfirstlane(__builtin_bit_cast(int, __builtin_amdgcn_exp2f(-BT[447]))));
    bf16x8 paA1[2], paA2[2], paB1[2], paB2[2];
#pragma unroll
    for (int i = 0; i < 2; ++i) { paB1[i] = bf16x8{}; paB2[i] = bf16x8{}; }
#define DA_NEARC(S_, HALF_) do { const int lnn_ = lane_now(); const LASC float* bt_ = BT + (64 * t + 32 * (HALF_) - (qw0 + (lnn_ & 31)) + 4 * (lnn_ >> 5) + 224); \
        { unsigned bti_ = (unsigned)(uintptr_t)bt_; asm volatile("" : "+v"(bti_)); bt_ = (const LASC float*)(uintptr_t)bti_; }     \
        _Pragma("unroll") for (int r = 0; r < 16; ++r) S_[r] = bt_[(r & 3) + 8 * (r >> 2)]; } while (0)
#define DA_VRD(DST, F_) do { const s16x4 lo_ = vtr(vp + ((F_) >> 1) * 4096 + ((F_) & 1) * 1024), hh_ = vtr(vp + ((F_) >> 1) * 4096 + ((F_) & 1) * 1024 + 512); DST = (bf16x8){lo_[0], lo_[1], lo_[2], lo_[3], hh_[0], hh_[1], hh_[2], hh_[3]}; } while (0)
#ifdef DA_XMFMA
#define DA_XM() do { f32x16 sx_ = __builtin_amdgcn_mfma_f32_32x32x16_bf16(kfB[0], qfB[0], (f32x16){}, 0, 0, 0); _Pragma("unroll") for (int xk = 1; xk < DA_XMFMA; ++xk) sx_ = __builtin_amdgcn_mfma_f32_32x32x16_bf16(kfB[xk & 3], qfB[xk & 3], sx_, 0, 0, 0); asm volatile("" :: "v"(sx_)); } while (0)
#else
#define DA_XM() do {} while (0)
#endif
#ifdef DA_XVALU
#define DA_XV(g) do { float x0_ = __builtin_amdgcn_exp2f(s2[(g)] * 0.5f), x1_ = __builtin_amdgcn_exp2f(s2[(g)] * 0.25f); asm volatile("" :: "v"(x0_), "v"(x1_)); } while (0)
#else
#define DA_XV(g) do {} while (0)
#endif
#define DA_STEP(KS, HALF, VP, PI1, PI2, PO1, PO2) do { \
        f32x16 s1, s2; const LASC unsigned char* vp; const LASC unsigned char* kb; \
        { kb = (KS) + klane_ + (HALF) * 512; vp = (VP) + vlane_; \
          { unsigned vpi_ = (unsigned)(uintptr_t)vp; asm volatile("" : "+v"(vpi_)); vp = (const LASC unsigned char*)(uintptr_t)vpi_; } }     \
        { bf16x8 kf[4]; \
          _Pragma("unroll") for (int ks = 0; ks < 4; ++ks) kf[ks] = *(const LASC bf16x8*)(kb + ks * 2048); \
          if (near) { DA_NEARC(s1, HALF); s1 = __builtin_amdgcn_mfma_f32_32x32x16_bf16(kf[0], q1f[0], s1, 0, 0, 0); } \
          else s1 = __builtin_amdgcn_mfma_f32_32x32x16_bf16(kf[0], q1f[0], (f32x16){}, 0, 0, 0); \
          _Pragma("unroll") for (int ks = 1; ks < 4; ++ks) s1 = __builtin_amdgcn_mfma_f32_32x32x16_bf16(kf[ks], q1f[ks], s1, 0, 0, 0); \
          SBAR(); \
          _Pragma("unroll") for (int ks = 0; ks < 4; ++ks) kf[ks] = *(const LASC bf16x8*)(kb + 8192 + ks * 2048); \
          DA_VRD(vf[0], 0); \
          if (near) { DA_NEARC(s2, HALF); s2 = __builtin_amdgcn_mfma_f32_32x32x16_bf16(kf[0], q2f[0], s2, 0, 0, 0); } \
          else s2 = __builtin_amdgcn_mfma_f32_32x32x16_bf16(kf[0], q2f[0], (f32x16){}, 0, 0, 0); \
          _Pragma("unroll") for (int ks = 1; ks < 4; ++ks) s2 = __builtin_amdgcn_mfma_f32_32x32x16_bf16(kf[ks], q2f[ks], s2, 0, 0, 0); DA_XM(); } \
        SBAR(); \
        { float sa = 0.f, sb = 0.f; u32x4 w1a, w1b, w2a, w2b; float pe0 = 0.f, pe1 = 0.f; \
            \
            \
          _Pragma("unroll") for (int g = 0; g < 16; ++g) { const int f = g >> 1, d0 = f >> 1, ks = f & 1, sm = g & 1; \
              if (sm == 0) { if (f + 1 < 8) DA_VRD(vf[(f + 1) & 1], f + 1); o1[d0] = __builtin_amdgcn_mfma_f32_32x32x16_bf16(PI1[ks], vf[f & 1], o1[d0], 0, 0, 0); } \
              else o2[d0] = __builtin_amdgcn_mfma_f32_32x32x16_bf16(PI2[ks], vf[f & 1], o2[d0], 0, 0, 0); \
              DA_XV(g); \
              const float e0 = __builtin_amdgcn_exp2f(g < 8 ? s1[2 * (g & 7)] : s2[2 * (g & 7)]), e1 = __builtin_amdgcn_exp2f(g < 8 ? s1[2 * (g & 7) + 1] : s2[2 * (g & 7) + 1]); \
              if (g > 0) { const int h = g - 1; unsigned w = cvtpk(pe0, pe1); \
                  if (h < 8) { sa += pe0; sa += pe1; asm volatile("" : "+v"(w), "+v"(sa)); if (h < 4) w1a[h & 3] = w; else w1b[h & 3] = w; } \
                  else { sb += pe0; sb += pe1; asm volatile("" : "+v"(w), "+v"(sb)); if (h < 12) w2a[h & 3] = w; else w2b[h & 3] = w; } } \
              pe0 = e0; pe1 = e1; asm volatile("" : "+v"(pe0), "+v"(pe1)); \
              SBAR(); } \
          { unsigned w = cvtpk(pe0, pe1); sb += pe0; sb += pe1; w2b[3] = w; } \
          l1 += sa; l2 += sb; \
          PO1[0] = __builtin_bit_cast(bf16x8, w1a); PO1[1] = __builtin_bit_cast(bf16x8, w1b); PO2[0] = __builtin_bit_cast(bf16x8, w2a); PO2[1] = __builtin_bit_cast(bf16x8, w2b); } \
    } while (0)
    bf16x8 vf[2];
    unsigned klane_ = (unsigned)(hi * 1024 + r32 * 16), vlane_ = (unsigned)(((lane >> 4) & 1) * 32 + (lane & 3) * 8 + (4 * hi + ((lane & 15) >> 2)) * 64);
    asm volatile("" : "+v"(klane_), "+v"(vlane_));
#ifdef TMODE
    const unsigned long long tm0_ = __builtin_amdgcn_s_memtime(), tr0_ = __builtin_amdgcn_s_memrealtime();
#endif
#ifdef DA_PRIO
    if (wid >= 4) __builtin_amdgcn_s_setprio(DA_PRIO);
#endif
    for (int t = 0; t < NT; ++t) {
        if (t + 1 < NT) DA_DMA(t + 1);
        const bool near = (t > tL) && (t < tR);
        const bool trans = (t == tL + 1 && tL >= 0) || (t == tR);
        const float f = (t == tR) ? fNR : fLN;
        const LASC unsigned char* ks_ = lds + DA_K + (t & 1) * 16384;
        const int tp = t > 0 ? t - 1 : 0;
        const LASC unsigned char* vprev = lds + DA_V + (tp % 3) * 16384 + (t > 0 ? 2048 : 0);
        const LASC unsigned char* vcur = lds + DA_V + (t % 3) * 16384;
        if (trans) { l1 *= f; l2 *= f; }
        DA_STEP(ks_, 0, vprev, paB1, paB2, paA1, paA2);
        if (trans) {
#pragma unroll
            for (int d = 0; d < 4; ++d) { o1[d] *= f; o2[d] *= f; } }
#ifdef DA_XBAR
        __syncthreads();
#endif
        DA_STEP(ks_, 1, vcur, paA1, paA2, paB1, paB2);
        asm volatile("s_waitcnt vmcnt(0)" ::: "memory");
        __syncthreads();
    }
    { const int ln_ = lane_now(); const LASC unsigned char* vp = lds + DA_V + ((NT - 1) % 3) * 16384 + 2048 + ((ln_ >> 4) & 1) * 32 + (ln_ & 3) * 8 + (4 * (ln_ >> 5) + ((ln_ & 15) >> 2)) * 64;
#pragma unroll
      for (int d0 = 0; d0 < 4; ++d0)
#pragma unroll
          for (int ks = 0; ks < 2; ++ks) { const s16x4 lo = vtr(vp + d0 * 4096 + ks * 1024), hh = vtr(vp + d0 * 4096 + ks * 1024 + 512); const bf16x8 vf = (bf16x8){lo[0], lo[1], lo[2], lo[3], hh[0], hh[1], hh[2], hh[3]};
              o1[d0] = __builtin_amdgcn_mfma_f32_32x32x16_bf16(paB1[ks], vf, o1[d0], 0, 0, 0); o2[d0] = __builtin_amdgcn_mfma_f32_32x32x16_bf16(paB2[ks], vf, o2[d0], 0, 0, 0); } }
#ifdef DA_PRIO
    __builtin_amdgcn_s_setprio(0);
#endif
#ifdef TMODE
    { const unsigned long long tm1_ = __builtin_amdgcn_s_memtime(), tr1_ = __builtin_amdgcn_s_memrealtime(); if (tprobe && tid == 0) { tprobe[0] = (float)(tm1_ - tm0_) / (float)NT; tprobe[1] = (float)(tr1_ - tr0_) * 10.0f / (float)NT; } }
#endif
    __syncthreads();
#undef DA_DMA
#undef DA_DMA1
#undef DA_GLDS
#undef DA_STEP
#undef DA_NEARC
#undef DA_VRD
    da_epilogue(lds, YA, subln_g, o1, o2, l1, l2, lam, head, tile0, qb, wid);
}
__device__ __forceinline__ void da_epilogue(LASC unsigned char* lds, bf16* YA, const float* subln_g, f32x16 (&o1)[4], f32x16 (&o2)[4], float l1, float l2, float lam, int head, int tile0, int qb, int wid) {
    const int lane = lane_now(), r32 = lane & 31, hi = lane >> 5;
    LASC float* wsf = (LASC float*)(lds + DA_WS) + wid * 128;
    l1 = add_x32(l1); l2 = add_x32(l2);
    if (hi == 0) { wsf[r32] = l1; wsf[32 + r32] = l2; }
    asm volatile("s_waitcnt lgkmcnt(0)" ::: "memory");
    float sg[4];
#pragma unroll
    for (int d0 = 0; d0 < 4; ++d0) sg[d0] = subln_g[32 * d0 + r32] * 0.8f;
    LASC bf16* stg = (LASC bf16*)(lds + wid * 8192);
#pragma unroll
    for (int r = 0; r < 16; ++r) {
        const int row = crow(r, hi); const float i1 = __builtin_amdgcn_rcpf(wsf[row]), i2 = lam * __builtin_amdgcn_rcpf(wsf[32 + row]);
        float v[4]; float ss = 0.f;
#pragma unroll
        for (int d0 = 0; d0 < 4; ++d0) { v[d0] = o1[d0][r] * i1 - o2[d0][r] * i2; ss += v[d0] * v[d0]; }
        ss += swz_xor<1>(ss); ss += swz_xor<2>(ss); ss += swz_xor<4>(ss); ss += swz_xor<8>(ss); ss += swz_xor<16>(ss);
        const float rs = __builtin_amdgcn_rsqf(ss * (1.0f / 128.0f) + 1e-6f);
#pragma unroll
        for (int d0 = 0; d0 < 4; ++d0) stg[row * 128 + d0 * 32 + r32] = (bf16)(cvtpk(v[d0] * rs * sg[d0], 0.f) & 0xffffu);
    }
    asm volatile("s_waitcnt lgkmcnt(0)" ::: "memory");
    { bf16* Yw = YA + (size_t)((tile0 + 4 * qb) * 64 + wid * 32) * 1536 + head * 128;
#pragma unroll
      for (int i = 0; i < 8; ++i) { const int row = i * 4 + (lane >> 4), ch = lane & 15; const u32x4 v = *(const LASC u32x4*)(stg + row * 128 + ch * 8); *(u32x4*)(Yw + (size_t)row * 1536 + ch * 8) = v; } }
    __syncthreads();
}

template <bool PRE, bool ACC> __device__ __forceinline__ void dil_task(const bf16* Qh, const bf16* Kh, const bf16* Vh, int drq0, int lq0, int L, int r, int tok_base, const LASC float* DBT, LASC float* Nsum, LASC float* Dsum, LASC unsigned char* vst, int lane) {
    const int r32 = lane & 31, hi = lane >> 5;
    bf16x8 qf[4];
#pragma unroll
    for (int ks = 0; ks < 4; ++ks) qf[ks] = *(const bf16x8*)(Qh + (size_t)(drq0 >> 6) * 4096 + (2 * ks + hi) * 512 + ((drq0 & 63) + r32) * 8);
    f32x16 o[2]; o[0] = f32x16{}; o[1] = f32x16{}; float l = 0.f;
    const int vrow = lane >> 3, vch = lane & 7;
    LASC unsigned char* vw = vst + (vch >> 2) * 1024 + vrow * 64 + (vch & 3) * 16;
    const LASC unsigned char* vr = vst + ((lane >> 4) & 1) * 32 + (lane & 3) * 8 + (4 * hi + ((lane & 15) >> 2)) * 64;
    bf16x8 kc[4], kn[4]; u32x4 vc[4], vn[4];
#define DIL_LOAD(KD, VD, S5) do { const int lk_ = lq0 - 64 + 32 * (S5); const int lc_ = min(max(lk_, 0), L - 32); const int dk_ = drq0 + (lc_ - lq0); \
        _Pragma("unroll") for (int ks = 0; ks < 4; ++ks) KD[ks] = *(const bf16x8*)(Kh + (size_t)(dk_ >> 6) * 4096 + (2 * ks + hi) * 512 + ((dk_ & 63) + r32) * 8); \
        const bf16* vg_ = Vh + (size_t)(dk_ + vrow) * 64 + vch * 8; \
        _Pragma("unroll") for (int i = 0; i < 4; ++i) VD[i] = *(const u32x4*)(vg_ + i * 8 * 64); } while (0)
    DIL_LOAD(kc, vc, 0);
#pragma unroll
    for (int s5 = 0; s5 < 5; ++s5) {
        if (s5 + 1 < 5) DIL_LOAD(kn, vn, s5 + 1);
        const int lk0 = lq0 - 64 + 32 * s5;
        if (lk0 >= 0 && lk0 < L) {
            const int jb = lk0 - lq0 - r32 + 4 * hi + 96;
            f32x16 p;
#pragma unroll
            for (int rg = 0; rg < 16; ++rg) p[rg] = DBT[jb + (rg & 3) + 8 * (rg >> 2)];
#pragma unroll
            for (int ks = 0; ks < 4; ++ks) p = __builtin_amdgcn_mfma_f32_32x32x16_bf16(kc[ks], qf[ks], p, 0, 0, 0);
            float s = 0.f;
#pragma unroll
            for (int rg = 0; rg < 16; ++rg) { p[rg] = __builtin_amdgcn_exp2f(p[rg]); s += p[rg]; }
            l += s;
            const bf16x8 pa0 = pack_frag(p, 0), pa1 = pack_frag(p, 8);
#pragma unroll
            for (int ss = 0; ss < 2; ++ss) {
                *(LASC u32x4*)(vw) = vc[2 * ss]; *(LASC u32x4*)(vw + 512) = vc[2 * ss + 1];
#pragma unroll
                for (int db = 0; db < 2; ++db) { const s16x4 lo = vtr(vr + db * 1024), hh = vtr(vr + db * 1024 + 512); const bf16x8 vf = (bf16x8){lo[0], lo[1], lo[2], lo[3], hh[0], hh[1], hh[2], hh[3]};
                    o[db] = __builtin_amdgcn_mfma_f32_32x32x16_bf16(ss == 0 ? pa0 : pa1, vf, o[db], 0, 0, 0); }
            }
        }
        if (s5 + 1 < 5) {
#pragma unroll
            for (int i = 0; i < 4; ++i) { kc[i] = kn[i]; vc[i] = vn[i]; } }
    }
#undef DIL_LOAD
    l = add_x32(l);
    if (hi == 0) { LASC float* dp = Dsum + tok_base + r32 * r; *dp = ACC ? *dp + l : l; }
#pragma unroll
    for (int db = 0; db < 2; ++db)
#pragma unroll
        for (int rg = 0; rg < 16; ++rg) { LASC float* np = Nsum + (tok_base + crow(rg, hi) * r) * 64 + 32 * db + r32; *np = ACC ? *np + o[db][rg] : o[db][rg]; }
}
template <bool PRE> __device__ __forceinline__ void dil_unit(LASC unsigned char* lds, const bf16* DIL, bf16* YB, const float* rel_bias, int head, int span, int S, int lgS, int tid_in) {
    int tid = tid_in; asm volatile("" : "+v"(tid));
    const int lane = tid & 63; const int wid = __builtin_amdgcn_readfirstlane(tid >> 6);
    LASC float* Nsum = (LASC float*)(lds + DL_N); LASC float* Dsum = (LASC float*)(lds + DL_D); LASC float* DBT = (LASC float*)(lds + DL_T); const LASC float* SC = (const LASC float*)(lds + SC_OFF);
    const float M2 = SC[2];
#ifdef DIL_DELAY
    for (int dd_ = 0; dd_ < DIL_DELAY; ++dd_) __builtin_amdgcn_s_sleep(127);
#endif
    for (int i = tid; i < 600; i += 512) { const int g = i / 200, j = i % 200 - 96; const int aj = j < 0 ? -j : j;
        DBT[i] = (aj <= 64) ? rel_bias[rel_bucket(j * (1 << (2 * g))) * 32 + 8 + 8 * g + head] * LOG2E - M2 : -1e30f; }
    __syncthreads();
    const int row0 = span * 512, seqbase = row0 & ~(S - 1), t0 = row0 & (S - 1);
#pragma unroll
    for (int g = 0; g < 3; ++g) {
        const int lgr = 2 * g, r = 1 << lgr, L = S >> lgr, nblk = 16 >> lgr;
        const bf16* Qh = DIL + (size_t)((g * 3 + 0) * 8 + head) * ((size_t)CH * 64); const bf16* Kh = DIL + (size_t)((g * 3 + 1) * 8 + head) * ((size_t)CH * 64); const bf16* Vh = DIL + (size_t)((g * 3 + 2) * 8 + head) * ((size_t)CH * 64);
        for (int j = wid; j < 16; j += 8) { const int cl = j / nblk, blk = j % nblk, lq0 = (t0 >> lgr) + 32 * blk;
            if (g == 0) dil_task<PRE, false>(Qh, Kh, Vh, seqbase + cl * L + lq0, lq0, L, r, lq0 * r + cl - t0, DBT + 200 * g, Nsum, Dsum, lds + DL_VS + wid * 2048, lane);
            else dil_task<PRE, true>(Qh, Kh, Vh, seqbase + cl * L + lq0, lq0, L, r, lq0 * r + cl - t0, DBT + 200 * g, Nsum, Dsum, lds + DL_VS + wid * 2048, lane); }
        if (g < 2) __syncthreads();
    }
    __syncthreads();
#pragma unroll
    for (int i = 0; i < 8; ++i) { const int row = (tid >> 3) + 64 * i, dc = tid & 7; const float inv = 1.0f / Dsum[row];
        const f32x4 a = *(const LASC f32x4*)(Nsum + row * 64 + dc * 8), b = *(const LASC f32x4*)(Nsum + row * 64 + dc * 8 + 4);
        u32x4 w; w.x = cvtpk(a[0] * inv, a[1] * inv); w.y = cvtpk(a[2] * inv, a[3] * inv); w.z = cvtpk(b[0] * inv, b[1] * inv); w.w = cvtpk(b[2] * inv, b[3] * inv);
        *(u32x4*)(YB + (size_t)(row0 + row) * 1536 + 1024 + head * 64 + dc * 8) = w; }
    __syncthreads();
}
}
#define LAS __attribute__((address_space(3)))
typedef unsigned short bf16;
typedef unsigned v4u __attribute__((ext_vector_type(4)));
typedef float f32x4 __attribute__((ext_vector_type(4)));
constexpr int NWAVES = 8, LDS_BYTES = 163840, BST_OFF = 163840 - 64;
constexpr int TOK = 32768, DM = 1024, CH = 16384, FF = 4096, NIN = 9728;
constexpr size_t MiB = 1u << 20;
constexpr size_t WS_MOD = 1 * MiB, WS_SBIAS = WS_MOD + 160 * 1024, WS_ROWSS = WS_MOD + 320 * 1024;
constexpr size_t WS_WIN = 2 * MiB, WS_WBA = 21 * MiB, WS_WBB = 23 * MiB, WS_WO = 24 * MiB, WS_WUP = 26 * MiB, WS_WDN = 410 * MiB;
constexpr size_t WS_QK = 42 * MiB, WS_VA = 106 * MiB, WS_DIL = 138 * MiB, WS_GT = 282 * MiB, WS_MG = 346 * MiB, WS_GT1 = 420 * MiB, WS_END = 484 * MiB;
constexpr size_t WS_A2 = 42 * MiB, WS_H = 106 * MiB;
constexpr size_t DO_XN = 0, DO_YA = 64 * MiB, DO_YB = 64 * MiB;
#define LDS_WAIT() asm volatile("s_waitcnt lgkmcnt(0)" ::: "memory")
#define XB_TMO      128
#define XB_XCNT(j)  (256  + 64 * (j))
#define XB_XSUB(j)  (1280 + 64 * (j))
#define XB_XGEN(j)  (2304 + 64 * (j))
#define XB_TOP      3328
#define XB_TOPGEN   3392
#define XCD_BAR_WORDS 3456
#define XB_SPIN_CAP (1u << 18)

__device__ __forceinline__ unsigned xb_ld(unsigned* p)              { return __hip_atomic_load(p, __ATOMIC_RELAXED, __HIP_MEMORY_SCOPE_AGENT); }
__device__ __forceinline__ unsigned xb_add(unsigned* p, unsigned v) { return __hip_atomic_fetch_add(p, v, __ATOMIC_RELAXED, __HIP_MEMORY_SCOPE_AGENT); }
__device__ __forceinline__ unsigned xb_xcc_id() { return (unsigned)__builtin_amdgcn_s_getreg((3 << 11) | 20) & 0xFu; }
#define XB_SPIN(cond, bar) do { unsigned _sp = 0; while (cond) { __builtin_amdgcn_s_sleep(1); \
    if ((++_sp & 255u) == 0u) { if (xb_ld(&(bar)[XB_TMO])) break; if (_sp > XB_SPIN_CAP) { atomicAdd(&(bar)[XB_TMO], 1u); break; } } } } while (0)

struct XcdBarrier {
    unsigned* bar; unsigned x;
    volatile LAS unsigned* st;
};

__device__ __forceinline__ XcdBarrier xcd_barrier_post(unsigned* bar, volatile LAS unsigned* st) {
    XcdBarrier b; b.bar = bar; b.x = xb_xcc_id(); b.st = st;
    if (threadIdx.x == 0) (void)xb_add(&bar[XB_XCNT(b.x)], 1u);
    return b;
}
__device__ __forceinline__ void xcd_barrier_complete(unsigned* bar, unsigned x, unsigned& nloc, unsigned& nx) {
    const unsigned G = gridDim.x * gridDim.y * gridDim.z;
    unsigned sum, cnt, mine, sp = 0u;
    for (;;) {
        sum = 0u; cnt = 0u; mine = 0u;
#pragma unroll
        for (unsigned j = 0; j < 16; ++j) { const unsigned c = xb_ld(&bar[XB_XCNT(j)]); sum += c; cnt += (c > 0u) ? 1u : 0u; mine = (j == x) ? c : mine; }
        if (sum == G) break;
        __builtin_amdgcn_s_sleep(1);
        if ((++sp & 255u) == 0u) { if (xb_ld(&bar[XB_TMO])) break; if (sp > XB_SPIN_CAP) { atomicAdd(&bar[XB_TMO], 1u); break; } }
    }
    nloc = mine > 0u ? mine : 1u; nx = cnt > 0u ? cnt : 1u;
}

__device__ __forceinline__ void xcd_barrier(const XcdBarrier& b) {
    asm volatile("s_waitcnt vmcnt(0)" ::: "memory");
    __syncthreads();
    if (threadIdx.x == 0) {
        unsigned* bar = b.bar;
        __builtin_amdgcn_s_waitcnt(0);
        unsigned nloc = b.st[0], nx = b.st[1];
        if (nloc == 0u) { xcd_barrier_complete(bar, b.x, nloc, nx); b.st[0] = nloc; b.st[1] = nx; }
        const unsigned old = xb_add(&bar[XB_XSUB(b.x)], 1u);
        const unsigned gen = old / nloc;
        if (old + 1u == (gen + 1u) * nloc) {
            __builtin_amdgcn_fence(__ATOMIC_RELEASE, "agent");
            asm volatile("s_waitcnt vmcnt(0)" ::: "memory");
            const unsigned og = xb_add(&bar[XB_TOP], 1u);
            const unsigned tg = og / nx;
            if (og + 1u == (tg + 1u) * nx) xb_add(&bar[XB_TOPGEN], 1u);
            else XB_SPIN(xb_ld(&bar[XB_TOPGEN]) == tg, bar);
            __builtin_amdgcn_fence(__ATOMIC_ACQUIRE, "agent");
            xb_add(&bar[XB_XGEN(b.x)], 1u);
            asm volatile("s_waitcnt vmcnt(0)" ::: "memory");
        } else {
            XB_SPIN(xb_ld(&bar[XB_XGEN(b.x)]) == gen, bar);
            __builtin_amdgcn_fence(__ATOMIC_ACQUIRE, "agent");
            asm volatile("s_waitcnt vmcnt(0)" ::: "memory");
        }
    }
    __syncthreads();
}

__device__ __forceinline__ unsigned f2bf(float f) { unsigned u = __builtin_bit_cast(unsigned, f); return (u + 0x7fffu + ((u >> 16) & 1u)) >> 16; }
__device__ __forceinline__ unsigned pk2(float lo, float hi) { return f2bf(lo) | (f2bf(hi) << 16); }
__device__ __forceinline__ float wave_sum(float v) {
    v += swz_xor<1>(v); v += swz_xor<2>(v); v += swz_xor<4>(v); v += swz_xor<8>(v); v += swz_xor<16>(v);
    return add_x32(v);
}
__device__ __forceinline__ float wave_max(float v) {
    v = fmaxf(v, swz_xor<1>(v)); v = fmaxf(v, swz_xor<2>(v)); v = fmaxf(v, swz_xor<4>(v)); v = fmaxf(v, swz_xor<8>(v)); v = fmaxf(v, swz_xor<16>(v));
    return max_x32(v);
}
template <bool PERMW> __device__ __forceinline__ void transpose_item(const float* W, int K, int N, bf16* WT, LAS float* scr, int item, int lane, int ldk = 0, int koff = 0) {
    if (ldk == 0) ldk = K;
    const int nblk = N / 32, kb = item / nblk, nb = item % nblk, k0 = 64 * kb, n0 = 32 * nb;
#pragma unroll 8
    for (int i = 0; i < 32; ++i) { const int kk = 2 * i + (lane >> 5); scr[kk * 33 + (lane & 31)] = W[(size_t)(k0 + kk) * N + n0 + (lane & 31)]; }
    LDS_WAIT(); asm volatile("" ::: "memory");
    const int c = lane & 7;
    int n0p = n0;
    if (PERMW) { const int lg = nb & 7; n0p = (nb & ~7) * 32 + 32 * (4 * (lg & 1) + (lg >> 1));
        if (nb >= 240) { const int gi = nb - 240, isb = gi >> 5, blk = gi & 31; n0p = (30 + (blk >> 2)) * 256 + 32 * (4 * isb + (blk & 3)); } }
#pragma unroll
    for (int j = 0; j < 4; ++j) { const int n = (lane >> 3) + 8 * j; const LAS float* s = scr + (8 * c) * 33 + n;
        v4u o; o.x = pk2(s[0 * 33], s[1 * 33]); o.y = pk2(s[2 * 33], s[3 * 33]); o.z = pk2(s[4 * 33], s[5 * 33]); o.w = pk2(s[6 * 33], s[7 * 33]);
        *(v4u*)(WT + (size_t)(n0p + n) * ldk + koff + k0 + 8 * c) = o; }
    LDS_WAIT(); asm volatile("" ::: "memory");
}
__device__ __forceinline__ void transpose6_item(const float* W, int K, int N, bf16* WT6, const float* gate  , LAS float* scr, int item, int lane) {
    const int nblk = N / 32, kb = item / nblk, nb = item % nblk, k0 = 64 * kb, n0 = 32 * nb;
#pragma unroll 8
    for (int i = 0; i < 32; ++i) { const int kk = 2 * i + (lane >> 5); scr[kk * 33 + (lane & 31)] = W[(size_t)(k0 + kk) * N + n0 + (lane & 31)]; }
    LDS_WAIT(); asm volatile("" ::: "memory");
    const int c = lane & 7;
#pragma unroll
    for (int j = 0; j < 4; ++j) { const int n = (lane >> 3) + 8 * j; const LAS float* s = scr + (8 * c) * 33 + n;
        float v[8];
#pragma unroll
        for (int q = 0; q < 8; ++q) v[q] = s[q * 33];
#pragma unroll
        for (int b = 0; b < 6; ++b) { const float g = gate[b * 6144 + n0 + n];
            v4u o; o.x = pk2(v[0] * g, v[1] * g); o.y = pk2(v[2] * g, v[3] * g); o.z = pk2(v[4] * g, v[5] * g); o.w = pk2(v[6] * g, v[7] * g);
            *(v4u*)(WT6 + (size_t)b * K * N + (size_t)(n0 + n) * K + k0 + 8 * c) = o; } }
    LDS_WAIT(); asm volatile("" ::: "memory");
}
__device__ __forceinline__ void gemv6_task(const LAS float* vec, LAS f32x4* red, const float* W, int N, int col0, const float* bias, float* out, int tid) {
    const int cgp = tid & 7, ks = tid >> 3;
    f32x4 acc[6];
#pragma unroll
    for (int b = 0; b < 6; ++b) acc[b] = (f32x4){0.f, 0.f, 0.f, 0.f};
#pragma unroll 4
    for (int kk = 0; kk < 16; ++kk) { const int k = ks * 16 + kk; const f32x4 w = *(const f32x4*)(W + (size_t)k * N + col0 + 4 * cgp);
#pragma unroll
        for (int b = 0; b < 6; ++b) acc[b] += w * vec[b * 1024 + k]; }
#pragma unroll
    for (int b = 0; b < 6; ++b) red[(ks * 8 + cgp) * 6 + b] = acc[b];
    __syncthreads();
    if (tid < 192) { const int b = tid >> 5, c = tid & 31; float s = 0.f; const LAS float* rf = (const LAS float*)red;
        for (int k2 = 0; k2 < 64; ++k2) s += rf[((k2 * 8 + (c >> 2)) * 6 + b) * 4 + (c & 3)];
        out[b * N + col0 + c] = s + (bias ? bias[col0 + c] : 0.f); }
    __syncthreads();
}

__device__ __forceinline__ void gemv6_task16(const LAS float* vec, LAS f32x4* red, const float* W, int N, int col0, float* out, int tid) {
    const int cgp = tid & 3, ks = tid >> 2;
    f32x4 acc[6];
#pragma unroll
    for (int b = 0; b < 6; ++b) acc[b] = (f32x4){0.f, 0.f, 0.f, 0.f};
#pragma unroll
    for (int kk = 0; kk < 8; ++kk) { const int k = ks * 8 + kk; const f32x4 w = *(const f32x4*)(W + (size_t)k * N + col0 + 4 * cgp);
#pragma unroll
        for (int b = 0; b < 6; ++b) acc[b] += w * vec[b * 1024 + k]; }
#pragma unroll
    for (int b = 0; b < 6; ++b) red[(ks * 4 + cgp) * 6 + b] = acc[b];
    __syncthreads();
    if (tid < 96) { const int b = tid >> 4, c = tid & 15; float s = 0.f; const LAS float* rf = (const LAS float*)red;
        for (int k2 = 0; k2 < 128; ++k2) s += rf[((k2 * 4 + (c >> 2)) * 6 + b) * 4 + (c & 3)];
        out[b * N + col0 + c] = s; }
    __syncthreads();
}

struct Args { const float* in[24]; float* out; unsigned char* ws; int ph_lo, ph_hi; };
constexpr int NPHASE = 11;

__global__ void __launch_bounds__(NWAVES * 64, 2) mk_fwd(Args a) {
    extern __shared__ __attribute__((aligned(16))) unsigned char lds_raw[];
    cg::grid_group grid = cg::this_grid();
    LAS unsigned char* lds = (LAS unsigned char*)lds_raw;
    const int wave = __builtin_amdgcn_readfirstlane((int)threadIdx.x >> 6);
#define lane (att::lane_now())
#define tid ((wave << 6) | att::lane_now())
    const int G = gridDim.x; const int bx = blockIdx.x; const int vcu = (G % 8 == 0) ? (bx % 8) * (G / 8) + bx / 8 : bx;
    const int gw = vcu * NWAVES + wave, NGW = G * NWAVES;
    unsigned char* ws = a.ws; unsigned char* dob = (unsigned char*)a.out;
    const float *x_p = a.in[0], *x_s = a.in[1], *c_p = a.in[2], *c_s = a.in[3], *rel_bias = a.in[4], *norm1_g = a.in[5], *w_ada = a.in[6], *b_ada = a.in[7], *w_in = a.in[8],
                *qn_a = a.in[9], *kn_a = a.in[10], *lq1 = a.in[11], *lk1 = a.in[12], *lq2 = a.in[13], *lk2 = a.in[14], *subln_g = a.in[15], *qn_b = a.in[16], *kn_b = a.in[17],
                *w_br_a = a.in[18], *w_br_b = a.in[19], *w_o = a.in[20], *norm2_g = a.in[21], *w_up = a.in[22], *w_down = a.in[23];
    float* mod = (float*)(ws + WS_MOD); float* sbias = (float*)(ws + WS_SBIAS); float* rowss = (float*)(ws + WS_ROWSS);
    bf16 *WinT = (bf16*)(ws + WS_WIN), *WbaT = (bf16*)(ws + WS_WBA), *WbbT = (bf16*)(ws + WS_WBB), *WupT = (bf16*)(ws + WS_WUP), *WoT = (bf16*)(ws + WS_WO), *WdnT = (bf16*)(ws + WS_WDN);
    bf16 *QK = (bf16*)(ws + WS_QK), *VA = (bf16*)(ws + WS_VA), *DIL = (bf16*)(ws + WS_DIL), *GT = (bf16*)(ws + WS_GT), *MG = (bf16*)(ws + WS_MG), *A2 = (bf16*)(ws + WS_A2), *HB = (bf16*)(ws + WS_H);
    bf16 *XN = (bf16*)(dob + DO_XN), *YA = (bf16*)(dob + DO_YA), *YB = (bf16*)(dob + DO_YB);
    const int lo = a.ph_lo, hi = a.ph_hi;
    if (lo < 0) grid.sync();
    volatile LAS unsigned* bst = (volatile LAS unsigned*)(lds + BST_OFF);
    if (threadIdx.x < 4) bst[threadIdx.x] = 0u;
    __syncthreads();
    const XcdBarrier xbar = xcd_barrier_post((unsigned*)ws, bst);
#ifdef PMODE
    if (blockIdx.x == 0 && threadIdx.x == 0) *(volatile unsigned long long*)(ws + 65536 + 512) = __builtin_amdgcn_s_memrealtime();
#define PSTAMP(k) do { if (bx == 0 && threadIdx.x == 0) ((float*)(ws + 65536 + 256))[(k)] = (float)(__builtin_amdgcn_s_memrealtime() - *(volatile unsigned long long*)(ws + 65536 + 512)) * 0.01f; } while (0)
#else
#define PSTAMP(k) do {} while (0)
#endif
#ifndef P2_ROT
#define P2_ROT(v) (((v) >> 5) % 3)
#endif
#ifndef PPREV
#define PPREV (PMODE - 1)
#endif
#ifndef PBASE
#define PBASE 0
#define PQ 32.0f
#endif
#ifndef TBASE
#define TBASE 0
#define TSCALE 0.01f
#endif
#ifndef PH_MASK
#define PH_MASK 0x7ff
#endif
#define PH_ON(k) ((PH_MASK >> (k)) & 1)
#ifndef PH_REP
#define PH_REP 0
#endif
#define NREP(k) ((((PH_REP) >> (k)) & 1) ? 2 : 1)
#define IN(k) (lo <= (k) && (k) < hi)
#ifndef XSYNC
#define XSYNC 0
#endif
#define SEAM(k) do { if (IN(k) && IN((k) + 1)) { xcd_barrier(xbar); for (int xs_ = 0; xs_ < XSYNC; ++xs_) xcd_barrier(xbar); PSTAMP(k); } } while (0)

    if (PH_ON(0) && IN(0)) for (int rep_ = 0; rep_ < NREP(0); ++rep_) {
        LAS float* scr = (LAS float*)(lds + wave * 16384);
        constexpr int I_IN = (DM / 64) * (NIN / 32), I_BA = (DM / 64) * (DM / 32), I_BB = (512 / 64) * (DM / 32), I_O = I_BA, I_UP = (DM / 64) * (FF / 32), I_DN = (FF / 64) * (DM / 32);
        constexpr int NITEMS = I_IN + I_BA + I_BB + I_O + I_UP + I_DN;
        for (int it = gw; it < NITEMS; it += NGW) {
            int r = it;
            if (r < I_IN) { transpose_item<true>(w_in, DM, NIN, WinT, scr, r, lane); continue; } r -= I_IN;
            if (r < I_BA) { transpose_item<false>(w_br_a, DM, DM, WbaT, scr, r, lane, 1536, 0); continue; } r -= I_BA;
            if (r < I_BB) { transpose_item<false>(w_br_b, 512, DM, WbaT, scr, r, lane, 1536, 1024); continue; } r -= I_BB;
            if (r < I_O) { transpose_item<false>(w_o, DM, DM, WoT, scr, r, lane); continue; } r -= I_O;
            if (r < I_UP) { transpose_item<true>(w_up, DM, FF, WupT, scr, r, lane); continue; } r -= I_UP;
            transpose_item<false>(w_down, FF, DM, WdnT, scr, r, lane, LDH, 0);
        }
        for (int i = gw * 64 + lane; i < TOK; i += NGW * 64) rowss[i] = 0.f;
        __syncthreads();
        LAS float* vec = (LAS float*)lds; LAS f32x4* red = (LAS f32x4*)(lds + 32768);
        for (int i = tid; i < 6 * 1024; i += 512) { const int b = i >> 10, k = i & 1023; const float c = b < 4 ? c_p[b * 1024 + k] : c_s[(b - 4) * 1024 + k]; vec[i] = c / (1.0f + __expf(-c)); }
        __syncthreads();
        for (int task = vcu; task < 6144 / 32; task += G) gemv6_task(vec, red, w_ada, 6144, task * 32, b_ada, mod, tid);
        __syncthreads();
    }
    SEAM(0);
    if (PH_ON(1) && IN(1)) for (int rep_ = 0; rep_ < NREP(1); ++rep_) {
        for (int m0 = 4 * gw; m0 < TOK; m0 += 4 * NGW) {
            const int ln = lane; const int b = pg8::batch_of(m0);
            const float* xr = m0 < 16384 ? x_p + (size_t)m0 * 1024 : x_s + (size_t)(m0 - 16384) * 1024;
            const float* sh1 = mod + b * 6144; const float* sc1 = mod + b * 6144 + 1024;
            f32x4 v[4][4];
#pragma unroll
            for (int r = 0; r < 4; ++r)
#pragma unroll
                for (int j = 0; j < 4; ++j) v[r][j] = ((const f32x4*)(xr + (size_t)r * 1024))[ln + 64 * j];
            f32x4 gm[4], sh[4];
#pragma unroll
            for (int j = 0; j < 4; ++j) { const int c = 4 * ln + 256 * j; gm[j] = *(const f32x4*)(norm1_g + c) * (*(const f32x4*)(sc1 + c) + 1.0f); sh[j] = *(const f32x4*)(sh1 + c); }
#pragma unroll
            for (int r = 0; r < 4; ++r) {
                float s = 0.f;
#pragma unroll
                for (int j = 0; j < 4; ++j) s += (v[r][j].x * v[r][j].x + v[r][j].y * v[r][j].y) + (v[r][j].z * v[r][j].z + v[r][j].w * v[r][j].w);
                const float rstd = 1.0f / sqrtf(wave_sum(s) * (1.0f / 1024.0f) + 1e-6f);
                unsigned long long* o8 = (unsigned long long*)(XN + (size_t)(m0 + r) * 1024) + ln;
#pragma unroll
                for (int j = 0; j < 4; ++j) { const f32x4 h = v[r][j] * rstd * gm[j] + sh[j]; o8[64 * j] = (unsigned long long)pk2(h.x, h.y) | ((unsigned long long)pk2(h.z, h.w) << 32); }
            }
        }
        __syncthreads();
        LAS float* vec = (LAS float*)lds; LAS f32x4* red = (LAS f32x4*)(lds + 32768);
        for (int i = tid; i < 6 * 1024; i += 512) { const int b = i >> 10, k = i & 1023; vec[i] = mod[b * 6144 + 3072 + k]; }
        __syncthreads();
        for (int task = vcu; task < FF / 16; task += G) gemv6_task16(vec, red, w_up, FF, task * 16, sbias, tid);
        __syncthreads();
    }
    SEAM(1);
#pragma unroll 1
    for (int c = 0; c < 2; ++c) {
        const int S = c == 0 ? 4096 : 8192, lgS = c == 0 ? 12 : 13;
        bf16* Yc = c == 0 ? YA : XN;
        bf16* GTc = c == 0 ? GT : (bf16*)(ws + WS_GT1);
        if (PH_ON(2) && IN(2 + 3 * c)) for (int rep_ = 0; rep_ < NREP(2); ++rep_) {
#ifdef STAG1
            for (int sd_ = 0; sd_ < STAG1 * (vcu & 3); ++sd_) __builtin_amdgcn_s_sleep(127);
#endif
            pg8::Gemm g{XN + (size_t)c * CH * DM, WinT, CH, NIN, DM}; pg8::P1Order SO{c, (int)G, (int)bx};
            { LAS float* gl_ = (LAS float*)(lds + 131072);
              if (tid < 512) gl_[tid] = tid < 64 ? qn_a[tid] * pg8::C2Q : tid < 128 ? kn_a[tid - 64] : tid < 320 ? qn_b[tid - 128] * pg8::C2Q : kn_b[tid - 320];
              __syncthreads(); }
            pg8::EpiProj E{QK, VA, DIL, GTc, (const LAS float*)(lds + 131072), S, lgS};
            static_assert(WS_GT1 - WS_GT == pg8::GTX_OFF * 2, "gate buffer distance");
            pg8::gemm_phase<pg8::EpiProj, pg8::P1Order, true, true>(lds, g, SO, E);
        }
        SEAM(2 + 3 * c);
        if (PH_ON(3) && IN(3 + 3 * c)) for (int rep_ = 0; rep_ < NREP(3); ++rep_) {
            if (wave == 0) {
                const int ln = lane;
                const float a1 = wave_sum(lq1[ln] * lk1[ln]), a2 = wave_sum(lq2[ln] * lk2[ln]);
                const float gqa = wave_max(fabsf(qn_a[ln])), gka = wave_max(fabsf(kn_a[ln]));
                float gb = 0.f;
#pragma unroll
                for (int g = 0; g < 3; ++g) gb = fmaxf(gb, wave_max(fabsf(qn_b[64 * g + ln])) * wave_max(fabsf(kn_b[64 * g + ln])));
                float ba = 0.f, bb = 0.f;
                for (int i = ln; i < 1024; i += 64) { const float v = fabsf(rel_bias[i]); if ((i & 31) < 8) ba = fmaxf(ba, v); else bb = fmaxf(bb, v); }
                ba = wave_max(ba); bb = wave_max(bb);
                if (ln == 0) { LAS float* SC = (LAS float*)(lds + att::SC_OFF); SC[0] = __expf(a1) - __expf(a2) + 0.2f; SC[1] = (8.0f * gqa * gka + ba) * att::LOG2E; SC[2] = (8.0f * gb + bb) * att::LOG2E; }
            }
            __syncthreads();
            { const int nqb = S / 256; const int rot = P2_ROT(vcu); int kda = 0; bool dil_done = false;
              for (int s = 0; ; ++s) {
                  const int uda = vcu + kda * G;
                  if (!dil_done && (s == rot || uda >= 512)) {
                      for (int u = vcu; u < 256; u += G) att::dil_unit<false>(lds, DIL, Yc, rel_bias, u & 7, u >> 3, S, lgS, tid);
                      dil_done = true;
                  } else if (uda < 512) { const int sh = uda / nqb, qb = uda % nqb, seq = sh >> 3, head = sh & 7;
#ifdef TMODE
                      att::da_unit(lds, QK, VA, Yc, rel_bias, subln_g, head, seq * (S / 64), S / 64, qb, tid, (bx == 0 && c == 1 && kda == 0) ? (float*)(ws + 65536) : nullptr);
#else
                      att::da_unit(lds, QK, VA, Yc, rel_bias, subln_g, head, seq * (S / 64), S / 64, qb, tid);
#endif
                      ++kda;
                  } else break;
              } }
        }
        SEAM(3 + 3 * c);
        if (c == 1) {
            if (PH_ON(4) && IN(7)) for (int rep_ = 0; rep_ < NREP(4); ++rep_) {
                pg8::Gemm g{YA, WbaT, TOK, DM, 1536}; pg8::StaticOrder SO; SO.init(TOK, DM, G, bx);
                const ptrdiff_t aoff1 = ((const char*)XN - (const char*)YA) - (ptrdiff_t)64 * 256 * 1536 * 2;
                pg8::EpiBrC E{MG, GT, GT + (size_t)CH * 1024, (const bf16*)(ws + WS_GT1), (const bf16*)(ws + WS_GT1) + (size_t)CH * 1024, aoff1, 16};
                pg8::gemm_phase<pg8::EpiBrC, pg8::StaticOrder, true, true>(lds, g, SO, E);
            }
            SEAM(7);
        }
    }
    if (PH_ON(8) && IN(8)) for (int rep_ = 0; rep_ < NREP(8); ++rep_) {
        pg8::Gemm g{MG, WoT, TOK, DM, DM, 32}; pg8::StaticOrder SO; SO.init(TOK, DM, G, bx);
        pg8::EpiWo E{x_p, x_s, a.out, A2, mod, norm2_g, rowss};
        pg8::gemm_phase<pg8::EpiWo, pg8::StaticOrder, true, true>(lds, g, SO, E);
    }
    SEAM(8);
    if (PH_ON(9) && IN(9)) for (int rep_ = 0; rep_ < NREP(9); ++rep_) {
        pg8::Gemm g{A2, WupT, TOK, FF, DM, 32}; pg8::StaticOrder SO; SO.init(TOK, FF, G, bx);
        pg8::EpiUp E{HB, rowss, sbias};
        pg8::gemm_phase<pg8::EpiUp, pg8::StaticOrder, true, true>(lds, g, SO, E);
    }
    SEAM(9);
    if (PH_ON(10) && IN(10)) for (int rep_ = 0; rep_ < NREP(10); ++rep_) {
        pg8::Gemm g{HB, WdnT, TOK, DM, FF, HNBLK, LDH, LDH}; pg8::StaticOrder SO; SO.init(TOK, DM, G, bx);
        pg8::EpiDown E{a.out, mod};
        pg8::gemm_phase<pg8::EpiDown, pg8::StaticOrder, true, true>(lds, g, SO, E);
    }
#ifdef PMODE
    xcd_barrier(xbar); PSTAMP(10);
    if (bx == 0 && threadIdx.x == 0) { const float* tp = (const float*)(ws + 65536 + 256); a.out[0] += floorf(((PMODE == 0 ? tp[0] : (PMODE == 99 ? tp[10] * 0.1f : tp[PMODE] - tp[PPREV])) - (float)PBASE) * (1.0f / PQ)); }
#endif
#ifdef TMODE
    xcd_barrier(xbar);
    if (bx == 0 && threadIdx.x == 0) { const float* tp = (const float*)(ws + 65536); a.out[0] += (TMODE == 0) ? 100.0f : ((tp[TMODE - 1] - (float)TBASE) * TSCALE); }
#endif
#undef IN
#undef SEAM
#undef lane
#undef tid
}

extern "C" void kernel_launch(void* const* d_in, const int* in_sizes, int n_in, void* d_out, int out_size, void* d_ws, size_t ws_size, hipStream_t stream) {
    static int grid = 0;
    if (grid == 0) {
        if (n_in != 24 || out_size != TOK * DM || ws_size < WS_END) { fprintf(stderr, "kernel_launch: unexpected shapes (n_in %d, out %d, ws %zu)\n", n_in, out_size, ws_size); grid = -1; return; }
        int dev = 0, cus = 0, per_cu = 0;
        if (hipGetDevice(&dev) != hipSuccess || hipDeviceGetAttribute(&cus, hipDeviceAttributeMultiprocessorCount, dev) != hipSuccess) { grid = -1; return; }
        if (hipFuncSetAttribute((const void*)mk_fwd, hipFuncAttributeMaxDynamicSharedMemorySize, LDS_BYTES) != hipSuccess) { fprintf(stderr, "kernel_launch: hipFuncSetAttribute failed\n"); grid = -1; return; }
        if (hipOccupancyMaxActiveBlocksPerMultiprocessor(&per_cu, (const void*)mk_fwd, NWAVES * 64, LDS_BYTES) != hipSuccess || per_cu < 1) { fprintf(stderr, "kernel_launch: occupancy query says %d\n", per_cu); per_cu = 1; }
        (void)hipGetLastError();
        grid = cus;
    }
    if (grid < 0) return;
#ifdef XMEMSET
    for (int xm_ = 0; xm_ < XMEMSET; ++xm_) (void)hipMemsetAsync((char*)d_ws + (480u << 20) + xm_ * 65536, 0, 65536, stream);
#endif
    if (hipMemsetAsync(d_ws, 0, 65536, stream) != hipSuccess) { fprintf(stderr, "kernel_launch: hipMemsetAsync failed\n"); return; }
    Args a{};
    for (int i = 0; i < 24; ++i) a.in[i] = (const float*)d_in[i];
    a.out = (float*)d_out; a.ws = (unsigned char*)d_ws;
#ifndef MK_PER_PHASE
    a.ph_lo = 0; a.ph_hi = NPHASE;
    void* args[] = {&a};
#ifdef PLAIN_LAUNCH
    hipLaunchKernelGGL(mk_fwd, dim3(grid), dim3(NWAVES * 64), LDS_BYTES, stream, a); hipError_t e = hipGetLastError(); (void)args;
#else
    hipError_t e = hipLaunchCooperativeKernel((const void*)mk_fwd, dim3(grid), dim3(NWAVES * 64), args, LDS_BYTES, stream);
#endif
    if (e != hipSuccess) fprintf(stderr, "kernel_launch: cooperative launch failed: %s (grid %d)\n", hipGetErrorString(e), grid);
#else
    for (int p = 0; p < NPHASE; ++p) { a.ph_lo = p; a.ph_hi = p + 1; hipLaunchKernelGGL(mk_fwd, dim3(grid), dim3(NWAVES * 64), LDS_BYTES, stream, a); }
#endif
}
```
